# Optimizing an MI355X kernel written in HIP

```python
import math
import jax, jax.numpy as jnp
from jax import lax
import numpy as np

D_MODEL = 1024
BATCH = 32
SEQ = 256
DEPTH = 2
DEC_BATCH = 2
DEC_SEQ = 1024
PAST_LEN = 512

GRID_W = 64
NA_HEADS = 8
HEAD_DIM = 64
NA_WIDTH = NA_HEADS * HEAD_DIM
WIN_R = 8
WIN_C = 16
S5_WIDTH = D_MODEL - NA_WIDTH
S5_GROUP = 16
S5_GROUPS = S5_WIDTH // S5_GROUP
S5_STATE = 64
FNET_GROUPS = 4
FNET_GROUP_WIDTH = D_MODEL // FNET_GROUPS
D_FF = -(-8 * D_MODEL // (3 * 256)) * 256
N_EVEN = (DEPTH + 1) // 2
N_ODD = DEPTH // 2
Q_BLOCK = 128
EPS = 1e-6

kernel_name = 'hybrid_natten_s5_fnet_diffusion_step'


def _rmsnorm(x, g):
    xf = x.astype(jnp.float32)
    y = xf * lax.rsqrt(jnp.mean(xf * xf, axis=-1, keepdims=True) + EPS)
    return (y * g.astype(jnp.float32)).astype(x.dtype)


def _modulation(cond, w_mod, b_mod):
    m = jax.nn.silu(cond) @ w_mod + b_mod
    return [t[:, None, :] for t in jnp.split(m, 6, axis=-1)]


def _modulate(h, shift, scale):
    return h * (1 + scale) + shift


def _swiglu(h, wg, wu, wd):
    return (jax.nn.silu(h @ wg) * (h @ wu)) @ wd


def _even_proj(h, w_in):
    B, L, _ = h.shape
    z = h @ w_in
    q, k, v, u = jnp.split(z, [NA_WIDTH, 2 * NA_WIDTH, 3 * NA_WIDTH], axis=-1)
    shp = (B, L, NA_HEADS, HEAD_DIM)
    return q.reshape(shp), k.reshape(shp), v.reshape(shp), u


def _ctx_attention(q, k, v):
    B, L, H, Dh = q.shape
    nb = L // Q_BLOCK
    scale = Dh ** -0.5
    qb = q.reshape(B, nb, Q_BLOCK, H, Dh).transpose(1, 0, 2, 3, 4)

    def block(qi):
        s = jnp.einsum('bqhd,bkhd->bhqk', qi, k).astype(jnp.float32) * scale
        p = jax.nn.softmax(s, axis=-1).astype(v.dtype)
        return jnp.einsum('bhqk,bkhd->bqhd', p, v)

    o = lax.map(block, qb)
    return o.transpose(1, 0, 2, 3, 4).reshape(B, L, H, Dh)


def _latent_na_attention(q, k, v, ck, cv, rpb):
    B, T, H, Dh = q.shape
    rows = T // GRID_W
    kr = min(WIN_R, rows)
    kc = WIN_C
    scale = Dh ** -0.5
    qg = q.reshape(B, rows, GRID_W, H, Dh).transpose(1, 0, 2, 3, 4)
    kg = k.reshape(B, rows, GRID_W, H, Dh)
    vg = v.reshape(B, rows, GRID_W, H, Dh)
    cols = np.arange(GRID_W)
    col_start = np.clip(cols - kc // 2, 0, GRID_W - kc)
    col_idx = col_start[:, None] + np.arange(kc)[None, :]
    dc_idx = col_idx - cols[:, None] + (WIN_C - 1)

    def row_block(args):
        r, qr = args
        rs = jnp.clip(r - kr // 2, 0, rows - kr)
        kband = lax.dynamic_slice_in_dim(kg, rs, kr, axis=1)
        vband = lax.dynamic_slice_in_dim(vg, rs, kr, axis=1)
        kwin = kband[:, :, col_idx]
        vwin = vband[:, :, col_idx]
        dr_idx = rs + jnp.arange(kr) - r + (WIN_R - 1)
        bias = rpb[:, dr_idx][:, :, dc_idx]
        bias = bias.transpose(0, 2, 1, 3).astype(jnp.float32)
        s_loc = jnp.einsum('bqhd,biqjhd->bhqij', qr, kwin).astype(jnp.float32) * scale + bias[None]
        s_ctx = jnp.einsum('bqhd,blhd->bhql', qr, ck).astype(jnp.float32) * scale
        s = jnp.concatenate([s_loc.reshape(B, H, GRID_W, kr * kc), s_ctx], axis=-1)
        p = jax.nn.softmax(s, axis=-1).astype(v.dtype)
        p_loc = p[..., :kr * kc].reshape(B, H, GRID_W, kr, kc)
        p_ctx = p[..., kr * kc:]
        return (jnp.einsum('bhqij,biqjhd->bqhd', p_loc, vwin)
                + jnp.einsum('bhql,blhd->bqhd', p_ctx, cv))

    o = lax.map(row_block, (jnp.arange(rows), qg))
    return o.transpose(1, 0, 2, 3, 4).reshape(B, T, H, Dh)


def _scan_combine(e1, e2):
    a1r, a1i, b1r, b1i = e1
    a2r, a2i, b2r, b2i = e2
    return (a2r * a1r - a2i * a1i,
            a2r * a1i + a2i * a1r,
            a2r * b1r - a2i * b1i + b2r,
            a2r * b1i + a2i * b1r + b2i)


def _s5_direction(u, lam_re, lam_im, log_step, b_re, b_im, c_re, c_im, s0_re, s0_im, reverse):
    f32 = jnp.float32
    lr = jnp.minimum(lam_re.astype(f32), -1e-4)
    li = lam_im.astype(f32)
    dt = jnp.exp(log_step.astype(f32))[:, None]
    mag = jnp.exp(lr * dt)
    ar = mag * jnp.cos(li * dt)
    ai = mag * jnp.sin(li * dt)
    den = lr * lr + li * li
    nr = ar - 1.0
    ni = ai
    cr = (nr * lr + ni * li) / den
    ci = (ni * lr - nr * li) / den
    br_, bi_ = b_re.astype(f32), b_im.astype(f32)
    bbr = cr[..., None] * br_ - ci[..., None] * bi_
    bbi = cr[..., None] * bi_ + ci[..., None] * br_
    bur = jnp.einsum('blgh,gph->blgp', u, bbr)
    bui = jnp.einsum('blgh,gph->blgp', u, bbi)
    L = u.shape[1]
    first = L - 1 if reverse else 0
    last = 0 if reverse else L - 1
    s0r = s0_re.astype(f32)
    s0i = s0_im.astype(f32)
    bur = bur.at[:, first].add(ar * s0r - ai * s0i)
    bui = bui.at[:, first].add(ar * s0i + ai * s0r)
    Ar = jnp.broadcast_to(ar, bur.shape)
    Ai = jnp.broadcast_to(ai, bur.shape)
    _, _, xr, xi = lax.associative_scan(_scan_combine, (Ar, Ai, bur, bui), axis=1, reverse=reverse)
    y = (jnp.einsum('blgp,ghp->blgh', xr, c_re.astype(f32))
         - jnp.einsum('blgp,ghp->blgh', xi, c_im.astype(f32)))
    return y, xr[:, last], xi[:, last]


def _s5_mixer(u, s0, lam_re, lam_im, log_step, b_re, b_im, c_re, c_im, d, glu_w, glu_b):
    B, L, _ = u.shape
    uf = u.astype(jnp.float32).reshape(B, L, S5_GROUPS, S5_GROUP)
    yf, fr, fi = _s5_direction(uf, lam_re[0], lam_im[0], log_step[0], b_re[0], b_im[0],
                               c_re[0], c_im[0], s0[:, 0, 0], s0[:, 0, 1], False)
    yb, br, bi = _s5_direction(uf, lam_re[1], lam_im[1], log_step[1], b_re[1], b_im[1],
                               c_re[1], c_im[1], s0[:, 1, 0], s0[:, 1, 1], True)
    y = (yf + yb).reshape(B, L, S5_WIDTH) + d.astype(jnp.float32) * uf.reshape(B, L, S5_WIDTH)
    y = jax.nn.gelu(y)
    y = y * jax.nn.sigmoid(y @ glu_w.astype(jnp.float32) + glu_b.astype(jnp.float32))
    state = jnp.stack([jnp.stack([fr, fi], axis=1), jnp.stack([br, bi], axis=1)], axis=1)
    return y.astype(u.dtype), state


def _fourier_mixer(h, w_in, w_out):
    B, L, _ = h.shape
    z = (h @ w_in).astype(jnp.float32).reshape(B, L, FNET_GROUPS, FNET_GROUP_WIDTH)
    f = jnp.fft.fft2(z, axes=(1, 3), norm='ortho').real
    return f.reshape(B, L, D_MODEL).astype(h.dtype) @ w_out


def setup_inputs(seed: int = 0) -> dict:
    key = jax.random.key(seed)
    ks = iter(jax.random.split(key, 32))
    f32 = jnp.float32

    def nrm(shape, scale):
        return jax.random.normal(next(ks), shape, f32) * scale

    dS = D_MODEL ** -0.5
    inp = {}
    inp['x_prompt'] = nrm((BATCH, SEQ, D_MODEL), 1.0)
    inp['x_sample'] = nrm((DEC_BATCH, DEC_SEQ, D_MODEL), 1.0)
    inp['cache_na_k'] = nrm((DEC_BATCH, N_EVEN, PAST_LEN, NA_HEADS, HEAD_DIM), 1.0)
    inp['cache_na_v'] = nrm((DEC_BATCH, N_EVEN, PAST_LEN, NA_HEADS, HEAD_DIM), 1.0)
    inp['state_s5'] = nrm((DEC_BATCH, N_EVEN, 2, 2, S5_GROUPS, S5_STATE), 0.5)
    inp['c'] = nrm((DEC_BATCH, D_MODEL), 1.0)
    inp['c_ctx'] = nrm((D_MODEL,), 1.0)
    inp['w_mod'] = nrm((DEPTH, D_MODEL, 6 * D_MODEL), 0.5 * dS)
    inp['b_mod'] = nrm((DEPTH, 6 * D_MODEL), 0.01)
    inp['norm_mix_g'] = 1.0 + nrm((DEPTH, D_MODEL), 0.01)
    inp['norm_ffn_g'] = 1.0 + nrm((DEPTH, D_MODEL), 0.01)
    inp['w_in_even'] = nrm((N_EVEN, D_MODEL, 3 * NA_WIDTH + S5_WIDTH), dS)
    inp['na_rpb'] = nrm((N_EVEN, NA_HEADS, 2 * WIN_R - 1, 2 * WIN_C - 1), 0.1)
    inp['s5_lam_re'] = -0.5 + nrm((N_EVEN, 2, S5_GROUPS, S5_STATE), 0.01)
    inp['s5_lam_im'] = jnp.pi * jnp.arange(S5_STATE, dtype=f32) + nrm((N_EVEN, 2, S5_GROUPS, S5_STATE), 0.01)
    inp['s5_log_step'] = jax.random.uniform(next(ks), (N_EVEN, 2, S5_GROUPS), f32,
                                            minval=math.log(0.001), maxval=math.log(0.1))
    inp['s5_b_re'] = nrm((N_EVEN, 2, S5_GROUPS, S5_STATE, S5_GROUP), (2 * S5_GROUP) ** -0.5)
    inp['s5_b_im'] = nrm((N_EVEN, 2, S5_GROUPS, S5_STATE, S5_GROUP), (2 * S5_GROUP) ** -0.5)
    inp['s5_c_re'] = nrm((N_EVEN, 2, S5_GROUPS, S5_GROUP, S5_STATE), (2 * S5_STATE) ** -0.5)
    inp['s5_c_im'] = nrm((N_EVEN, 2, S5_GROUPS, S5_GROUP, S5_STATE), (2 * S5_STATE) ** -0.5)
    inp['s5_d'] = nrm((N_EVEN, S5_WIDTH), 1.0)
    inp['s5_glu_w'] = nrm((N_EVEN, S5_WIDTH, S5_WIDTH), S5_WIDTH ** -0.5)
    inp['s5_glu_b'] = nrm((N_EVEN, S5_WIDTH), 0.01)
    inp['w_out_even'] = nrm((N_EVEN, D_MODEL, D_MODEL), dS)
    inp['w_in_odd'] = nrm((N_ODD, D_MODEL, D_MODEL), dS)
    inp['w_out_odd'] = nrm((N_ODD, D_MODEL, D_MODEL), dS)
    inp['ffn_w_gate'] = nrm((DEPTH, D_MODEL, D_FF), dS)
    inp['ffn_w_up'] = nrm((DEPTH, D_MODEL, D_FF), dS)
    inp['ffn_w_down'] = nrm((DEPTH, D_FF, D_MODEL), D_FF ** -0.5)
    inp['final_norm_g'] = 1.0 + nrm((D_MODEL,), 0.01)
    return inp


def reference(x_prompt, x_sample, cache_na_k, cache_na_v, state_s5, c, c_ctx,
              w_mod, b_mod, norm_mix_g, norm_ffn_g, w_in_even, na_rpb,
              s5_lam_re, s5_lam_im, s5_log_step, s5_b_re, s5_b_im, s5_c_re, s5_c_im,
              s5_d, s5_glu_w, s5_glu_b, w_out_even, w_in_odd, w_out_odd,
              ffn_w_gate, ffn_w_up, ffn_w_down, final_norm_g):
    xp = x_prompt
    xs = x_sample
    Bp, Lp, _ = xp.shape
    Bs, Ls, _ = xs.shape
    new_k, new_v, new_s = [], [], []
    for layer in range(DEPTH):
        mp = _modulation(c_ctx[None], w_mod[layer], b_mod[layer])
        ms = _modulation(c, w_mod[layer], b_mod[layer])
        hp = _modulate(_rmsnorm(xp, norm_mix_g[layer]), mp[0], mp[1])
        hs = _modulate(_rmsnorm(xs, norm_mix_g[layer]), ms[0], ms[1])
        if layer % 2 == 0:
            e = layer // 2
            s5p = (s5_lam_re[e], s5_lam_im[e], s5_log_step[e], s5_b_re[e], s5_b_im[e],
                   s5_c_re[e], s5_c_im[e], s5_d[e], s5_glu_w[e], s5_glu_b[e])
            qp, kp, vp, up = _even_proj(hp, w_in_even[e])
            ap = _ctx_attention(qp, kp, vp)
            s0 = jnp.zeros((Bp, 2, 2, S5_GROUPS, S5_STATE), jnp.float32)
            yp, stp = _s5_mixer(up, s0, *s5p)
            op = jnp.concatenate([ap.reshape(Bp, Lp, NA_WIDTH), yp], axis=-1) @ w_out_even[e]
            new_k.append(kp)
            new_v.append(vp)
            new_s.append(stp)
            qs, ks_, vs, us = _even_proj(hs, w_in_even[e])
            as_ = _latent_na_attention(qs, ks_, vs, cache_na_k[:, e], cache_na_v[:, e], na_rpb[e])
            ys, _ = _s5_mixer(us, state_s5[:, e].astype(jnp.float32), *s5p)
            os_ = jnp.concatenate([as_.reshape(Bs, Ls, NA_WIDTH), ys], axis=-1) @ w_out_even[e]
        else:
            o = layer // 2
            op = _fourier_mixer(hp, w_in_odd[o], w_out_odd[o])
            os_ = _fourier_mixer(hs, w_in_odd[o], w_out_odd[o])
        xp = xp + mp[2] * op
        xs = xs + ms[2] * os_
        hp = _modulate(_rmsnorm(xp, norm_ffn_g[layer]), mp[3], mp[4])
        hs = _modulate(_rmsnorm(xs, norm_ffn_g[layer]), ms[3], ms[4])
        xp = xp + mp[5] * _swiglu(hp, ffn_w_gate[layer], ffn_w_up[layer], ffn_w_down[layer])
        xs = xs + ms[5] * _swiglu(hs, ffn_w_gate[layer], ffn_w_up[layer], ffn_w_down[layer])
    y_prompt = _rmsnorm(xp, final_norm_g)
    y_sample = _rmsnorm(xs, final_norm_g)
    new_cache_na_k = jnp.stack(new_k, axis=1)
    new_cache_na_v = jnp.stack(new_v, axis=1)
    new_state_s5 = jnp.stack(new_s, axis=1)
    return (y_prompt, y_sample, new_cache_na_k, new_cache_na_v, new_state_s5)
```

```cpp
#include <hip/hip_runtime.h>
#include <hip/hip_cooperative_groups.h>
#include <cstdio>
namespace cg = cooperative_groups;

typedef unsigned short bf16_t;
typedef short bf16x8 __attribute__((ext_vector_type(8)));
typedef float f32x4 __attribute__((ext_vector_type(4)));
typedef float f32x16 __attribute__((ext_vector_type(16)));
typedef unsigned u32x4 __attribute__((ext_vector_type(4)));
typedef unsigned u32x2 __attribute__((ext_vector_type(2)));

#ifndef N_LAUNCH_MODE
#define N_LAUNCH_MODE 0
#endif

constexpr int DM = 1024, NP = 8192, NL = 2048, NTOK = NP + NL, LP = 256, LS = 1024;
constexpr int DFF = 2816, NAW = 512, S5W = 512;
constexpr int NPHASE = 18;

constexpr size_t al256(size_t x) { return (x + 255) & ~(size_t)255; }
constexpr size_t OFF_MOD = 0;
constexpr size_t OFF_AR = al256(OFF_MOD + 2 * 3 * 6144 * 4);
constexpr size_t OFF_AI = al256(OFF_AR + 4096 * 4);
constexpr size_t OFF_BBAR = al256(OFF_AI + 4096 * 4);
constexpr size_t OFF_WT_IN = al256(OFF_BBAR + 131072 * 4);
constexpr size_t OFF_WT_GLU = al256(OFF_WT_IN + 2048 * 1024 * 2);
constexpr size_t OFF_WT_OUT = al256(OFF_WT_GLU + 512 * 512 * 2);
constexpr size_t OFF_WT_INO = al256(OFF_WT_OUT + 1024 * 1024 * 2);
constexpr size_t OFF_WT_OUTO = al256(OFF_WT_INO + 1024 * 1024 * 2);
constexpr size_t OFF_WT_GU = al256(OFF_WT_OUTO + 1024 * 1024 * 2);
constexpr size_t OFF_WT_DN = al256(OFF_WT_GU + (size_t)2 * 5632 * 1024 * 2);
constexpr size_t OFF_CS2 = al256(OFF_WT_DN + (size_t)2 * 1024 * 2816 * 2);
constexpr size_t OFF_CL2P = al256(OFF_CS2 + 512 * 256 * 2);
constexpr size_t OFF_CL2S = al256(OFF_CL2P + 256 * 512 * 2);
constexpr size_t OFF_ABUF = al256(OFF_CL2S + 1024 * 2048 * 2);
constexpr size_t OFF_CAT = al256(OFF_ABUF + (size_t)NTOK * 1024 * 2);
constexpr size_t OFF_X = al256(OFF_CAT + (size_t)NTOK * 1024 * 2);
constexpr size_t OFF_POOL = al256(OFF_X + (size_t)NTOK * 1024 * 4);
constexpr size_t OFF_QB = OFF_POOL;
constexpr size_t OFF_KB = OFF_QB + (size_t)NTOK * 512 * 2;
constexpr size_t OFF_VB = OFF_KB + (size_t)NTOK * 512 * 2;
constexpr size_t OFF_U = OFF_VB + (size_t)NTOK * 512 * 2;
constexpr size_t OFF_YF = OFF_U + (size_t)NTOK * 512 * 4;
constexpr size_t OFF_YB = OFF_YF + (size_t)NTOK * 512 * 4;
constexpr size_t POOL_END0 = OFF_YB + (size_t)NTOK * 512 * 4;
constexpr size_t OFF_HFF = OFF_POOL;
constexpr size_t OFF_Z = OFF_POOL;
constexpr size_t OFF_OT = OFF_Z + (size_t)NTOK * 1024 * 2;
constexpr size_t WS_NEED = POOL_END0;
static_assert(WS_NEED <= (size_t)256 * 1024 * 1024, "workspace");

struct Params {
  const float *x_prompt, *x_sample, *cache_k, *cache_v, *state_s5, *c, *c_ctx, *w_mod, *b_mod, *norm_mix_g, *norm_ffn_g,
      *w_in_even, *na_rpb, *lam_re, *lam_im, *log_step, *b_re, *b_im, *c_re, *c_im, *s5_d, *glu_w, *glu_b, *w_out_even,
      *w_in_odd, *w_out_odd, *w_gate, *w_up, *w_down, *final_g;
  float* out;
  char* ws;
};

typedef __bf16 bf16v2_t __attribute__((ext_vector_type(2)));
__device__ __forceinline__ unsigned pack_bf16(float lo, float hi) {
  bf16v2_t v = {(__bf16)lo, (__bf16)hi};
  return __builtin_bit_cast(unsigned, v);
}
__device__ __forceinline__ float bf2f(unsigned short h) { return __uint_as_float(((unsigned)h) << 16); }
__device__ __forceinline__ u32x4 pack8(f32x4 a, f32x4 b) {
  u32x4 r;
  r[0] = pack_bf16(a[0], a[1]); r[1] = pack_bf16(a[2], a[3]); r[2] = pack_bf16(b[0], b[1]); r[3] = pack_bf16(b[2], b[3]);
  return r;
}
__device__ __forceinline__ bf16x8 as_bf16x8(u32x4 v) { return __builtin_bit_cast(bf16x8, v); }
__device__ __forceinline__ float sigmoidf_(float x) { return 1.0f / (1.0f + __expf(-x)); }
__device__ __forceinline__ float siluf_(float x) { return x * sigmoidf_(x); }
__device__ __forceinline__ float gelu_tanh(float x) {
  const float u = 0.7978845608028654f * (x + 0.044715f * x * x * x);
  const float t = 1.0f - 2.0f / (1.0f + __expf(2.0f * u));
  return 0.5f * x * (1.0f + t);
}
__device__ __forceinline__ float half_bcast(float x, int which) {
  auto r = __builtin_amdgcn_permlane32_swap(__float_as_uint(x), __float_as_uint(x), false, false);
  return __uint_as_float(which ? r[1] : r[0]);
}
__device__ __forceinline__ float xor32(float x) {
  auto r = __builtin_amdgcn_permlane32_swap(__float_as_uint(x), __float_as_uint(x), false, false);
  return (threadIdx.x & 32) ? __uint_as_float(r[0]) : __uint_as_float(r[1]);
}
__device__ __forceinline__ int cond_index(int row) { return row < NP ? 0 : 1 + ((row - NP) >> 10); }
__device__ __forceinline__ const float* xin_row(const Params& p, int row) {
  return row < NP ? p.x_prompt + (size_t)row * DM : p.x_sample + (size_t)(row - NP) * DM;
}

struct ALoadPlain {
  const bf16_t* A; int lda;
  __device__ __forceinline__ u32x4 operator()(int row, int k) const { return *(const u32x4*)(A + (size_t)row * lda + k); }
};

template <class AL, class EP>
__device__ __forceinline__ void gemm_tile(const AL& al, const bf16_t* Bt, int ldb, int K, int m0, int n0, const EP& ep, char* smem) {
  const int tid = threadIdx.x, lane = tid & 63, wid = tid >> 6, wm = wid >> 1, wn = wid & 1;
  const int lr = lane & 31, lh = lane >> 5;
  f32x16 acc[2][2];
#pragma unroll
  for (int a = 0; a < 2; ++a)
#pragma unroll
    for (int b = 0; b < 2; ++b)
#pragma unroll
      for (int i = 0; i < 16; ++i) acc[a][b][i] = 0.f;
  const int ldrow = tid >> 3, ldseg = tid & 7;
  u32x4 ra[4], rb[4];
  const int nk = K >> 6;
#pragma unroll
  for (int i = 0; i < 4; ++i) {
    const int row = ldrow + 32 * i;
    ra[i] = al(m0 + row, ldseg * 8);
    rb[i] = *(const u32x4*)(Bt + (size_t)(n0 + row) * ldb + ldseg * 8);
  }
#pragma unroll
  for (int i = 0; i < 4; ++i) {
    const int row = ldrow + 32 * i;
    const int off = row * 128 + ((ldseg ^ ((row >> 1) & 7)) << 4);
    *(u32x4*)(smem + off) = ra[i];
    *(u32x4*)(smem + 16384 + off) = rb[i];
  }
  __syncthreads();
  for (int kt = 0; kt < nk; ++kt) {
    if (kt + 1 < nk) {
#pragma unroll
      for (int i = 0; i < 4; ++i) {
        const int row = ldrow + 32 * i;
        ra[i] = al(m0 + row, (kt + 1) * 64 + ldseg * 8);
        rb[i] = *(const u32x4*)(Bt + (size_t)(n0 + row) * ldb + (kt + 1) * 64 + ldseg * 8);
      }
    }
    const char* sa = smem + (kt & 1) * 32768;
    const char* sb = sa + 16384;
#pragma unroll
    for (int ks = 0; ks < 4; ++ks) {
      bf16x8 af[2], bfr[2];
#pragma unroll
      for (int mt = 0; mt < 2; ++mt) {
        const int row = wm * 64 + mt * 32 + lr;
        af[mt] = *(const bf16x8*)(sa + row * 128 + (((ks * 2 + lh) ^ ((row >> 1) & 7)) << 4));
      }
#pragma unroll
      for (int nt = 0; nt < 2; ++nt) {
        const int row = wn * 64 + nt * 32 + lr;
        bfr[nt] = *(const bf16x8*)(sb + row * 128 + (((ks * 2 + lh) ^ ((row >> 1) & 7)) << 4));
      }
#pragma unroll
      for (int mt = 0; mt < 2; ++mt)
#pragma unroll
        for (int nt = 0; nt < 2; ++nt) acc[mt][nt] = __builtin_amdgcn_mfma_f32_32x32x16_bf16(bfr[nt], af[mt], acc[mt][nt], 0, 0, 0);
    }
    if (kt + 1 < nk) {
      char* d = smem + ((kt + 1) & 1) * 32768;
#pragma unroll
      for (int i = 0; i < 4; ++i) {
        const int row = ldrow + 32 * i;
        const int off = row * 128 + ((ldseg ^ ((row >> 1) & 7)) << 4);
        *(u32x4*)(d + off) = ra[i];
        *(u32x4*)(d + 16384 + off) = rb[i];
      }
    }
    __syncthreads();
  }
  ep(acc, m0 + wm * 64, n0 + wn * 64, lr, lh);
}

template <class F>
__device__ __forceinline__ void epi_foreach(const f32x16 (&acc)[2][2], int rowbase, int colbase, int lr, int lh, const F& f) {
#pragma unroll
  for (int mt = 0; mt < 2; ++mt)
#pragma unroll
    for (int nt = 0; nt < 2; ++nt)
#pragma unroll
      for (int g = 0; g < 4; ++g) {
        const f32x4 v = {acc[mt][nt][4 * g], acc[mt][nt][4 * g + 1], acc[mt][nt][4 * g + 2], acc[mt][nt][4 * g + 3]};
        f(rowbase + mt * 32 + lr, colbase + nt * 32 + 8 * g + 4 * lh, v);
      }
}

struct EpiBf16 {
  bf16_t* C; int ldc;
  __device__ __forceinline__ void operator()(const f32x16 (&acc)[2][2], int rowbase, int colbase, int lr, int lh) const {
    epi_foreach(acc, rowbase, colbase, lr, lh, [&](int row, int col, f32x4 v) {
      u32x2 o; o[0] = pack_bf16(v[0], v[1]); o[1] = pack_bf16(v[2], v[3]);
      *(u32x2*)(C + (size_t)row * ldc + col) = o;
    });
  }
};
struct EpiInEven {
  bf16_t *Q, *Kb, *Vb; float *U, *outk, *outv;
  __device__ __forceinline__ void operator()(const f32x16 (&acc)[2][2], int rowbase, int colbase, int lr, int lh) const {
    const int region = colbase >> 9;
    epi_foreach(acc, rowbase, colbase, lr, lh, [&](int row, int col, f32x4 v) {
      const int c = col & 511;
      if (region == 3) {
        *(f32x4*)(U + (size_t)row * 512 + c) = v;
      } else {
        u32x2 o; o[0] = pack_bf16(v[0], v[1]); o[1] = pack_bf16(v[2], v[3]);
        bf16_t* dst = region == 0 ? Q : (region == 1 ? Kb : Vb);
        *(u32x2*)(dst + (size_t)row * 512 + c) = o;
        if (region != 0 && row < NP) {
          float* od = region == 1 ? outk : outv;
          *(f32x4*)(od + (size_t)row * 512 + c) = v;
        }
      }
    });
  }
};
struct EpiResid {
  const float *xp, *xs; const float* Xin; bool from_input; float* Xout; const float* gate;
  __device__ __forceinline__ void operator()(const f32x16 (&acc)[2][2], int rowbase, int colbase, int lr, int lh) const {
    epi_foreach(acc, rowbase, colbase, lr, lh, [&](int row, int col, f32x4 v) {
      const float* xr = from_input ? (row < NP ? xp + (size_t)row * DM : xs + (size_t)(row - NP) * DM) : Xin + (size_t)row * DM;
      const f32x4 x = *(const f32x4*)(xr + col);
      const f32x4 gt = *(const f32x4*)(gate + cond_index(row) * 6144 + col);
      f32x4 o;
#pragma unroll
      for (int e = 0; e < 4; ++e) o[e] = x[e] + gt[e] * v[e];
      *(f32x4*)(Xout + (size_t)row * DM + col) = o;
    });
  }
};
struct EpiSwiGLU {
  bf16_t* H;
  __device__ __forceinline__ void operator()(const f32x16 (&acc)[2][2], int rowbase, int colbase, int lr, int lh) const {
#pragma unroll
    for (int mt = 0; mt < 2; ++mt)
#pragma unroll
      for (int g = 0; g < 4; ++g) {
        const int row = rowbase + mt * 32 + lr, col = (colbase >> 1) + 8 * g + 4 * lh;
        float o[4];
#pragma unroll
        for (int e = 0; e < 4; ++e) o[e] = siluf_(acc[mt][0][4 * g + e]) * acc[mt][1][4 * g + e];
        u32x2 w; w[0] = pack_bf16(o[0], o[1]); w[1] = pack_bf16(o[2], o[3]);
        *(u32x2*)(H + (size_t)row * DFF + col) = w;
      }
  }
};
struct ALoadGlu {
  const float *YF, *YB, *U, *D;
  __device__ __forceinline__ u32x4 operator()(int row, int k) const {
    const size_t o = (size_t)row * 512 + k;
    f32x4 a[2];
#pragma unroll
    for (int h = 0; h < 2; ++h) {
      const f32x4 yf = *(const f32x4*)(YF + o + 4 * h), yb = *(const f32x4*)(YB + o + 4 * h), u = *(const f32x4*)(U + o + 4 * h), d = *(const f32x4*)(D + k + 4 * h);
#pragma unroll
      for (int e = 0; e < 4; ++e) a[h][e] = gelu_tanh(yf[e] + yb[e] + d[e] * u[e]);
    }
    return pack8(a[0], a[1]);
  }
};
struct EpiGlu {
  const float *YF, *YB, *U, *D, *bias; bf16_t* CAT;
  __device__ __forceinline__ void operator()(const f32x16 (&acc)[2][2], int rowbase, int colbase, int lr, int lh) const {
    epi_foreach(acc, rowbase, colbase, lr, lh, [&](int row, int col, f32x4 v) {
      const size_t o = (size_t)row * 512 + col;
      const f32x4 yf = *(const f32x4*)(YF + o), yb = *(const f32x4*)(YB + o), u = *(const f32x4*)(U + o), d = *(const f32x4*)(D + col), b = *(const f32x4*)(bias + col);
      float r[4];
#pragma unroll
      for (int e = 0; e < 4; ++e) { const float y = gelu_tanh(yf[e] + yb[e] + d[e] * u[e]); r[e] = y * sigmoidf_(v[e] + b[e]); }
      u32x2 w; w[0] = pack_bf16(r[0], r[1]); w[1] = pack_bf16(r[2], r[3]);
      *(u32x2*)(CAT + (size_t)row * DM + 512 + col) = w;
    });
  }
};

__device__ void prep_mod_item(const Params& p, int item, char* smem) {
  const int layer = item / 96, cg64 = item % 96;
  const int tid = threadIdx.x, kg = tid >> 4, l16 = tid & 15;
  float* sc = (float*)smem;
  float* red = (float*)(smem + 12288);
  __syncthreads();
  for (int i = tid; i < 3072; i += 256) {
    const int ci = i >> 10, k = i & 1023;
    const float cv = ci == 0 ? p.c_ctx[k] : p.c[(ci - 1) * DM + k];
    sc[i] = siluf_(cv);
  }
  __syncthreads();
  const int col = cg64 * 64 + l16 * 4;
  const float* w = p.w_mod + ((size_t)layer * DM + kg * 64) * 6144 + col;
  float a[3][4];
#pragma unroll
  for (int ci = 0; ci < 3; ++ci)
#pragma unroll
    for (int e = 0; e < 4; ++e) a[ci][e] = 0.f;
#pragma unroll 8
  for (int r = 0; r < 64; ++r) {
    const f32x4 wv = *(const f32x4*)(w + (size_t)r * 6144);
#pragma unroll
    for (int ci = 0; ci < 3; ++ci) {
      const float s = sc[ci * 1024 + kg * 64 + r];
#pragma unroll
      for (int e = 0; e < 4; ++e) a[ci][e] += s * wv[e];
    }
  }
#pragma unroll
  for (int ci = 0; ci < 3; ++ci)
#pragma unroll
    for (int e = 0; e < 4; ++e) red[(kg * 3 + ci) * 64 + l16 * 4 + e] = a[ci][e];
  __syncthreads();
  if (tid < 192) {
    const int ci = tid >> 6, c = tid & 63;
    float sum = p.b_mod[layer * 6144 + cg64 * 64 + c];
#pragma unroll
    for (int k2 = 0; k2 < 16; ++k2) sum += red[(k2 * 3 + ci) * 64 + c];
    ((float*)(p.ws + OFF_MOD))[(size_t)(layer * 3 + ci) * 6144 + cg64 * 64 + c] = sum;
  }
}

__device__ void prep_transpose_tile(const float* src, int K, int N, bf16_t* dst, int kt, int nt, int mapmode, char* smem) {
  float* T = (float*)smem;
  const int tid = threadIdx.x;
  __syncthreads();
#pragma unroll
  for (int i = 0; i < 4; ++i) {
    const int idx = tid + 256 * i, kr = idx >> 4, c4 = idx & 15;
    const f32x4 v = *(const f32x4*)(src + (size_t)(kt * 64 + kr) * N + nt * 64 + c4 * 4);
#pragma unroll
    for (int e = 0; e < 4; ++e) T[kr * 65 + c4 * 4 + e] = v[e];
  }
  __syncthreads();
#pragma unroll
  for (int i = 0; i < 2; ++i) {
    const int idx = tid + 256 * i, nr = idx >> 3, seg = idx & 7;
    f32x4 a, b;
#pragma unroll
    for (int e = 0; e < 4; ++e) { a[e] = T[(seg * 8 + e) * 65 + nr]; b[e] = T[(seg * 8 + 4 + e) * 65 + nr]; }
    const int n = nt * 64 + nr;
    int drow = n;
    if (mapmode == 1) drow = (n >> 5) * 64 + (n & 31);
    else if (mapmode == 2) drow = (n >> 5) * 64 + 32 + (n & 31);
    *(u32x4*)(dst + (size_t)drow * K + kt * 64 + seg * 8) = pack8(a, b);
  }
}

__device__ void prep_s5_item(const Params& p, int item) {
  const int idx = item * 256 + threadIdx.x;
  const int d = idx >> 11, g = (idx >> 6) & 31;
  const float lr = fminf(p.lam_re[idx], -1e-4f), li = p.lam_im[idx];
  const float dt = expf(p.log_step[d * 32 + g]);
  const float mag = expf(lr * dt);
  const float ar = mag * cosf(li * dt), ai = mag * sinf(li * dt);
  const float den = lr * lr + li * li, nr = ar - 1.0f, ni = ai;
  const float cr = (nr * lr + ni * li) / den, ci = (ni * lr - nr * li) / den;
  ((float*)(p.ws + OFF_AR))[idx] = ar;
  ((float*)(p.ws + OFF_AI))[idx] = ai;
  float* bb = (float*)(p.ws + OFF_BBAR);
  const int pp = idx & 63;
  const size_t o0 = ((size_t)((d * 32 + g) * 2 + 0) * 64 + pp) * 16, o1 = ((size_t)((d * 32 + g) * 2 + 1) * 64 + pp) * 16;
  for (int h = 0; h < 16; ++h) {
    const float br = p.b_re[(size_t)idx * 16 + h], bi = p.b_im[(size_t)idx * 16 + h];
    bb[o0 + h] = cr * br - ci * bi;
    bb[o1 + h] = cr * bi + ci * br;
  }
}

__device__ void prep_dft_item(const Params& p, int item) {
  const int tid = threadIdx.x;
  bf16_t* dst; int e0;
  int mode;
  if (item < 64) { dst = (bf16_t*)(p.ws + OFF_CS2); e0 = item * 2048 + tid * 8; mode = 0; }
  else if (item < 128) { dst = (bf16_t*)(p.ws + OFF_CL2P); e0 = (item - 64) * 2048 + tid * 8; mode = 1; }
  else { dst = (bf16_t*)(p.ws + OFF_CL2S); e0 = (item - 128) * 2048 + tid * 8; mode = 2; }
  float v[8];
#pragma unroll
  for (int j = 0; j < 8; ++j) {
    const int e = e0 + j;
    float s, c;
    if (mode == 0) {
      const int row = e >> 8, cc = e & 255, kc = row >> 1, cs = row & 1;
      const int ph = (kc * cc) & 255;
      sincospif((float)ph * (2.0f / 256.0f), &s, &c);
      v[j] = (cs ? s : c) * (1.0f / 16.0f);
    } else if (mode == 1) {
      const int kl = e >> 9, r = e & 511, cs = r >> 8, l = r & 255;
      const int ph = (kl * l) & 255;
      sincospif((float)ph * (2.0f / 256.0f), &s, &c);
      v[j] = (cs ? -s : c) * (1.0f / 16.0f);
    } else {
      const int kl = e >> 11, r = e & 2047, cs = r >> 10, l = r & 1023;
      const int ph = (kl * l) & 1023;
      sincospif((float)ph * (2.0f / 1024.0f), &s, &c);
      v[j] = (cs ? -s : c) * (1.0f / 32.0f);
    }
  }
  u32x4 o; o[0] = pack_bf16(v[0], v[1]); o[1] = pack_bf16(v[2], v[3]); o[2] = pack_bf16(v[4], v[5]); o[3] = pack_bf16(v[6], v[7]);
  *(u32x4*)(dst + e0) = o;
}

__device__ void phase_prep(const Params& p, char* smem) {
  constexpr int N_MOD = 192;
  constexpr int T0 = N_MOD;
  constexpr int T_IN = 16 * 32, T_GLU = 8 * 8, T_SQ = 256, T_FF = 16 * 44;
  constexpr int N_TR = T_IN + T_GLU + 3 * T_SQ + 6 * T_FF;
  constexpr int S0 = T0 + N_TR, D0 = S0 + 16, TOTAL = D0 + 1152;
  for (int item = blockIdx.x; item < TOTAL; item += gridDim.x) {
    if (item < T0) prep_mod_item(p, item, smem);
    else if (item < S0) {
      int t = item - T0;
      if (t < T_IN) { prep_transpose_tile(p.w_in_even, 1024, 2048, (bf16_t*)(p.ws + OFF_WT_IN), t / 32, t % 32, 0, smem); continue; }
      t -= T_IN;
      if (t < T_GLU) { prep_transpose_tile(p.glu_w, 512, 512, (bf16_t*)(p.ws + OFF_WT_GLU), t / 8, t % 8, 0, smem); continue; }
      t -= T_GLU;
      if (t < 3 * T_SQ) {
        const int w = t / T_SQ, tt = t % T_SQ;
        const float* src = w == 0 ? p.w_out_even : (w == 1 ? p.w_in_odd : p.w_out_odd);
        const size_t off = w == 0 ? OFF_WT_OUT : (w == 1 ? OFF_WT_INO : OFF_WT_OUTO);
        prep_transpose_tile(src, 1024, 1024, (bf16_t*)(p.ws + off), tt / 16, tt % 16, 0, smem);
        continue;
      }
      t -= 3 * T_SQ;
      const int w = t / T_FF, tt = t % T_FF;
      if (w < 4) {
        const int layer = w & 1, isup = w >> 1;
        const float* src = (isup ? p.w_up : p.w_gate) + (size_t)layer * 1024 * DFF;
        prep_transpose_tile(src, 1024, DFF, (bf16_t*)(p.ws + OFF_WT_GU) + (size_t)layer * 5632 * 1024, tt / 44, tt % 44, 1 + isup, smem);
      } else {
        const int layer = w - 4;
        prep_transpose_tile(p.w_down + (size_t)layer * DFF * 1024, DFF, 1024, (bf16_t*)(p.ws + OFF_WT_DN) + (size_t)layer * 1024 * DFF, tt / 16, tt % 16, 0, smem);
      }
    } else if (item < D0) prep_s5_item(p, item - S0);
    else prep_dft_item(p, item - D0);
  }
}

__device__ void phase_norm(const Params& p, bool from_input, const float* gvec, const float* modbase  ) {
  const int lane = threadIdx.x & 63, wid = threadIdx.x >> 6;
  const float* X = (const float*)(p.ws + OFF_X);
  bf16_t* A = (bf16_t*)(p.ws + OFF_ABUF);
  for (int row = blockIdx.x * 4 + wid; row < NTOK; row += gridDim.x * 4) {
    const float* xr = from_input ? xin_row(p, row) : X + (size_t)row * DM;
    f32x4 v[4];
    float ss = 0.f;
#pragma unroll
    for (int i = 0; i < 4; ++i) {
      v[i] = *(const f32x4*)(xr + i * 256 + lane * 4);
#pragma unroll
      for (int e = 0; e < 4; ++e) ss += v[i][e] * v[i][e];
    }
#pragma unroll
    for (int o = 32; o >= 1; o >>= 1) ss += __shfl_xor(ss, o);
    const float rstd = rsqrtf(ss * (1.0f / DM) + 1e-6f);
    const float* mb = modbase + cond_index(row) * 6144;
#pragma unroll
    for (int i = 0; i < 4; ++i) {
      const int k = i * 256 + lane * 4;
      const f32x4 g = *(const f32x4*)(gvec + k), sh = *(const f32x4*)(mb + k), sc = *(const f32x4*)(mb + 1024 + k);
      float o[4];
#pragma unroll
      for (int e = 0; e < 4; ++e) o[e] = v[i][e] * rstd * g[e] * (1.0f + sc[e]) + sh[e];
      u32x2 w; w[0] = pack_bf16(o[0], o[1]); w[1] = pack_bf16(o[2], o[3]);
      *(u32x2*)(A + (size_t)row * DM + k) = w;
    }
  }
}
__device__ void phase_final_norm(const Params& p) {
  const int lane = threadIdx.x & 63, wid = threadIdx.x >> 6;
  const float* X = (const float*)(p.ws + OFF_X);
  for (int row = blockIdx.x * 4 + wid; row < NTOK; row += gridDim.x * 4) {
    const float* xr = X + (size_t)row * DM;
    f32x4 v[4];
    float ss = 0.f;
#pragma unroll
    for (int i = 0; i < 4; ++i) {
      v[i] = *(const f32x4*)(xr + i * 256 + lane * 4);
#pragma unroll
      for (int e = 0; e < 4; ++e) ss += v[i][e] * v[i][e];
    }
#pragma unroll
    for (int o = 32; o >= 1; o >>= 1) ss += __shfl_xor(ss, o);
    const float rstd = rsqrtf(ss * (1.0f / DM) + 1e-6f);
#pragma unroll
    for (int i = 0; i < 4; ++i) {
      const int k = i * 256 + lane * 4;
      const f32x4 g = *(const f32x4*)(p.final_g + k);
      f32x4 o;
#pragma unroll
      for (int e = 0; e < 4; ++e) o[e] = v[i][e] * rstd * g[e];
      *(f32x4*)(p.out + (size_t)row * DM + k) = o;
    }
  }
}

__device__ void attn_item(const Params& p, int item, char* smem) {
  const int tid = threadIdx.x, lane = tid & 63, wid = tid >> 6, lr = lane & 31, lh = lane >> 5;
  const bf16_t* QB = (const bf16_t*)(p.ws + OFF_QB);
  const bf16_t* KB = (const bf16_t*)(p.ws + OFF_KB);
  const bf16_t* VB = (const bf16_t*)(p.ws + OFF_VB);
  bf16_t* CAT = (bf16_t*)(p.ws + OFF_CAT);
  bool latent; int b, head, qrow0, nchunks, r0 = 0, rowstart = 0;
  if (item < 128) { latent = true; b = item >> 6; head = (item >> 3) & 7; const int rp = item & 7; r0 = rp * 2; qrow0 = NP + b * LS + r0 * 64; nchunks = 9;
    int rs0 = r0 - 4; rs0 = rs0 < 0 ? 0 : (rs0 > 8 ? 8 : rs0); rowstart = rs0 < 6 ? rs0 : 6; }
  else { latent = false; const int it = item - 128; b = it >> 4; head = (it >> 1) & 7; qrow0 = b * LP + (it & 1) * 128; nchunks = 2; }
  const int qrow = qrow0 + wid * 32 + lr;
  bf16x8 qf[4];
#pragma unroll
  for (int ks = 0; ks < 4; ++ks) qf[ks] = *(const bf16x8*)(QB + (size_t)qrow * 512 + head * 64 + ks * 16 + lh * 8);
  f32x16 o[2];
#pragma unroll
  for (int i = 0; i < 16; ++i) { o[0][i] = 0.f; o[1][i] = 0.f; }
  float mrun = -1e30f, lsum = 0.f;
  const int qr = r0 + (wid >> 1), qc = (wid & 1) * 32 + lr;
  int rs = qr - 4; rs = rs < 0 ? 0 : (rs > 8 ? 8 : rs);
  int cs = qc - 8; cs = cs < 0 ? 0 : (cs > 48 ? 48 : cs);
  char* Ks = smem;
  char* Vt = smem + 16384;
  const float LOG2E = 1.4426950408889634f;
  for (int c = 0; c < nchunks; ++c) {
    __syncthreads();
    const bool local = latent && c < 5;
    if (!latent || local) {
      const int krow0 = latent ? NP + b * LS + (rowstart + 2 * c) * 64 : b * LP + c * 128;
#pragma unroll
      for (int i = 0; i < 4; ++i) {
        const int idx = tid + 256 * i, key = idx >> 3, seg = idx & 7;
        const u32x4 v = *(const u32x4*)(KB + (size_t)(krow0 + key) * 512 + head * 64 + seg * 8);
        *(u32x4*)(Ks + key * 128 + ((seg ^ ((key >> 1) & 7)) << 4)) = v;
      }
#pragma unroll
      for (int i = 0; i < 2; ++i) {
        const int idx = tid + 256 * i, kp = idx >> 3, seg = idx & 7;
        const u32x4 v0 = *(const u32x4*)(VB + (size_t)(krow0 + 2 * kp) * 512 + head * 64 + seg * 8);
        const u32x4 v1 = *(const u32x4*)(VB + (size_t)(krow0 + 2 * kp + 1) * 512 + head * 64 + seg * 8);
#pragma unroll
        for (int j = 0; j < 4; ++j) {
          const unsigned lo = (v0[j] & 0xffffu) | (v1[j] << 16), hi = (v0[j] >> 16) | (v1[j] & 0xffff0000u);
          *(unsigned*)(Vt + (seg * 8 + 2 * j) * 272 + kp * 4) = lo;
          *(unsigned*)(Vt + (seg * 8 + 2 * j + 1) * 272 + kp * 4) = hi;
        }
      }
    } else {
      const int l0 = (c - 5) * 128;
      const float* ck = p.cache_k + ((size_t)b * 512 + l0) * 512 + head * 64;
      const float* cv = p.cache_v + ((size_t)b * 512 + l0) * 512 + head * 64;
#pragma unroll
      for (int i = 0; i < 4; ++i) {
        const int idx = tid + 256 * i, key = idx >> 3, seg = idx & 7;
        const f32x4 a = *(const f32x4*)(ck + (size_t)key * 512 + seg * 8), bq = *(const f32x4*)(ck + (size_t)key * 512 + seg * 8 + 4);
        *(u32x4*)(Ks + key * 128 + ((seg ^ ((key >> 1) & 7)) << 4)) = pack8(a, bq);
      }
#pragma unroll
      for (int i = 0; i < 2; ++i) {
        const int idx = tid + 256 * i, kp = idx >> 3, seg = idx & 7;
        const float* s0 = cv + (size_t)(2 * kp) * 512 + seg * 8;
        const float* s1 = s0 + 512;
#pragma unroll
        for (int h4 = 0; h4 < 2; ++h4) {
          const f32x4 a = *(const f32x4*)(s0 + 4 * h4), bq = *(const f32x4*)(s1 + 4 * h4);
#pragma unroll
          for (int e = 0; e < 4; ++e) *(unsigned*)(Vt + (seg * 8 + 4 * h4 + e) * 272 + kp * 4) = pack_bf16(a[e], bq[e]);
        }
      }
    }
    __syncthreads();
#pragma unroll 1
    for (int kt = 0; kt < 4; ++kt) {
      int kr = 0;
      if (local) {
        kr = rowstart + 2 * c + (kt >> 1);
        if (kr < rs || kr >= rs + 8) continue;
      }
      f32x16 st;
#pragma unroll
      for (int i = 0; i < 16; ++i) st[i] = 0.f;
#pragma unroll
      for (int ks = 0; ks < 4; ++ks) {
        const int row = kt * 32 + lr;
        const bf16x8 kf = *(const bf16x8*)(Ks + row * 128 + (((ks * 2 + lh) ^ ((row >> 1) & 7)) << 4));
        st = __builtin_amdgcn_mfma_f32_32x32x16_bf16(kf, qf[ks], st, 0, 0, 0);
      }
      float s2[16];
      float tmax = -1e30f;
      if (local) {
        const float* rp = p.na_rpb + ((size_t)head * 15 + (kr - qr + 7)) * 31;
#pragma unroll
        for (int i = 0; i < 16; ++i) {
          const int kc = (kt & 1) * 32 + 8 * (i >> 2) + 4 * lh + (i & 3);
          const bool valid = kc >= cs && kc < cs + 16;
          float sv = -1e30f;
          if (valid) sv = (st[i] * 0.125f + rp[kc - qc + 15]) * LOG2E;
          s2[i] = sv;
          tmax = fmaxf(tmax, sv);
        }
      } else {
#pragma unroll
        for (int i = 0; i < 16; ++i) { s2[i] = st[i] * (0.125f * LOG2E); tmax = fmaxf(tmax, s2[i]); }
      }
      tmax = fmaxf(tmax, xor32(tmax));
      const float mnew = fmaxf(mrun, tmax);
      const float alpha = __builtin_amdgcn_exp2f(mrun - mnew);
      mrun = mnew;
      float psum = 0.f;
#pragma unroll
      for (int i = 0; i < 16; ++i) { s2[i] = __builtin_amdgcn_exp2f(s2[i] - mnew); psum += s2[i]; }
      lsum = lsum * alpha + psum;
#pragma unroll
      for (int i = 0; i < 16; ++i) { o[0][i] *= alpha; o[1][i] *= alpha; }
#pragma unroll
      for (int s = 0; s < 2; ++s) {
        u32x4 pk;
        pk[0] = pack_bf16(s2[8 * s + 0], s2[8 * s + 1]); pk[1] = pack_bf16(s2[8 * s + 2], s2[8 * s + 3]);
        pk[2] = pack_bf16(s2[8 * s + 4], s2[8 * s + 5]); pk[3] = pack_bf16(s2[8 * s + 6], s2[8 * s + 7]);
        const bf16x8 pf = as_bf16x8(pk);
#pragma unroll
        for (int dt = 0; dt < 2; ++dt) {
          const char* vp = Vt + (dt * 32 + lr) * 272 + (kt * 32 + 16 * s + 4 * lh) * 2;
          const u32x2 a0 = *(const u32x2*)vp, a1 = *(const u32x2*)(vp + 16);
          u32x4 vv; vv[0] = a0[0]; vv[1] = a0[1]; vv[2] = a1[0]; vv[3] = a1[1];
          o[dt] = __builtin_amdgcn_mfma_f32_32x32x16_bf16(as_bf16x8(vv), pf, o[dt], 0, 0, 0);
        }
      }
    }
  }
  const float ltot = lsum + xor32(lsum);
  const float inv = 1.0f / ltot;
#pragma unroll
  for (int dt = 0; dt < 2; ++dt)
#pragma unroll
    for (int g = 0; g < 4; ++g) {
      const int d = dt * 32 + 8 * g + 4 * lh;
      u32x2 w; w[0] = pack_bf16(o[dt][4 * g] * inv, o[dt][4 * g + 1] * inv); w[1] = pack_bf16(o[dt][4 * g + 2] * inv, o[dt][4 * g + 3] * inv);
      *(u32x2*)(CAT + (size_t)qrow * DM + head * 64 + d) = w;
    }
}

__device__ void s5_wave(const Params& p, int rowbase, int L, int g, int d, const float* s0  , float* outstate  , char* xs  ) {
  const int lane = threadIdx.x & 63, lr = lane & 31, lh = lane >> 5;
  const float* U = (const float*)(p.ws + OFF_U);
  float* Y = (float*)(p.ws + (d ? OFF_YB : OFF_YF));
  const float* AR = (const float*)(p.ws + OFF_AR);
  const float* AI = (const float*)(p.ws + OFF_AI);
  const float* BB = (const float*)(p.ws + OFF_BBAR);
  const int dg = d * 32 + g;
  bf16x8 bfrag[4];
#pragma unroll
  for (int nb = 0; nb < 4; ++nb) {
    const int ri = nb >> 1, pb = nb & 1;
    const float* src = BB + ((size_t)(dg * 2 + ri) * 64 + pb * 32 + lr) * 16 + lh * 8;
    bfrag[nb] = as_bf16x8(pack8(*(const f32x4*)src, *(const f32x4*)(src + 4)));
  }
  bf16x8 cfrag[4];
  {
    const int hch = lane & 15, q4 = lane >> 4;
#pragma unroll
    for (int ks = 0; ks < 4; ++ks) {
      const int p0 = 16 * ks + 4 * q4;
      const f32x4 cr = *(const f32x4*)(p.c_re + ((size_t)dg * 16 + hch) * 64 + p0), ci = *(const f32x4*)(p.c_im + ((size_t)dg * 16 + hch) * 64 + p0);
      u32x4 t; t[0] = pack_bf16(cr[0], -ci[0]); t[1] = pack_bf16(cr[1], -ci[1]); t[2] = pack_bf16(cr[2], -ci[2]); t[3] = pack_bf16(cr[3], -ci[3]);
      cfrag[ks] = as_bf16x8(t);
    }
  }
  float apr[2][4], api[2][4], cr_[2], ci_[2];
#pragma unroll
  for (int pb = 0; pb < 2; ++pb) {
    const float ar = AR[dg * 64 + pb * 32 + lr], ai = AI[dg * 64 + pb * 32 + lr];
    apr[pb][0] = ar; api[pb][0] = ai;
#pragma unroll
    for (int j = 1; j < 4; ++j) { apr[pb][j] = apr[pb][j - 1] * ar - api[pb][j - 1] * ai; api[pb][j] = apr[pb][j - 1] * ai + api[pb][j - 1] * ar; }
    if (s0) { cr_[pb] = s0[((d * 2 + 0) * 32 + g) * 64 + pb * 32 + lr]; ci_[pb] = s0[((d * 2 + 1) * 32 + g) * 64 + pb * 32 + lr]; }
    else { cr_[pb] = 0.f; ci_[pb] = 0.f; }
  }
  const int nch = L >> 5;
#pragma unroll 1
  for (int c = 0; c < nch; ++c) {
    const int spos = c * 32 + lr;
    const int t = d ? L - 1 - spos : spos;
    const float* up = U + (size_t)(rowbase + t) * 512 + g * 16 + lh * 8;
    const bf16x8 uf = as_bf16x8(pack8(*(const f32x4*)up, *(const f32x4*)(up + 4)));
#pragma unroll
    for (int pb = 0; pb < 2; ++pb) {
      f32x16 xr, xi;
#pragma unroll
      for (int i = 0; i < 16; ++i) { xr[i] = 0.f; xi[i] = 0.f; }
      xr = __builtin_amdgcn_mfma_f32_32x32x16_bf16(uf, bfrag[pb], xr, 0, 0, 0);
      xi = __builtin_amdgcn_mfma_f32_32x32x16_bf16(uf, bfrag[2 + pb], xi, 0, 0, 0);
      const float a1r = apr[pb][0], a1i = api[pb][0], a4r = apr[pb][3], a4i = api[pb][3];
#pragma unroll
      for (int gq = 0; gq < 4; ++gq)
#pragma unroll
        for (int j = 1; j < 4; ++j) {
          const int i = 4 * gq + j;
          const float pr = xr[i - 1], pi = xi[i - 1];
          xr[i] += a1r * pr - a1i * pi;
          xi[i] += a1r * pi + a1i * pr;
        }
      float cinr[4], cini[4];
      float cr = cr_[pb], ci = ci_[pb];
#pragma unroll
      for (int gi = 0; gi < 8; ++gi) {
        const int i3 = 4 * (gi >> 1) + 3, owner = gi & 1;
        if (lh == owner) { cinr[gi >> 1] = cr; cini[gi >> 1] = ci; }
        const float candr = xr[i3] + a4r * cr - a4i * ci, candi = xi[i3] + a4r * ci + a4i * cr;
        cr = half_bcast(candr, owner);
        ci = half_bcast(candi, owner);
      }
      cr_[pb] = cr; ci_[pb] = ci;
#pragma unroll
      for (int gq = 0; gq < 4; ++gq)
#pragma unroll
        for (int j = 0; j < 4; ++j) {
          const int i = 4 * gq + j;
          const float vr = xr[i] + apr[pb][j] * cinr[gq] - api[pb][j] * cini[gq];
          const float vi = xi[i] + apr[pb][j] * cini[gq] + api[pb][j] * cinr[gq];
          const int m = 8 * gq + 4 * lh + j;
          *(unsigned*)(xs + m * 272 + (pb * 32 + lr) * 4) = pack_bf16(vr, vi);
        }
    }
    asm volatile("s_waitcnt lgkmcnt(0)" ::: "memory");
#pragma unroll
    for (int mt = 0; mt < 2; ++mt) {
      f32x4 ya = {0.f, 0.f, 0.f, 0.f};
#pragma unroll
      for (int ks = 0; ks < 4; ++ks) {
        const bf16x8 xf = *(const bf16x8*)(xs + (mt * 16 + (lane & 15)) * 272 + (32 * ks + 8 * (lane >> 4)) * 2);
        ya = __builtin_amdgcn_mfma_f32_16x16x32_bf16(xf, cfrag[ks], ya, 0, 0, 0);
      }
#pragma unroll
      for (int j = 0; j < 4; ++j) {
        const int sp = c * 32 + mt * 16 + (lane >> 4) * 4 + j;
        const int tt = d ? L - 1 - sp : sp;
        Y[(size_t)(rowbase + tt) * 512 + g * 16 + (lane & 15)] = ya[j];
      }
    }
    asm volatile("s_waitcnt lgkmcnt(0)" ::: "memory");
  }
  if (outstate && lh == 0) {
#pragma unroll
    for (int pb = 0; pb < 2; ++pb) {
      outstate[((d * 2 + 0) * 32 + g) * 64 + pb * 32 + lr] = cr_[pb];
      outstate[((d * 2 + 1) * 32 + g) * 64 + pb * 32 + lr] = ci_[pb];
    }
  }
}

__device__ void phase_mix0(const Params& p, char* smem) {
  const int wid = threadIdx.x >> 6;
  for (int item = blockIdx.x; item < 1184; item += gridDim.x) {
    if (item < 32) {
      const int b = item >> 4, g = (item & 15) * 2 + (wid >> 1), d = wid & 1;
      s5_wave(p, NP + b * LS, LS, g, d, p.state_s5 + (size_t)b * 8192, nullptr, smem + wid * 8704);
    } else if (item < 160) {
      attn_item(p, item - 32, smem);
    } else if (item < 672) {
      const int it = item - 160, b = it >> 4, g = (it & 15) * 2 + (wid >> 1), d = wid & 1;
      s5_wave(p, b * LP, LP, g, d, nullptr, p.out + (size_t)NTOK * DM + (size_t)2 * NP * 512 + (size_t)b * 8192, smem + wid * 8704);
    } else {
      attn_item(p, item - 672 + 128, smem);
    }
    __syncthreads();
  }
}

template <class AL, class EP>
__device__ __forceinline__ void gemm_phase(const AL& al, const bf16_t* Bt, int ldb, int K, int MT, int NT, const EP& ep, char* smem) {
  const int total = MT * NT;
  for (int t = blockIdx.x; t < total; t += gridDim.x) {
    const int nt = t % NT, mt = t / NT;
    gemm_tile(al, Bt, ldb, K, mt * 128, nt * 128, ep, smem);
  }
}

__global__ void __launch_bounds__(256, 2) mega(Params p, int ph_lo, int ph_hi) {
  __shared__ __attribute__((aligned(16))) char smem[65536];
  cg::grid_group grid = cg::this_grid();
  float* MOD = (float*)(p.ws + OFF_MOD);
  bf16_t* ABUF = (bf16_t*)(p.ws + OFF_ABUF);
  bf16_t* CAT = (bf16_t*)(p.ws + OFF_CAT);
  float* X = (float*)(p.ws + OFF_X);
  bf16_t* HFF = (bf16_t*)(p.ws + OFF_HFF);
  if (ph_lo <= 0 && 0 < ph_hi) {
    if (0 > ph_lo) grid.sync();
    { phase_prep(p, smem); }
  }
  if (ph_lo <= 1 && 1 < ph_hi) {
    if (1 > ph_lo) grid.sync();
    { phase_norm(p, true, p.norm_mix_g, MOD + 0 * 3 * 6144 + 0 * 1024); }
  }
  if (ph_lo <= 2 && 2 < ph_hi) {
    if (2 > ph_lo) grid.sync();
    {
        EpiInEven ep{(bf16_t*)(p.ws + OFF_QB), (bf16_t*)(p.ws + OFF_KB), (bf16_t*)(p.ws + OFF_VB), (float*)(p.ws + OFF_U),
                     p.out + (size_t)NTOK * DM, p.out + (size_t)NTOK * DM + (size_t)NP * 512};
        gemm_phase(ALoadPlain{ABUF, DM}, (const bf16_t*)(p.ws + OFF_WT_IN), DM, DM, NTOK / 128, 16, ep, smem);
      }
  }
  if (ph_lo <= 3 && 3 < ph_hi) {
    if (3 > ph_lo) grid.sync();
    { phase_mix0(p, smem); }
  }
  if (ph_lo <= 4 && 4 < ph_hi) {
    if (4 > ph_lo) grid.sync();
    {
        const float *YF = (const float*)(p.ws + OFF_YF), *YB = (const float*)(p.ws + OFF_YB), *U = (const float*)(p.ws + OFF_U);
        gemm_phase(ALoadGlu{YF, YB, U, p.s5_d}, (const bf16_t*)(p.ws + OFF_WT_GLU), 512, 512, NTOK / 128, 4, EpiGlu{YF, YB, U, p.s5_d, p.glu_b, CAT}, smem);
      }
  }
  if (ph_lo <= 5 && 5 < ph_hi) {
    if (5 > ph_lo) grid.sync();
    { gemm_phase(ALoadPlain{CAT, DM}, (const bf16_t*)(p.ws + OFF_WT_OUT), DM, DM, NTOK / 128, 8, EpiResid{p.x_prompt, p.x_sample, nullptr, true, X, MOD + 2 * 1024}, smem); }
  }
  if (ph_lo <= 6 && 6 < ph_hi) {
    if (6 > ph_lo) grid.sync();
    { phase_norm(p, false, p.norm_ffn_g, MOD + 3 * 1024); }
  }
  if (ph_lo <= 7 && 7 < ph_hi) {
    if (7 > ph_lo) grid.sync();
    { gemm_phase(ALoadPlain{ABUF, DM}, (const bf16_t*)(p.ws + OFF_WT_GU), DM, DM, NTOK / 128, 44, EpiSwiGLU{HFF}, smem); }
  }
  if (ph_lo <= 8 && 8 < ph_hi) {
    if (8 > ph_lo) grid.sync();
    { gemm_phase(ALoadPlain{HFF, DFF}, (const bf16_t*)(p.ws + OFF_WT_DN), DFF, DFF, NTOK / 128, 8, EpiResid{p.x_prompt, p.x_sample, X, false, X, MOD + 5 * 1024}, smem); }
  }
  if (ph_lo <= 9 && 9 < ph_hi) {
    if (9 > ph_lo) grid.sync();
    { phase_norm(p, false, p.norm_mix_g + DM, MOD + 3 * 6144 + 0); }
  }
  if (ph_lo <= 10 && 10 < ph_hi) {
    if (10 > ph_lo) grid.sync();
    { gemm_phase(ALoadPlain{ABUF, DM}, (const bf16_t*)(p.ws + OFF_WT_INO), DM, DM, NTOK / 128, 8, EpiBf16{(bf16_t*)(p.ws + OFF_Z), DM}, smem); }
  }
  if (ph_lo <= 11 && 11 < ph_hi) {
    if (11 > ph_lo) grid.sync();
    {
        const bf16_t* CS2 = (const bf16_t*)(p.ws + OFF_CS2);
        const bf16_t* Z = (const bf16_t*)(p.ws + OFF_Z);
        bf16_t* OT = (bf16_t*)(p.ws + OFF_OT);
        const int total = 128 * 8 + 8 * 32;
        for (int t = blockIdx.x; t < total; t += gridDim.x) {
          int bg, mt, nt, L, rowb; size_t obase;
          if (t < 1024) { bg = t >> 3; mt = (t >> 1) & 3; nt = t & 1; L = LP; rowb = (bg >> 2) * LP; obase = (size_t)bg * 512 * LP; }
          else { const int tt = t - 1024; bg = tt >> 5; mt = (tt >> 3) & 3; nt = tt & 7; L = LS; rowb = NP + (bg >> 2) * LS; obase = (size_t)128 * 512 * LP + (size_t)bg * 512 * LS; }
          gemm_tile(ALoadPlain{CS2, 256}, Z + (size_t)rowb * DM + (bg & 3) * 256, DM, 256, mt * 128, nt * 128, EpiBf16{OT + obase, L}, smem);
        }
      }
  }
  if (ph_lo <= 12 && 12 < ph_hi) {
    if (12 > ph_lo) grid.sync();
    {
        const bf16_t* OT = (const bf16_t*)(p.ws + OFF_OT);
        bf16_t* F = CAT;
        const int total = 128 + 512;
        for (int t = blockIdx.x; t < total; t += gridDim.x) {
          if (t < 128) {
            const int b = t >> 6, mt = (t >> 3) & 7, nt = t & 7;
            gemm_tile(ALoadPlain{(const bf16_t*)(p.ws + OFF_CL2S), 2048}, OT + (size_t)128 * 512 * LP + (size_t)b * 4 * 512 * LS, 2048, 2048, mt * 128, nt * 128,
                      EpiBf16{F + (size_t)(NP + b * LS) * DM, DM}, smem);
          } else {
            const int tt = t - 128, b = tt >> 4, mt = (tt >> 3) & 1, nt = tt & 7;
            gemm_tile(ALoadPlain{(const bf16_t*)(p.ws + OFF_CL2P), 512}, OT + (size_t)b * 4 * 512 * LP, 512, 512, mt * 128, nt * 128,
                      EpiBf16{F + (size_t)(b * LP) * DM, DM}, smem);
          }
        }
      }
  }
  if (ph_lo <= 13 && 13 < ph_hi) {
    if (13 > ph_lo) grid.sync();
    { gemm_phase(ALoadPlain{CAT, DM}, (const bf16_t*)(p.ws + OFF_WT_OUTO), DM, DM, NTOK / 128, 8, EpiResid{p.x_prompt, p.x_sample, X, false, X, MOD + 3 * 6144 + 2 * 1024}, smem); }
  }
  if (ph_lo <= 14 && 14 < ph_hi) {
    if (14 > ph_lo) grid.sync();
    { phase_norm(p, false, p.norm_ffn_g + DM, MOD + 3 * 6144 + 3 * 1024); }
  }
  if (ph_lo <= 15 && 15 < ph_hi) {
    if (15 > ph_lo) grid.sync();
    { gemm_phase(ALoadPlain{ABUF, DM}, (const bf16_t*)(p.ws + OFF_WT_GU) + (size_t)5632 * 1024, DM, DM, NTOK / 128, 44, EpiSwiGLU{HFF}, smem); }
  }
  if (ph_lo <= 16 && 16 < ph_hi) {
    if (16 > ph_lo) grid.sync();
    { gemm_phase(ALoadPlain{HFF, DFF}, (const bf16_t*)(p.ws + OFF_WT_DN) + (size_t)1024 * DFF, DFF, DFF, NTOK / 128, 8, EpiResid{p.x_prompt, p.x_sample, X, false, X, MOD + 3 * 6144 + 5 * 1024}, smem); }
  }
  if (ph_lo <= 17 && 17 < ph_hi) {
    if (17 > ph_lo) grid.sync();
    { phase_final_norm(p); }
  }
}

extern "C" void kernel_launch(void* const* d_in, const int* in_sizes, int n_in, void* d_out, int out_size, void* d_ws, size_t ws_size, hipStream_t stream) {
  static int grid_blocks = 0;
  if (!grid_blocks) {
    int dev = 0, cus = 0, per_cu = 0;
    hipGetDevice(&dev);
    hipDeviceGetAttribute(&cus, hipDeviceAttributeMultiprocessorCount, dev);
    hipOccupancyMaxActiveBlocksPerMultiprocessor(&per_cu, mega, 256, 0);
    if (per_cu > 2) per_cu = 2;
    if (per_cu < 1) per_cu = 1;
    grid_blocks = cus * per_cu;
  }
  if (ws_size < WS_NEED) { fprintf(stderr, "workspace too small: %zu < %zu\n", ws_size, (size_t)WS_NEED); return; }
  Params p{};
  const float** pp = (const float**)&p;
  for (int i = 0; i < 30; ++i) pp[i] = (const float*)d_in[i];
  p.out = (float*)d_out;
  p.ws = (char*)d_ws;
#if N_LAUNCH_MODE == 1
  int lo = 0, hi = NPHASE;
  void* args[] = {&p, &lo, &hi};
  hipError_t e = hipLaunchCooperativeKernel((void*)mega, dim3(grid_blocks), dim3(256), args, 0, stream);
  if (e != hipSuccess) fprintf(stderr, "cooperative launch failed: %s (grid %d)\n", hipGetErrorString(e), grid_blocks);
#else
  for (int ph = 0; ph < NPHASE; ++ph) {
    int lo = ph, hi = ph + 1;
    void* args[] = {&p, &lo, &hi};
    hipLaunchCooperativeKernel((void*)mega, dim3(grid_blocks), dim3(256), args, 0, stream);
  }
#endif
}
```

```cpp
#include <hip/hip_runtime.h>
#include <cstdio>

typedef unsigned short bf16_t;
typedef short bf16x8 __attribute__((ext_vector_type(8)));
typedef float f32x4 __attribute__((ext_vector_type(4)));
typedef float f32x16 __attribute__((ext_vector_type(16)));
typedef unsigned u32x4 __attribute__((ext_vector_type(4)));
typedef unsigned u32x2 __attribute__((ext_vector_type(2)));

#ifndef N_LAUNCH_MODE
#define N_LAUNCH_MODE 1
#endif

constexpr int DM = 1024, NP = 8192, NL = 2048, NTOK = NP + NL, LP = 256, LS = 1024;
constexpr int DFF = 2816, NAW = 512, S5W = 512;
constexpr int NPHASE = 18;

constexpr size_t al256(size_t x) { return (x + 255) & ~(size_t)255; }
constexpr size_t OFF_MOD = 0;
constexpr size_t OFF_AR = al256(OFF_MOD + 2 * 3 * 6144 * 4);
constexpr size_t OFF_AI = al256(OFF_AR + 4096 * 4);
constexpr size_t OFF_BBAR = al256(OFF_AI + 4096 * 4);
constexpr size_t OFF_WT_IN = al256(OFF_BBAR + 131072 * 4);
constexpr size_t OFF_WT_GLU = al256(OFF_WT_IN + 2048 * 1024 * 2);
constexpr size_t OFF_WT_OUT = al256(OFF_WT_GLU + 512 * 512 * 2);
constexpr size_t OFF_WT_INO = al256(OFF_WT_OUT + 1024 * 1024 * 2);
constexpr size_t OFF_WT_OUTO = al256(OFF_WT_INO + 1024 * 1024 * 2);
constexpr size_t OFF_WT_GU = al256(OFF_WT_OUTO + 1024 * 1024 * 2);
constexpr size_t OFF_WT_DN = al256(OFF_WT_GU + (size_t)2 * 5632 * 1024 * 2);
constexpr size_t OFF_CS2 = al256(OFF_WT_DN + (size_t)2 * 1024 * 2816 * 2);
constexpr size_t OFF_CL2P = al256(OFF_CS2 + 512 * 256 * 2);
constexpr size_t OFF_CL2S = al256(OFF_CL2P + 256 * 512 * 2);
constexpr size_t OFF_ABUF = al256(OFF_CL2S + 1024 * 2048 * 2);
constexpr size_t OFF_CAT = al256(OFF_ABUF + (size_t)NTOK * 1024 * 2);
constexpr size_t OFF_X = al256(OFF_CAT + (size_t)NTOK * 1024 * 2);
constexpr size_t OFF_POOL = al256(OFF_X + (size_t)NTOK * 1024 * 4);
constexpr size_t OFF_QB = OFF_POOL;
constexpr size_t OFF_KB = OFF_QB + (size_t)NTOK * 512 * 2;
constexpr size_t OFF_VB = OFF_KB + (size_t)NTOK * 512 * 2;
constexpr size_t OFF_U = OFF_VB + (size_t)NTOK * 512 * 2;
constexpr size_t OFF_YF = OFF_U + (size_t)NTOK * 512 * 4;
constexpr size_t OFF_YB = OFF_YF + (size_t)NTOK * 512 * 4;
constexpr size_t POOL_END0 = OFF_YB + (size_t)NTOK * 512 * 4;
constexpr size_t OFF_HFF = OFF_POOL;
constexpr size_t OFF_Z = OFF_POOL;
constexpr size_t OFF_OT = OFF_Z + (size_t)NTOK * 1024 * 2;
constexpr size_t OFF_YBF = POOL_END0;
constexpr size_t OFF_BAR = al256(OFF_YBF + (size_t)NTOK * 512 * 2);
constexpr size_t OFF_SUMSQ = OFF_BAR + 16384;
constexpr size_t OFF_PCNT = OFF_SUMSQ + (size_t)4 * NTOK * 4;
constexpr size_t ZERO_BYTES = 16384 + (size_t)4 * NTOK * 4 + 40 * 256;
constexpr size_t OFF_GS = al256(OFF_PCNT + 40 * 256);
constexpr size_t OFF_SHWGU = al256(OFF_GS + 3 * 3 * 1024 * 4);
constexpr size_t OFF_SHWINO = al256(OFF_SHWGU + 2 * 3 * 5632 * 4);
constexpr size_t WS_NEED = al256(OFF_SHWINO + 3 * 1024 * 4);
static_assert(WS_NEED <= (size_t)256 * 1024 * 1024, "workspace");

struct Params {
  const float *x_prompt, *x_sample, *cache_k, *cache_v, *state_s5, *c, *c_ctx, *w_mod, *b_mod, *norm_mix_g, *norm_ffn_g,
      *w_in_even, *na_rpb, *lam_re, *lam_im, *log_step, *b_re, *b_im, *c_re, *c_im, *s5_d, *glu_w, *glu_b, *w_out_even,
      *w_in_odd, *w_out_odd, *w_gate, *w_up, *w_down, *final_g;
  float* out;
  char* ws;
};

typedef __bf16 bf16v2_t __attribute__((ext_vector_type(2)));
__device__ __forceinline__ unsigned pack_bf16(float lo, float hi) {
  bf16v2_t v = {(__bf16)lo, (__bf16)hi};
  return __builtin_bit_cast(unsigned, v);
}
__device__ __forceinline__ float bf2f(unsigned short h) { return __uint_as_float(((unsigned)h) << 16); }
__device__ __forceinline__ u32x4 pack8(f32x4 a, f32x4 b) {
  u32x4 r;
  r[0] = pack_bf16(a[0], a[1]); r[1] = pack_bf16(a[2], a[3]); r[2] = pack_bf16(b[0], b[1]); r[3] = pack_bf16(b[2], b[3]);
  return r;
}
__device__ __forceinline__ bf16x8 as_bf16x8(u32x4 v) { return __builtin_bit_cast(bf16x8, v); }
__device__ __forceinline__ float sigmoidf_(float x) { return 1.0f / (1.0f + __expf(-x)); }
__device__ __forceinline__ float siluf_(float x) { return x * sigmoidf_(x); }
__device__ __forceinline__ float gelu_tanh(float x) {
  const float u = 0.7978845608028654f * (x + 0.044715f * x * x * x);
  const float t = 1.0f - 2.0f / (1.0f + __expf(2.0f * u));
  return 0.5f * x * (1.0f + t);
}
__device__ __forceinline__ float half_bcast(float x, int which) {
  auto r = __builtin_amdgcn_permlane32_swap(__float_as_uint(x), __float_as_uint(x), false, false);
  return __uint_as_float(which ? r[1] : r[0]);
}
__device__ __forceinline__ float xor32(float x) {
  auto r = __builtin_amdgcn_permlane32_swap(__float_as_uint(x), __float_as_uint(x), false, false);
  return (threadIdx.x & 32) ? __uint_as_float(r[0]) : __uint_as_float(r[1]);
}
__device__ __forceinline__ int opaque_tid() { int t = threadIdx.x; asm volatile("" : "+v"(t)); return t; }
__device__ __forceinline__ int cond_index(int row) { return row < NP ? 0 : 1 + ((row - NP) >> 10); }
__device__ __forceinline__ const float* xin_row(const Params& p, int row) {
  return row < NP ? p.x_prompt + (size_t)row * DM : p.x_sample + (size_t)(row - NP) * DM;
}

#define LAS __attribute__((address_space(3)))
#define XB_TMO      128
#define XB_XCNT(j)  (256  + 64 * (j))
#define XB_XSUB(j)  (1280 + 64 * (j))
#define XB_XGEN(j)  (2304 + 64 * (j))
#define XB_TOP      3328
#define XB_TOPGEN   3392
#define XCD_BAR_WORDS 3456
#define XB_SPIN_CAP (1u << 22)
__device__ __forceinline__ unsigned xb_ld(unsigned* p)              { return __hip_atomic_load(p, __ATOMIC_RELAXED, __HIP_MEMORY_SCOPE_AGENT); }
__device__ __forceinline__ unsigned xb_add(unsigned* p, unsigned v) { return __hip_atomic_fetch_add(p, v, __ATOMIC_RELAXED, __HIP_MEMORY_SCOPE_AGENT); }
__device__ __forceinline__ unsigned xb_xcc_id() { return (unsigned)__builtin_amdgcn_s_getreg((3 << 11) | 20) & 0xFu; }
#define XB_SPIN(cond, bar) do { unsigned _sp = 0; while (cond) { __builtin_amdgcn_s_sleep(1); \
    if ((++_sp & 255u) == 0u) { if (xb_ld(&(bar)[XB_TMO])) break; if (_sp > XB_SPIN_CAP) { atomicAdd(&(bar)[XB_TMO], 1u); break; } } } } while (0)
struct XcdBarrier { unsigned* bar; unsigned x; volatile LAS unsigned* st; };
__device__ __forceinline__ XcdBarrier xcd_barrier_post(unsigned* bar, volatile LAS unsigned* st) {
  XcdBarrier b; b.bar = bar; b.x = xb_xcc_id(); b.st = st;
  if (threadIdx.x == 0) (void)xb_add(&bar[XB_XCNT(b.x)], 1u);
  return b;
}
__device__ __forceinline__ void xcd_barrier_complete(unsigned* bar, unsigned x, unsigned& nloc, unsigned& nx) {
  const unsigned G = gridDim.x * gridDim.y * gridDim.z;
  unsigned sum, cnt, mine, sp = 0u;
  for (;;) {
    sum = 0u; cnt = 0u; mine = 0u;
#pragma unroll
    for (unsigned j = 0; j < 16; ++j) { const unsigned c = xb_ld(&bar[XB_XCNT(j)]); sum += c; cnt += (c > 0u) ? 1u : 0u; mine = (j == x) ? c : mine; }
    if (sum == G) break;
    __builtin_amdgcn_s_sleep(1);
    if ((++sp & 255u) == 0u) { if (xb_ld(&bar[XB_TMO])) break; if (sp > XB_SPIN_CAP) { atomicAdd(&bar[XB_TMO], 1u); break; } }
  }
  nloc = mine > 0u ? mine : 1u; nx = cnt > 0u ? cnt : 1u;
}
__device__ __forceinline__ void xcd_barrier(const XcdBarrier& b) {
  asm volatile("s_waitcnt vmcnt(0)" ::: "memory");
  __syncthreads();
  if (threadIdx.x == 0) {
    unsigned* bar = b.bar;
    __builtin_amdgcn_s_waitcnt(0);
    unsigned nloc = b.st[0], nx = b.st[1];
    if (nloc == 0u) { xcd_barrier_complete(bar, b.x, nloc, nx); b.st[0] = nloc; b.st[1] = nx; }
    const unsigned old = xb_add(&bar[XB_XSUB(b.x)], 1u);
    const unsigned gen = old / nloc;
    if (old + 1u == (gen + 1u) * nloc) {
      __builtin_amdgcn_fence(__ATOMIC_RELEASE, "agent");
      asm volatile("s_waitcnt vmcnt(0)" ::: "memory");
      const unsigned og = xb_add(&bar[XB_TOP], 1u);
      const unsigned tg = og / nx;
      if (og + 1u == (tg + 1u) * nx) xb_add(&bar[XB_TOPGEN], 1u);
      else XB_SPIN(xb_ld(&bar[XB_TOPGEN]) == tg, bar);
      __builtin_amdgcn_fence(__ATOMIC_ACQUIRE, "agent");
      xb_add(&bar[XB_XGEN(b.x)], 1u);
      asm volatile("s_waitcnt vmcnt(0)" ::: "memory");
    } else {
      XB_SPIN(xb_ld(&bar[XB_XGEN(b.x)]) == gen, bar);
      __builtin_amdgcn_fence(__ATOMIC_ACQUIRE, "agent");
      asm volatile("s_waitcnt vmcnt(0)" ::: "memory");
    }
  }
  __syncthreads();
}

constexpr int G8_HTB = 128 * 64 * 2;
__device__ __forceinline__ int lds_byte(int r, int c) { const int st = (r >> 4) * 2 + (c >> 5), rr = r & 15, cc = c & 31, ob = rr * 64 + cc * 2; return st * 1024 + (ob ^ (((ob >> 9) & 1) << 5)); }
__device__ __forceinline__ void stage_rc(int b, int& R, int& C) { const int st = b / 1024, sb = b % 1024, swz = sb ^ (((sb >> 9) & 1) << 5); R = (st >> 1) * 16 + swz / 64; C = (st & 1) * 32 + (swz % 64) / 2; }
struct Unit { const char* a; const char* b; size_t cbase; int ldc; int pm, pn; int row0; };

template <bool HALF_M = false, class Epi, class Sched>
__device__ __forceinline__ void gemm8(LAS unsigned char* lds, int K, int lda, int ldb, const Sched& S, const Epi& E) {
  const int tid = opaque_tid(), wid = __builtin_amdgcn_readfirstlane(tid >> 6), lane = tid & 63, wr = wid >> 2, wc = wid & 3, fr = lane & 15, fq = lane >> 4;
  const int nt = K / 64;
  unsigned voffA[2], voffB[2];
#pragma unroll
  for (int i = 0; i < 2; ++i) { int R, C; stage_rc(tid * 16 + i * 8192, R, C);
    const int rho = R & 31, Rb = Epi::PERM ? ((R & ~31) + 8 * ((rho & 15) >> 2) + 4 * (rho >> 4) + (rho & 3)) : R;
    voffA[i] = (unsigned)(R * lda + C) * 2u; voffB[i] = (unsigned)(Rb * ldb + C) * 2u; }
  const size_t kstep = 128;
  const size_t hstepA = (size_t)128 * lda * 2, hstepB = (size_t)128 * ldb * 2;
  const unsigned ldsw = (unsigned)wid * 1024u;
  const int aoff = lds_byte(wr * 64 + fr, fq * 8), boff = lds_byte(wc * 32 + fr, fq * 8);
#define G8_SA(b, h) (((b) * 2 + (h)) * G8_HTB)
#define G8_SB(b, h) ((4 + (b) * 2 + (h)) * G8_HTB)
#define G8_STAGE(bufoff, gbase, voff) do { _Pragma("unroll") for (int _i = 0; _i < 2; ++_i) \
    __builtin_amdgcn_global_load_lds((const unsigned*)((const char*)(gbase) + (voff)[_i]), (LAS unsigned*)(lds + (bufoff) + ldsw + _i * 8192), 16, 0, 0); } while (0)
#define G8_LDA(dst, b, h) do { _Pragma("unroll") for (int m = 0; m < 4; ++m) _Pragma("unroll") for (int k = 0; k < 2; ++k) dst[m][k] = *(const LAS bf16x8*)(lds + G8_SA(b, h) + aoff + m * 2048 + k * 1024); } while (0)
#define G8_LDB(dst, b, h) do { _Pragma("unroll") for (int n = 0; n < 2; ++n) _Pragma("unroll") for (int k = 0; k < 2; ++k) dst[n][k] = *(const LAS bf16x8*)(lds + G8_SB(b, h) + boff + n * 2048 + k * 1024); } while (0)
#define G8_MMA(ai, bj, At, Bt) do { __builtin_amdgcn_s_setprio(1); _Pragma("unroll") for (int m = 0; m < 4; ++m) _Pragma("unroll") for (int n = 0; n < 2; ++n) _Pragma("unroll") for (int k = 0; k < 2; ++k) \
    acc[ai][bj][m][n] = __builtin_amdgcn_mfma_f32_16x16x32_bf16(Bt[n][k], At[m][k], acc[ai][bj][m][n], 0, 0, 0); __builtin_amdgcn_s_setprio(0); } while (0)
#define G8_WAIT_V(n) asm volatile("s_waitcnt vmcnt(" #n ")" ::: "memory")
#define G8_WAIT_L(n) asm volatile("s_waitcnt lgkmcnt(" #n ")" ::: "memory")
#define G8_BAR __builtin_amdgcn_s_barrier()
#define G8_SCHED __builtin_amdgcn_sched_barrier(0)
  Unit cur, nxt; int ui = 0;
  if (!S.next(0, cur)) return;
  f32x4 acc[2][2][4][2];
#pragma unroll
  for (int a = 0; a < 2; ++a)
#pragma unroll
    for (int b = 0; b < 2; ++b)
#pragma unroll
      for (int m = 0; m < 4; ++m)
#pragma unroll
        for (int n = 0; n < 2; ++n) acc[a][b][m][n] = (f32x4){0.f, 0.f, 0.f, 0.f};
  bf16x8 At[4][2], B0[2][2], B1[2][2];
  const char* cA = cur.a; const char* cB = cur.b;
  G8_STAGE(G8_SB(0, 0), cB, voffB); G8_STAGE(G8_SA(0, 0), cA, voffA); G8_STAGE(G8_SB(0, 1), cB + hstepB, voffB); G8_STAGE(G8_SA(0, 1), cA + hstepA, voffA);
  if (wr == 1) G8_BAR;
  G8_WAIT_V(4); G8_BAR;
  G8_STAGE(G8_SB(1, 0), cB + kstep, voffB); G8_STAGE(G8_SA(1, 0), cA + kstep, voffA); G8_STAGE(G8_SB(1, 1), cB + hstepB + kstep, voffB);
  G8_WAIT_V(6); G8_BAR;
  for (;;) {
    const bool has_next = S.next(ui + 1, nxt);
    const char* nA = has_next ? nxt.a : cA; const char* nB = has_next ? nxt.b : cB;
    for (int t = 0; t < nt; t += 2) {
      const bool last = (t == nt - 2);
      const char* a1 = cA + (size_t)(t + 1) * kstep;
      const char* a2 = last ? nA : cA + (size_t)(t + 2) * kstep; const char* b2 = last ? nB : cB + (size_t)(t + 2) * kstep;
      const char* a3 = a2 + kstep; const char* b3 = b2 + kstep;
      G8_LDB(B0, 0, 0); G8_SCHED; G8_LDA(At, 0, 0); G8_STAGE(G8_SA(1, 1), a1 + hstepA, voffA);
      G8_WAIT_L(8); G8_BAR; G8_WAIT_L(0); G8_MMA(0, 0, At, B0); G8_BAR; G8_SCHED;
      G8_LDB(B1, 0, 1); G8_STAGE(G8_SB(0, 0), b2, voffB);
      G8_BAR; G8_WAIT_L(0); G8_MMA(0, 1, At, B1); G8_BAR;
      if constexpr (!HALF_M) { G8_LDA(At, 0, 1); } G8_STAGE(G8_SA(0, 0), a2, voffA);
      G8_BAR; G8_WAIT_L(0); if constexpr (!HALF_M) { G8_MMA(1, 0, At, B0); } G8_BAR; G8_SCHED;
      G8_STAGE(G8_SB(0, 1), b2 + hstepB, voffB);
      G8_WAIT_V(6); G8_BAR; if constexpr (!HALF_M) { G8_MMA(1, 1, At, B1); } G8_BAR;
      G8_LDB(B0, 1, 0); G8_SCHED; G8_LDA(At, 1, 0); G8_STAGE(G8_SA(0, 1), a2 + hstepA, voffA);
      G8_WAIT_L(8); G8_BAR; G8_WAIT_L(0); G8_MMA(0, 0, At, B0); G8_BAR; G8_SCHED;
      G8_LDB(B1, 1, 1); G8_STAGE(G8_SB(1, 0), b3, voffB);
      G8_BAR; G8_WAIT_L(0); G8_MMA(0, 1, At, B1); G8_BAR;
      if constexpr (!HALF_M) { G8_LDA(At, 1, 1); } G8_STAGE(G8_SA(1, 0), a3, voffA);
      G8_BAR; G8_WAIT_L(0); if constexpr (!HALF_M) { G8_MMA(1, 0, At, B0); } G8_BAR; G8_SCHED;
      G8_STAGE(G8_SB(1, 1), b3 + hstepB, voffB);
      G8_WAIT_V(6); G8_BAR; if constexpr (!HALF_M) { G8_MMA(1, 1, At, B1); } G8_BAR;
    }
    if constexpr (!Epi::AFTER_DRAIN) E(acc, cur, wr, wc, fr, fq);
    if (!has_next) break;
#pragma unroll
    for (int a = 0; a < 2; ++a)
#pragma unroll
      for (int b = 0; b < 2; ++b)
#pragma unroll
        for (int m = 0; m < 4; ++m)
#pragma unroll
          for (int n = 0; n < 2; ++n) acc[a][b][m][n] = (f32x4){0.f, 0.f, 0.f, 0.f};
    cur = nxt; cA = nA; cB = nB; ++ui;
  }
  G8_WAIT_V(0);
  if (wr == 0) G8_BAR;
  G8_BAR;
  if constexpr (Epi::AFTER_DRAIN) E(acc, cur, wr, wc, fr, fq);
#undef G8_SA
#undef G8_SB
#undef G8_STAGE
#undef G8_LDA
#undef G8_LDB
#undef G8_MMA
#undef G8_WAIT_V
#undef G8_WAIT_L
#undef G8_BAR
#undef G8_SCHED
}

struct SchedFlat {
  const char *A, *B; size_t atstep, btstep; int ldc; int nM, nN, nwg, G, c, limit;
  __device__ __forceinline__ void init(const bf16_t* A_, int lda, const bf16_t* B_, int ldb, int M, int N, int ldc_) {
    A = (const char*)A_; B = (const char*)B_; atstep = (size_t)256 * lda * 2; btstep = (size_t)256 * ldb * 2; ldc = ldc_;
    nM = M / 256; nN = N / 256; nwg = nM * nN; G = gridDim.x; c = blockIdx.x; limit = nwg;
  }
  __device__ __forceinline__ void unit_at(int L, Unit& u) const {
    int wgid = L; { const int q = nwg / 8, r = nwg % 8, xcd = wgid % 8, off = wgid / 8; wgid = (xcd < r ? xcd * (q + 1) : r * (q + 1) + (xcd - r) * q) + off; }
    const int nig = 8 * nN, gid = wgid / nig, fm = gid * 8, gsz = (nM - fm) < 8 ? (nM - fm) : 8;
    u.pm = fm + ((wgid % nig) % gsz); u.pn = (wgid % nig) / gsz;
    u.a = A + (size_t)u.pm * atstep; u.b = B + (size_t)u.pn * btstep; u.ldc = ldc; u.cbase = (size_t)u.pm * 256 * ldc + (size_t)u.pn * 256; u.row0 = u.pm * 256;
  }
  __device__ __forceinline__ bool next(int i, Unit& u) const {
    const long L = (long)i * G + c; if (L >= limit) return false;
    unit_at((int)L, u);
    return true;
  }
};
struct SchedFlatTail {
  SchedFlat f; int first;
  __device__ __forceinline__ bool next(int i, Unit& u) const {
    const int Lh = i * f.G + f.c; if (Lh >= 2 * (f.nwg - first)) return false;
    f.unit_at(first + (Lh >> 1), u);
    if (Lh & 1) { u.a += f.atstep / 2; u.row0 += 128; u.cbase += (size_t)128 * f.ldc; }
    return true;
  }
};
struct SchedF1 {
  const char *CS2, *Z; int G, c;
  __device__ __forceinline__ bool next(int i, Unit& u) const {
    const int L = i * G + c; if (L >= 320) return false;
    int bg, pm, pn, Lseq, rowb; size_t obase;
    if (L < 256) { bg = L >> 1; pm = L & 1; pn = 0; Lseq = LP; rowb = (bg >> 2) * LP; obase = (size_t)bg * 512 * LP; }
    else { const int t = L - 256; bg = t >> 3; pm = (t >> 2) & 1; pn = t & 3; Lseq = LS; rowb = NP + (bg >> 2) * LS; obase = (size_t)128 * 512 * LP + (size_t)bg * 512 * LS; }
    u.pm = pm; u.pn = pn; u.ldc = Lseq;
    u.a = CS2 + (size_t)pm * 256 * 256 * 2;
    u.b = Z + ((size_t)(rowb + pn * 256) * DM + (bg & 3) * 256) * 2;
    u.cbase = obase + (size_t)pm * 256 * Lseq + (size_t)pn * 256;
    return true;
  }
};
struct SchedF2P {
  const char *CL, *OT; int c;
  __device__ __forceinline__ bool next(int i, Unit& u) const {
    if (i > 0 || c >= 128) return false;
    const int b = c >> 2, pn = c & 3;
    u.pm = 0; u.pn = pn; u.ldc = DM;
    u.a = CL; u.b = OT + ((size_t)b * 4 * 512 * LP + (size_t)pn * 256 * 512) * 2;
    u.cbase = (size_t)(b * LP) * DM + (size_t)pn * 256;
    return true;
  }
};
struct SchedF2S {
  const char *CL, *OT; int c;
  __device__ __forceinline__ bool next(int i, Unit& u) const {
    const int t = c - 128;
    if (i > 0 || t < 0 || t >= 64) return false;
    const int b = t >> 5, ph = (t >> 2) & 7, pn = t & 3;
    u.pm = ph; u.pn = pn; u.ldc = DM;
    u.a = CL + (size_t)ph * 128 * 2048 * 2;
    u.b = OT + ((size_t)128 * 512 * LP + (size_t)b * 4 * 512 * LS + (size_t)pn * 256 * 2048) * 2;
    u.cbase = (size_t)(NP + b * LS + ph * 128) * DM + (size_t)pn * 256;
    return true;
  }
};

template <bool PERMC = false, class F>
__device__ __forceinline__ void epi_foreach(const f32x4 (&acc)[2][2][4][2], int wr, int wc, int fr, int fq, const F& f) {
#pragma unroll
  for (int ai = 0; ai < 2; ++ai)
#pragma unroll
    for (int m = 0; m < 4; ++m)
#pragma unroll
      for (int bj = 0; bj < 2; ++bj)
#pragma unroll
        for (int n = 0; n < 2; ++n) f(128 * ai + 64 * wr + 16 * m + fr, PERMC ? 128 * bj + 32 * wc + 8 * fq + 4 * n : 128 * bj + 32 * wc + 16 * n + 4 * fq, acc[ai][bj][m][n]);
}
struct EpiBf16 {
  static constexpr bool AFTER_DRAIN = false, PERM = true;
  bf16_t* C;
  __device__ __forceinline__ void operator()(const f32x4 (&acc)[2][2][4][2], const Unit& u, int wr, int wc, int fr, int fq) const {
    bf16_t* base = C + u.cbase; const int ldc = u.ldc;
#pragma unroll
    for (int ai = 0; ai < 2; ++ai)
#pragma unroll
      for (int m = 0; m < 4; ++m)
#pragma unroll
        for (int bj = 0; bj < 2; ++bj) {
          const f32x4 v0 = acc[ai][bj][m][0], v1 = acc[ai][bj][m][1];
          u32x4 o; o[0] = pack_bf16(v0[0], v0[1]); o[1] = pack_bf16(v0[2], v0[3]); o[2] = pack_bf16(v1[0], v1[1]); o[3] = pack_bf16(v1[2], v1[3]);
          *(u32x4*)(base + (size_t)(128 * ai + 64 * wr + 16 * m + fr) * ldc + 128 * bj + 32 * wc + 8 * fq) = o;
        }
  }
};
struct EpiBf16Half {
  static constexpr bool AFTER_DRAIN = false, PERM = false;
  bf16_t* C;
  __device__ __forceinline__ void operator()(const f32x4 (&acc)[2][2][4][2], const Unit& u, int wr, int wc, int fr, int fq) const {
    bf16_t* base = C + u.cbase; const int ldc = u.ldc;
#pragma unroll
    for (int m = 0; m < 4; ++m)
#pragma unroll
      for (int bj = 0; bj < 2; ++bj)
#pragma unroll
        for (int n = 0; n < 2; ++n) {
          const f32x4 v = acc[0][bj][m][n];
          u32x2 o; o[0] = pack_bf16(v[0], v[1]); o[1] = pack_bf16(v[2], v[3]);
          *(u32x2*)(base + (size_t)(64 * wr + 16 * m + fr) * ldc + 128 * bj + 32 * wc + 16 * n + 4 * fq) = o;
        }
  }
};
struct EpiInEven {
  static constexpr bool AFTER_DRAIN = false, PERM = true;
  bf16_t *Q, *Kb, *Vb; float *U, *outk, *outv;
  __device__ __forceinline__ void operator()(const f32x4 (&acc)[2][2][4][2], const Unit& u, int wr, int wc, int fr, int fq) const {
    const int region = u.pn >> 1, cb = (u.pn & 1) * 256, rb = u.pm * 256;
    epi_foreach<true>(acc, wr, wc, fr, fq, [&](int r, int c, f32x4 v) {
      const int row = rb + r, col = cb + c;
      if (region == 3) {
        { u32x2 uw; uw[0] = pack_bf16(v[0], v[1]); uw[1] = pack_bf16(v[2], v[3]); *(u32x2*)((bf16_t*)U + (size_t)(col >> 4) * ((size_t)NTOK * 16) + (size_t)row * 16 + (col & 15)) = uw; }
      } else {
        u32x2 o; o[0] = pack_bf16(v[0], v[1]); o[1] = pack_bf16(v[2], v[3]);
        bf16_t* dst = region == 0 ? Q : (region == 1 ? Kb : Vb);
        *(u32x2*)(dst + (size_t)row * 512 + col) = o;
        if (region != 0 && row < NP) {
          float* od = region == 1 ? outk : outv;
          *(f32x4*)(od + (size_t)row * 512 + col) = v;
        }
      }
    });
  }
};
struct EpiResid {
  static constexpr bool AFTER_DRAIN = false, PERM = true;
  const float *xp, *xs; const bf16_t* Xin; bool from_input; bf16_t* Xout; const float* gate;
  bf16_t* AB; const float* gs; float* sumsq;
  __device__ __forceinline__ void operator()(const f32x4 (&acc)[2][2][4][2], const Unit& u, int wr, int wc, int fr, int fq) const {
    const int rb = u.pm * 256, cb = u.pn * 256;
    const int ci = cond_index(rb);
    const int c0 = cb + 32 * wc + 8 * fq;
    f32x4 gt[2][2], g4[2][2];
#pragma unroll
    for (int bj = 0; bj < 2; ++bj)
#pragma unroll
      for (int n = 0; n < 2; ++n) {
        gt[bj][n] = *(const f32x4*)(gate + ci * 6144 + c0 + 128 * bj + 4 * n);
        g4[bj][n] = AB ? *(const f32x4*)(gs + ci * 1024 + c0 + 128 * bj + 4 * n) : (f32x4){0.f, 0.f, 0.f, 0.f};
      }
    const float* xbase = rb < NP ? xp + (size_t)rb * DM : xs + (size_t)(rb - NP) * DM;
    const bf16_t* xbb = Xin + (size_t)rb * DM;
#pragma unroll
    for (int am = 0; am < 4; ++am) {
      const int ai = am >> 1, m0 = (am & 1) * 2;
      f32x4 x[2][2][2];
#pragma unroll
      for (int mm = 0; mm < 2; ++mm)
#pragma unroll
        for (int bj = 0; bj < 2; ++bj) {
          const size_t xo = (size_t)(128 * ai + 64 * wr + 16 * (m0 + mm) + fr) * DM + c0 + 128 * bj;
          if (from_input) { x[mm][bj][0] = *(const f32x4*)(xbase + xo); x[mm][bj][1] = *(const f32x4*)(xbase + xo + 4); }
          else {
            const u32x4 t = *(const u32x4*)(xbb + xo);
            x[mm][bj][0] = (f32x4){__uint_as_float(t[0] << 16), __uint_as_float(t[0] & 0xffff0000u), __uint_as_float(t[1] << 16), __uint_as_float(t[1] & 0xffff0000u)};
            x[mm][bj][1] = (f32x4){__uint_as_float(t[2] << 16), __uint_as_float(t[2] & 0xffff0000u), __uint_as_float(t[3] << 16), __uint_as_float(t[3] & 0xffff0000u)};
          }
        }
#pragma unroll
      for (int mm = 0; mm < 2; ++mm) {
        const int m = m0 + mm;
        const int row = rb + 128 * ai + 64 * wr + 16 * m + fr;
        float ss = 0.f;
#pragma unroll
        for (int bj = 0; bj < 2; ++bj) {
          const int col = c0 + 128 * bj;
          f32x4 o[2];
#pragma unroll
          for (int n = 0; n < 2; ++n)
#pragma unroll
            for (int e = 0; e < 4; ++e) o[n][e] = x[mm][bj][n][e] + gt[bj][n][e] * acc[ai][bj][m][n][e];
          { u32x4 xw; xw[0] = pack_bf16(o[0][0], o[0][1]); xw[1] = pack_bf16(o[0][2], o[0][3]); xw[2] = pack_bf16(o[1][0], o[1][1]); xw[3] = pack_bf16(o[1][2], o[1][3]);
            *(u32x4*)(Xout + (size_t)row * DM + col) = xw; }
          if (AB) {
#pragma unroll
            for (int n = 0; n < 2; ++n)
#pragma unroll
              for (int e = 0; e < 4; ++e) ss += o[n][e] * o[n][e];
            u32x4 w;
            w[0] = pack_bf16(o[0][0] * g4[bj][0][0], o[0][1] * g4[bj][0][1]); w[1] = pack_bf16(o[0][2] * g4[bj][0][2], o[0][3] * g4[bj][0][3]);
            w[2] = pack_bf16(o[1][0] * g4[bj][1][0], o[1][1] * g4[bj][1][1]); w[3] = pack_bf16(o[1][2] * g4[bj][1][2], o[1][3] * g4[bj][1][3]);
            *(u32x4*)(AB + (size_t)row * DM + col) = w;
          }
        }
        if (AB) {
          ss += __shfl_xor(ss, 16);
          ss += __shfl_xor(ss, 32);
          if (fq == 0) atomicAdd(sumsq + row, ss);
        }
      }
    }
  }
};
struct EpiFinal {
  static constexpr bool AFTER_DRAIN = true, PERM = true;
  const bf16_t* Xin; const float* gate; const float* gfin; float* out; float* sumsq; unsigned* pcnt;
  __device__ __forceinline__ void operator()(f32x4 (&acc)[2][2][4][2], const Unit& u, int wr, int wc, int fr, int fq) const {
    const int rb = u.pm * 256, cb = u.pn * 256;
    const int ci = cond_index(rb);
    const int c0 = cb + 32 * wc + 8 * fq;
    f32x4 gt[2][2];
#pragma unroll
    for (int bj = 0; bj < 2; ++bj)
#pragma unroll
      for (int n = 0; n < 2; ++n) gt[bj][n] = *(const f32x4*)(gate + ci * 6144 + c0 + 128 * bj + 4 * n);
    const bf16_t* xbase = Xin + (size_t)rb * DM;
#pragma unroll
    for (int am = 0; am < 4; ++am) {
      const int ai = am >> 1, m0 = (am & 1) * 2;
      f32x4 x[2][2][2];
#pragma unroll
      for (int mm = 0; mm < 2; ++mm)
#pragma unroll
        for (int bj = 0; bj < 2; ++bj) {
          const u32x4 t = *(const u32x4*)(xbase + (size_t)(128 * ai + 64 * wr + 16 * (m0 + mm) + fr) * DM + c0 + 128 * bj);
          x[mm][bj][0] = (f32x4){__uint_as_float(t[0] << 16), __uint_as_float(t[0] & 0xffff0000u), __uint_as_float(t[1] << 16), __uint_as_float(t[1] & 0xffff0000u)};
          x[mm][bj][1] = (f32x4){__uint_as_float(t[2] << 16), __uint_as_float(t[2] & 0xffff0000u), __uint_as_float(t[3] << 16), __uint_as_float(t[3] & 0xffff0000u)};
        }
#pragma unroll
      for (int mm = 0; mm < 2; ++mm) {
        const int m = m0 + mm;
        float ss = 0.f;
#pragma unroll
        for (int bj = 0; bj < 2; ++bj)
#pragma unroll
          for (int n = 0; n < 2; ++n) {
            f32x4 o;
#pragma unroll
            for (int e = 0; e < 4; ++e) { o[e] = x[mm][bj][n][e] + gt[bj][n][e] * acc[ai][bj][m][n][e]; ss += o[e] * o[e]; }
            acc[ai][bj][m][n] = o;
          }
        ss += __shfl_xor(ss, 16);
        ss += __shfl_xor(ss, 32);
        if (fq == 0) atomicAdd(sumsq + rb + 128 * ai + 64 * wr + 16 * m + fr, ss);
      }
    }
    asm volatile("s_waitcnt vmcnt(0)" ::: "memory");
    unsigned* pc = pcnt + u.pm * 64;
    if ((threadIdx.x & 63) == 0) __hip_atomic_fetch_add(pc, 1u, __ATOMIC_RELAXED, __HIP_MEMORY_SCOPE_AGENT);
    {
      unsigned spins = 0;
      while ((unsigned)__builtin_amdgcn_readfirstlane(__hip_atomic_load(pc, __ATOMIC_RELAXED, __HIP_MEMORY_SCOPE_AGENT)) < 32u) {
        __builtin_amdgcn_s_sleep(2);
        if (++spins > (1u << 22)) break;
      }
    }
    f32x4 gf[2][2];
#pragma unroll
    for (int bj = 0; bj < 2; ++bj)
#pragma unroll
      for (int n = 0; n < 2; ++n) gf[bj][n] = *(const f32x4*)(gfin + c0 + 128 * bj + 4 * n);
    float sq[2][4];
#pragma unroll
    for (int ai = 0; ai < 2; ++ai)
#pragma unroll
      for (int m = 0; m < 4; ++m) sq[ai][m] = __hip_atomic_load(sumsq + rb + 128 * ai + 64 * wr + 16 * m + fr, __ATOMIC_RELAXED, __HIP_MEMORY_SCOPE_AGENT);
#pragma unroll
    for (int ai = 0; ai < 2; ++ai)
#pragma unroll
      for (int m = 0; m < 4; ++m) {
        const int row = rb + 128 * ai + 64 * wr + 16 * m + fr;
        const float rs = rsqrtf(sq[ai][m] * (1.0f / DM) + 1e-6f);
#pragma unroll
        for (int bj = 0; bj < 2; ++bj)
#pragma unroll
          for (int n = 0; n < 2; ++n) {
            f32x4 y;
#pragma unroll
            for (int e = 0; e < 4; ++e) y[e] = acc[ai][bj][m][n][e] * rs * gf[bj][n][e];
            *(f32x4*)(out + (size_t)row * DM + c0 + 128 * bj + 4 * n) = y;
          }
      }
  }
};
template <bool HALF>
struct EpiSwiGLU {
  static constexpr bool AFTER_DRAIN = false, PERM = false;
  bf16_t* H; const float* sumsq; const float* shw;
  __device__ __forceinline__ void operator()(const f32x4 (&acc)[2][2][4][2], const Unit& u, int wr, int wc, int fr, int fq) const {
    const int rb = u.row0;
    const float* sw = shw + cond_index(rb) * 5632 + u.pn * 256 + 32 * wc + 4 * fq;
    f32x4 sg[2], su[2];
#pragma unroll
    for (int bj = 0; bj < 2; ++bj) { sg[bj] = *(const f32x4*)(sw + 128 * bj); su[bj] = *(const f32x4*)(sw + 128 * bj + 16); }
    float rstd[2][4];
#pragma unroll
    for (int ai = 0; ai < (HALF ? 1 : 2); ++ai)
#pragma unroll
      for (int m = 0; m < 4; ++m) rstd[ai][m] = sumsq[rb + 128 * ai + 64 * wr + 16 * m + fr];
#pragma unroll
    for (int ai = 0; ai < (HALF ? 1 : 2); ++ai)
#pragma unroll
      for (int m = 0; m < 4; ++m) {
        const int row = rb + 128 * ai + 64 * wr + 16 * m + fr;
        const float rs = rsqrtf(rstd[ai][m] * (1.0f / DM) + 1e-6f);
#pragma unroll
        for (int bj = 0; bj < 2; ++bj) {
          const int col = (u.pn * 256 + 128 * bj + 32 * wc) / 2 + 4 * fq;
          float o[4];
#pragma unroll
          for (int e = 0; e < 4; ++e) o[e] = siluf_(rs * acc[ai][bj][m][0][e] + sg[bj][e]) * (rs * acc[ai][bj][m][1][e] + su[bj][e]);
          u32x2 w; w[0] = pack_bf16(o[0], o[1]); w[1] = pack_bf16(o[2], o[3]);
          *(u32x2*)(H + (size_t)row * DFF + col) = w;
        }
      }
  }
};
struct EpiBf16Norm {
  static constexpr bool AFTER_DRAIN = false, PERM = true;
  bf16_t* C; const float* sumsq; const float* shw;
  __device__ __forceinline__ void operator()(const f32x4 (&acc)[2][2][4][2], const Unit& u, int wr, int wc, int fr, int fq) const {
    const int rb = u.pm * 256, c0 = u.pn * 256 + 32 * wc + 8 * fq;
    const float* sw = shw + cond_index(rb) * 1024 + c0;
    f32x4 sh[2][2];
#pragma unroll
    for (int bj = 0; bj < 2; ++bj)
#pragma unroll
      for (int n = 0; n < 2; ++n) sh[bj][n] = *(const f32x4*)(sw + 128 * bj + 4 * n);
    float rstd[2][4];
#pragma unroll
    for (int ai = 0; ai < 2; ++ai)
#pragma unroll
      for (int m = 0; m < 4; ++m) rstd[ai][m] = sumsq[rb + 128 * ai + 64 * wr + 16 * m + fr];
#pragma unroll
    for (int ai = 0; ai < 2; ++ai)
#pragma unroll
      for (int m = 0; m < 4; ++m) {
        const int row = rb + 128 * ai + 64 * wr + 16 * m + fr;
        const float rs = rsqrtf(rstd[ai][m] * (1.0f / DM) + 1e-6f);
#pragma unroll
        for (int bj = 0; bj < 2; ++bj) {
          const f32x4 v0 = acc[ai][bj][m][0], v1 = acc[ai][bj][m][1];
          u32x4 w;
          w[0] = pack_bf16(rs * v0[0] + sh[bj][0][0], rs * v0[1] + sh[bj][0][1]); w[1] = pack_bf16(rs * v0[2] + sh[bj][0][2], rs * v0[3] + sh[bj][0][3]);
          w[2] = pack_bf16(rs * v1[0] + sh[bj][1][0], rs * v1[1] + sh[bj][1][1]); w[3] = pack_bf16(rs * v1[2] + sh[bj][1][2], rs * v1[3] + sh[bj][1][3]);
          *(u32x4*)(C + (size_t)row * DM + c0 + 128 * bj) = w;
        }
      }
  }
};
template <bool HALF>
struct EpiGlu {
  static constexpr bool AFTER_DRAIN = false, PERM = true;
  const bf16_t* YBF; const float* bias; bf16_t* CAT;
  __device__ __forceinline__ void operator()(const f32x4 (&acc)[2][2][4][2], const Unit& u, int wr, int wc, int fr, int fq) const {
    const int rb = u.row0, c0 = u.pn * 256 + 32 * wc + 8 * fq;
    f32x4 bb[2][2];
#pragma unroll
    for (int bj = 0; bj < 2; ++bj)
#pragma unroll
      for (int n = 0; n < 2; ++n) bb[bj][n] = *(const f32x4*)(bias + c0 + 128 * bj + 4 * n);
#pragma unroll
    for (int ai = 0; ai < (HALF ? 1 : 2); ++ai) {
      u32x4 yy[4][2];
#pragma unroll
      for (int m = 0; m < 4; ++m)
#pragma unroll
        for (int bj = 0; bj < 2; ++bj) yy[m][bj] = *(const u32x4*)(YBF + (size_t)(rb + 128 * ai + 64 * wr + 16 * m + fr) * 512 + c0 + 128 * bj);
#pragma unroll
      for (int m = 0; m < 4; ++m) {
        const int row = rb + 128 * ai + 64 * wr + 16 * m + fr;
#pragma unroll
        for (int bj = 0; bj < 2; ++bj) {
          u32x4 w;
#pragma unroll
          for (int n = 0; n < 2; ++n) {
            const f32x4 v = acc[ai][bj][m][n]; const f32x4 b = bb[bj][n];
            const unsigned ya = yy[m][bj][2 * n], yb = yy[m][bj][2 * n + 1];
            const float y0 = __uint_as_float(ya << 16), y1 = __uint_as_float(ya & 0xffff0000u), y2 = __uint_as_float(yb << 16), y3 = __uint_as_float(yb & 0xffff0000u);
            w[2 * n] = pack_bf16(y0 * sigmoidf_(v[0] + b[0]), y1 * sigmoidf_(v[1] + b[1]));
            w[2 * n + 1] = pack_bf16(y2 * sigmoidf_(v[2] + b[2]), y3 * sigmoidf_(v[3] + b[3]));
          }
          *(u32x4*)(CAT + (size_t)row * DM + 512 + c0 + 128 * bj) = w;
        }
      }
    }
  }
};

__device__ __forceinline__ void prep_mod_item(const Params& p, int item, char* smem, int tid) {
  const int layer = item / 96, cg64 = item % 96;
  const int kg = tid >> 4, l16 = tid & 15;
  float* sc = (float*)smem;
  float* red = (float*)(smem + 12288);
  __syncthreads();
  for (int i = tid; i < 3072; i += 256) {
    const int ci = i >> 10, k = i & 1023;
    const float cv = ci == 0 ? p.c_ctx[k] : p.c[(ci - 1) * DM + k];
    sc[i] = siluf_(cv);
  }
  __syncthreads();
  const int col = cg64 * 64 + l16 * 4;
  const float* w = p.w_mod + ((size_t)layer * DM + kg * 64) * 6144 + col;
  float a[3][4];
#pragma unroll
  for (int ci = 0; ci < 3; ++ci)
#pragma unroll
    for (int e = 0; e < 4; ++e) a[ci][e] = 0.f;
#pragma unroll 8
  for (int r = 0; r < 64; ++r) {
    const f32x4 wv = *(const f32x4*)(w + (size_t)r * 6144);
#pragma unroll
    for (int ci = 0; ci < 3; ++ci) {
      const float s = sc[ci * 1024 + kg * 64 + r];
#pragma unroll
      for (int e = 0; e < 4; ++e) a[ci][e] += s * wv[e];
    }
  }
#pragma unroll
  for (int ci = 0; ci < 3; ++ci)
#pragma unroll
    for (int e = 0; e < 4; ++e) red[(kg * 3 + ci) * 64 + l16 * 4 + e] = a[ci][e];
  __syncthreads();
  if (tid < 192) {
    const int ci = tid >> 6, c = tid & 63;
    float sum = p.b_mod[layer * 6144 + cg64 * 64 + c];
#pragma unroll
    for (int k2 = 0; k2 < 16; ++k2) sum += red[(k2 * 3 + ci) * 64 + c];
    ((float*)(p.ws + OFF_MOD))[(size_t)(layer * 3 + ci) * 6144 + cg64 * 64 + c] = sum;
  }
}

__device__ __forceinline__ void prep_transpose_tile(const float* src, int K, int N, bf16_t* dst, int kt, int nt, int mapmode, char* smem, int tid) {
  float* T = (float*)smem;
  __syncthreads();
#pragma unroll
  for (int i = 0; i < 4; ++i) {
    const int idx = tid + 256 * i, kr = idx >> 4, c4 = idx & 15;
    const f32x4 v = *(const f32x4*)(src + (size_t)(kt * 64 + kr) * N + nt * 64 + c4 * 4);
#pragma unroll
    for (int e = 0; e < 4; ++e) T[kr * 65 + c4 * 4 + e] = v[e];
  }
  __syncthreads();
#pragma unroll
  for (int i = 0; i < 2; ++i) {
    const int idx = tid + 256 * i, nr = idx >> 3, seg = idx & 7;
    f32x4 a, b;
#pragma unroll
    for (int e = 0; e < 4; ++e) { a[e] = T[(seg * 8 + e) * 65 + nr]; b[e] = T[(seg * 8 + 4 + e) * 65 + nr]; }
    const int n = nt * 64 + nr;
    int drow = n;
    if (mapmode == 1) drow = (n >> 4) * 32 + (n & 15);
    else if (mapmode == 2) drow = (n >> 4) * 32 + 16 + (n & 15);
    *(u32x4*)(dst + (size_t)drow * K + kt * 64 + seg * 8) = pack8(a, b);
  }
}

__device__ __forceinline__ void prep_s5_item(const Params& p, int item, int tid) {
  const int idx = item * 256 + tid;
  const int d = idx >> 11, g = (idx >> 6) & 31;
  const float lr = fminf(p.lam_re[idx], -1e-4f), li = p.lam_im[idx];
  const float dt = expf(p.log_step[d * 32 + g]);
  const float mag = expf(lr * dt);
  const float ar = mag * cosf(li * dt), ai = mag * sinf(li * dt);
  const float den = lr * lr + li * li, nr = ar - 1.0f, ni = ai;
  const float cr = (nr * lr + ni * li) / den, ci = (ni * lr - nr * li) / den;
  ((float*)(p.ws + OFF_AR))[idx] = ar;
  ((float*)(p.ws + OFF_AI))[idx] = ai;
  float* bb = (float*)(p.ws + OFF_BBAR);
  const int pp = idx & 63;
  const size_t o0 = ((size_t)((d * 32 + g) * 2 + 0) * 64 + pp) * 16, o1 = ((size_t)((d * 32 + g) * 2 + 1) * 64 + pp) * 16;
  for (int h = 0; h < 16; ++h) {
    const float br = p.b_re[(size_t)idx * 16 + h], bi = p.b_im[(size_t)idx * 16 + h];
    bb[o0 + h] = cr * br - ci * bi;
    bb[o1 + h] = cr * bi + ci * br;
  }
}

__device__ __forceinline__ void prep_dft_item(const Params& p, int item, int tid) {
  bf16_t* dst; int e0;
  int mode;
  if (item < 64) { dst = (bf16_t*)(p.ws + OFF_CS2); e0 = item * 2048 + tid * 8; mode = 0; }
  else if (item < 128) { dst = (bf16_t*)(p.ws + OFF_CL2P); e0 = (item - 64) * 2048 + tid * 8; mode = 1; }
  else { dst = (bf16_t*)(p.ws + OFF_CL2S); e0 = (item - 128) * 2048 + tid * 8; mode = 2; }
  float v[8];
#pragma unroll
  for (int j = 0; j < 8; ++j) {
    const int e = e0 + j;
    float s, c;
    if (mode == 0) {
      const int row = e >> 8, cc = e & 255, kc = row >> 1, cs = row & 1;
      const int ph = (kc * cc) & 255;
      sincospif((float)ph * (2.0f / 256.0f), &s, &c);
      v[j] = (cs ? s : c) * (1.0f / 16.0f);
    } else if (mode == 1) {
      const int kl = e >> 9, r = e & 511, cs = r >> 8, l = r & 255;
      const int ph = (kl * l) & 255;
      sincospif((float)ph * (2.0f / 256.0f), &s, &c);
      v[j] = (cs ? -s : c) * (1.0f / 16.0f);
    } else {
      const int kl = e >> 11, r = e & 2047, cs = r >> 10, l = r & 1023;
      const int ph = (kl * l) & 1023;
      sincospif((float)ph * (2.0f / 1024.0f), &s, &c);
      v[j] = (cs ? -s : c) * (1.0f / 32.0f);
    }
  }
  u32x4 o; o[0] = pack_bf16(v[0], v[1]); o[1] = pack_bf16(v[2], v[3]); o[2] = pack_bf16(v[4], v[5]); o[3] = pack_bf16(v[6], v[7]);
  *(u32x4*)(dst + e0) = o;
}

__device__ __forceinline__ void prep_transpose_job(const Params& p, int job, int t, char* smem, int tid) {
  if (job == 0) prep_transpose_tile(p.w_in_even, 1024, 2048, (bf16_t*)(p.ws + OFF_WT_IN), t / 32, t % 32, 0, smem, tid);
  else if (job == 1) prep_transpose_tile(p.glu_w, 512, 512, (bf16_t*)(p.ws + OFF_WT_GLU), t / 8, t % 8, 0, smem, tid);
  else if (job <= 4) {
    const float* src = job == 2 ? p.w_out_even : (job == 3 ? p.w_in_odd : p.w_out_odd);
    const size_t off = job == 2 ? OFF_WT_OUT : (job == 3 ? OFF_WT_INO : OFF_WT_OUTO);
    prep_transpose_tile(src, 1024, 1024, (bf16_t*)(p.ws + off), t / 16, t % 16, 0, smem, tid);
  } else if (job <= 8) {
    const int layer = (job - 5) & 1, isup = (job - 5) >> 1;
    const float* src = (isup ? p.w_up : p.w_gate) + (size_t)layer * 1024 * DFF;
    prep_transpose_tile(src, 1024, DFF, (bf16_t*)(p.ws + OFF_WT_GU) + (size_t)layer * 5632 * 1024, t / 44, t % 44, 1 + isup, smem, tid);
  } else {
    const int layer = job - 9;
    prep_transpose_tile(p.w_down + (size_t)layer * DFF * 1024, DFF, 1024, (bf16_t*)(p.ws + OFF_WT_DN) + (size_t)layer * 1024 * DFF, t / 16, t % 16, 0, smem, tid);
  }
}
constexpr int TR_EARLY = 512;
constexpr int TR_MID = 64 + 256 + 256 + 3 * 704;
constexpr int TR_LATE = 256 + 3 * 704;
__device__ __forceinline__ void prep_transpose_early(const Params& p, int t, char* smem, int tid) {
  prep_transpose_job(p, 0, t, smem, tid);
}
__device__ __forceinline__ void prep_transpose_mid(const Params& p, int t, char* smem, int tid) {
  int job;
  if (t < 64) job = 1; else if ((t -= 64) < 256) job = 2; else if ((t -= 256) < 256) job = 3;
  else if ((t -= 256) < 704) job = 5; else if ((t -= 704) < 704) job = 7; else { t -= 704; job = 9; }
  prep_transpose_job(p, job, t, smem, tid);
}
__device__ __forceinline__ void prep_transpose_late(const Params& p, int t, char* smem, int tid) {
  int job;
  if (t < 256) job = 4; else if ((t -= 256) < 704) job = 6; else if ((t -= 704) < 704) job = 8; else { t -= 704; job = 10; }
  prep_transpose_job(p, job, t, smem, tid);
}

__device__ __forceinline__ void phase_prep(const Params& p, char* smem0) {
  constexpr int T0 = 96;
  constexpr int S0 = T0 + TR_EARLY, TOTAL = S0 + 16;
  static_assert((T0 % 2) == 0 && (TR_EARLY % 2) == 0 && (TOTAL % 2) == 0, "even");
  const int T_ = opaque_tid();
  const int vb = T_ >> 8, tid = T_ & 255;
  char* smem = smem0 + vb * 32768;
  for (int item0 = blockIdx.x * 2; item0 < TOTAL; item0 += gridDim.x * 2) {
    const int item = item0 + vb;
    if (item < T0) prep_mod_item(p, item, smem, tid);
    else if (item < S0) prep_transpose_early(p, item - T0, smem, tid);
    else prep_s5_item(p, item - S0, tid);
  }
}
__device__ __forceinline__ void phase_prep_mod1(const Params& p, char* smem0, int first_block) {
  if ((int)blockIdx.x < first_block) return;
  const int T_ = opaque_tid();
  const int vb = T_ >> 8, tid = T_ & 255;
  char* smem = smem0 + vb * 32768;
  const int nb = gridDim.x - first_block;
  for (int item0 = ((int)blockIdx.x - first_block) * 2; item0 < 96; item0 += nb * 2) prep_mod_item(p, 96 + item0 + vb, smem, tid);
}
__device__ __forceinline__ void phase_prep_dft(const Params& p, int first_block) {
  if ((int)blockIdx.x < first_block) return;
  const int T_ = opaque_tid();
  const int vb = T_ >> 8, tid = T_ & 255;
  const int nb = gridDim.x - first_block;
  for (int item0 = ((int)blockIdx.x - first_block) * 2; item0 < 1152; item0 += nb * 2) prep_dft_item(p, item0 + vb, tid);
}
__device__ __forceinline__ void phase_prep_late(const Params& p, char* smem0, int which, int first_block) {
  if ((int)blockIdx.x < first_block) return;
  const int T_ = opaque_tid();
  const int vb = T_ >> 8, tid = T_ & 255;
  char* smem = smem0 + vb * 32768;
  const int nb = gridDim.x - first_block, total = which ? TR_LATE : TR_MID;
  for (int item0 = ((int)blockIdx.x - first_block) * 2; item0 < total; item0 += nb * 2) {
    if (which) prep_transpose_late(p, item0 + vb, smem, tid); else prep_transpose_mid(p, item0 + vb, smem, tid);
  }
}

__device__ __forceinline__ void phase_norm(const Params& p, bool from_input, const float* gvec, const float* modbase  ) {
  const int T_ = opaque_tid();
  const int lane = T_ & 63, wid = T_ >> 6;
  const float* X = (const float*)(p.ws + OFF_X);
  bf16_t* A = (bf16_t*)(p.ws + OFF_ABUF);
  for (int row = blockIdx.x * 8 + wid; row < NTOK; row += gridDim.x * 8) {
    const float* xr = from_input ? xin_row(p, row) : X + (size_t)row * DM;
    f32x4 v[4];
    float ss = 0.f;
#pragma unroll
    for (int i = 0; i < 4; ++i) {
      v[i] = *(const f32x4*)(xr + i * 256 + lane * 4);
#pragma unroll
      for (int e = 0; e < 4; ++e) ss += v[i][e] * v[i][e];
    }
#pragma unroll
    for (int o = 32; o >= 1; o >>= 1) ss += __shfl_xor(ss, o);
    const float rstd = rsqrtf(ss * (1.0f / DM) + 1e-6f);
    const float* mb = modbase + cond_index(row) * 6144;
#pragma unroll
    for (int i = 0; i < 4; ++i) {
      const int k = i * 256 + lane * 4;
      const f32x4 g = *(const f32x4*)(gvec + k), sh = *(const f32x4*)(mb + k), sc = *(const f32x4*)(mb + 1024 + k);
      float o[4];
#pragma unroll
      for (int e = 0; e < 4; ++e) o[e] = v[i][e] * rstd * g[e] * (1.0f + sc[e]) + sh[e];
      u32x2 w; w[0] = pack_bf16(o[0], o[1]); w[1] = pack_bf16(o[2], o[3]);
      *(u32x2*)(A + (size_t)row * DM + k) = w;
    }
  }
}
__device__ __forceinline__ void phase_norm_consts(const Params& p, int part, int first_block) {
  const int T_ = opaque_tid();
  const int lane = T_ & 63, wid = T_ >> 6;
  const float* MOD = (const float*)(p.ws + OFF_MOD);
  float* GS = (float*)(p.ws + OFF_GS);
  const int nblk = (int)gridDim.x - first_block, blk = (int)blockIdx.x - first_block;
  if (blk < 0) return;
  if (part < 2) {
    const int i0 = part == 0 ? 0 : 3072, i1 = part == 0 ? 3072 : 9216;
    for (int i = i0 + blk * 512 + T_; i < i1; i += nblk * 512) {
      const int uu = i / 3072, ci = (i >> 10) % 3, k = i & 1023;
      const float* gvec = uu == 0 ? p.norm_ffn_g : (uu == 1 ? p.norm_mix_g + DM : p.norm_ffn_g + DM);
      const int layer = uu == 0 ? 0 : 1, j = uu == 1 ? 1 : 4;
      GS[i] = gvec[k] * (1.0f + MOD[(size_t)(layer * 3 + ci) * 6144 + j * 1024 + k]);
    }
  }
  const int rbase = part == 0 ? 0 : (part == 2 ? 5632 : 11264), rcnt = part == 1 ? 1024 : 5632;
  for (int r0 = blk * 8 + wid; r0 < rcnt; r0 += nblk * 8) {
    const int row = rbase + r0;
    const bf16_t* wrow; const float* sh; float* dst; int dstride;
    if (row < 2 * 5632) {
      const int layer = row / 5632, n = row - layer * 5632;
      wrow = (const bf16_t*)(p.ws + OFF_WT_GU) + (size_t)row * 1024;
      sh = MOD + (size_t)layer * 3 * 6144 + 3 * 1024;
      dst = (float*)(p.ws + OFF_SHWGU) + (size_t)layer * 3 * 5632 + n; dstride = 5632;
    } else {
      const int n = row - 2 * 5632;
      wrow = (const bf16_t*)(p.ws + OFF_WT_INO) + (size_t)n * 1024;
      sh = MOD + (size_t)3 * 6144;
      dst = (float*)(p.ws + OFF_SHWINO) + n; dstride = 1024;
    }
    const u32x4 w0 = *(const u32x4*)(wrow + lane * 16), w1 = *(const u32x4*)(wrow + lane * 16 + 8);
    float wf[16];
#pragma unroll
    for (int q = 0; q < 4; ++q) { wf[2 * q] = __uint_as_float(w0[q] << 16); wf[2 * q + 1] = __uint_as_float(w0[q] & 0xffff0000u); wf[8 + 2 * q] = __uint_as_float(w1[q] << 16); wf[8 + 2 * q + 1] = __uint_as_float(w1[q] & 0xffff0000u); }
#pragma unroll
    for (int ci = 0; ci < 3; ++ci) {
      float acc = 0.f;
#pragma unroll
      for (int q = 0; q < 4; ++q) {
        const f32x4 sv = *(const f32x4*)(sh + ci * 6144 + lane * 16 + q * 4);
#pragma unroll
        for (int e = 0; e < 4; ++e) acc += wf[q * 4 + e] * sv[e];
      }
#pragma unroll
      for (int o = 32; o >= 1; o >>= 1) acc += __shfl_xor(acc, o);
      if (lane == 0) dst[ci * dstride] = acc;
    }
  }
}

__device__ __forceinline__ void phase_final_norm(const Params& p) {
  const int T_ = opaque_tid();
  const int lane = T_ & 63, wid = T_ >> 6;
  const float* X = (const float*)(p.ws + OFF_X);
  for (int row = blockIdx.x * 8 + wid; row < NTOK; row += gridDim.x * 8) {
    const float* xr = X + (size_t)row * DM;
    f32x4 v[4];
    float ss = 0.f;
#pragma unroll
    for (int i = 0; i < 4; ++i) {
      v[i] = *(const f32x4*)(xr + i * 256 + lane * 4);
#pragma unroll
      for (int e = 0; e < 4; ++e) ss += v[i][e] * v[i][e];
    }
#pragma unroll
    for (int o = 32; o >= 1; o >>= 1) ss += __shfl_xor(ss, o);
    const float rstd = rsqrtf(ss * (1.0f / DM) + 1e-6f);
#pragma unroll
    for (int i = 0; i < 4; ++i) {
      const int k = i * 256 + lane * 4;
      const f32x4 g = *(const f32x4*)(p.final_g + k);
      f32x4 o;
#pragma unroll
      for (int e = 0; e < 4; ++e) o[e] = v[i][e] * rstd * g[e];
      *(f32x4*)(p.out + (size_t)row * DM + k) = o;
    }
  }
}

__device__ __forceinline__ void attn_item(const Params& p, int item, char* smem, int tid, int c_lo, int c_hi, int ntrips, int merge, char* smem_peer) {
  const int lane = tid & 63, wid = tid >> 6, lr = lane & 31, lh = lane >> 5;
  const bf16_t* QB = (const bf16_t*)(p.ws + OFF_QB);
  const bf16_t* KB = (const bf16_t*)(p.ws + OFF_KB);
  const bf16_t* VB = (const bf16_t*)(p.ws + OFF_VB);
  bf16_t* CAT = (bf16_t*)(p.ws + OFF_CAT);
  bool latent; int b, head, qrow0, nchunks, r0 = 0, rowstart = 0;
  if (item < 128) { latent = true; b = item >> 6; head = (item >> 3) & 7; const int rp = item & 7; r0 = rp * 2; qrow0 = NP + b * LS + r0 * 64; nchunks = 9;
    int rs0 = r0 - 4; rs0 = rs0 < 0 ? 0 : (rs0 > 8 ? 8 : rs0); rowstart = rs0 < 6 ? rs0 : 6; }
  else { latent = false; const int it = item - 128; b = it >> 4; head = (it >> 1) & 7; qrow0 = b * LP + (it & 1) * 128; nchunks = 2; }
  const int qrow = qrow0 + wid * 32 + lr;
  bf16x8 qf[4];
#pragma unroll
  for (int ks = 0; ks < 4; ++ks) qf[ks] = *(const bf16x8*)(QB + (size_t)qrow * 512 + head * 64 + ks * 16 + lh * 8);
  f32x16 o[2];
#pragma unroll
  for (int i = 0; i < 16; ++i) { o[0][i] = 0.f; o[1][i] = 0.f; }
  float mrun = -1e30f, lsum = 0.f;
  const int qr = r0 + (wid >> 1), qc = (wid & 1) * 32 + lr;
  int rs = qr - 4; rs = rs < 0 ? 0 : (rs > 8 ? 8 : rs);
  int cs = qc - 8; cs = cs < 0 ? 0 : (cs > 48 ? 48 : cs);
  char* Ks = smem;
  char* Vt = smem + 16384;
  const float LOG2E = 1.4426950408889634f;
  (void)nchunks;
  for (int tr = 0; tr < ntrips; ++tr) {
    const int c = c_lo + tr;
    const bool active = c < c_hi;
    const bool local = latent && c < 5;
    __syncthreads();
    if (active) {
    if (!latent || local) {
      const int krow0 = latent ? NP + b * LS + (rowstart + 2 * c) * 64 : b * LP + c * 128;
#pragma unroll
      for (int i = 0; i < 4; ++i) {
        const int idx = tid + 256 * i, key = idx >> 3, seg = idx & 7;
        const u32x4 v = *(const u32x4*)(KB + (size_t)(krow0 + key) * 512 + head * 64 + seg * 8);
        *(u32x4*)(Ks + key * 128 + ((seg ^ ((key >> 1) & 7)) << 4)) = v;
      }
#pragma unroll
      for (int i = 0; i < 2; ++i) {
        const int idx = tid + 256 * i, kp = idx >> 3, seg = idx & 7;
        const u32x4 v0 = *(const u32x4*)(VB + (size_t)(krow0 + 2 * kp) * 512 + head * 64 + seg * 8);
        const u32x4 v1 = *(const u32x4*)(VB + (size_t)(krow0 + 2 * kp + 1) * 512 + head * 64 + seg * 8);
#pragma unroll
        for (int j = 0; j < 4; ++j) {
          const unsigned lo = (v0[j] & 0xffffu) | (v1[j] << 16), hi = (v0[j] >> 16) | (v1[j] & 0xffff0000u);
          *(unsigned*)(Vt + (seg * 8 + 2 * j) * 272 + kp * 4) = lo;
          *(unsigned*)(Vt + (seg * 8 + 2 * j + 1) * 272 + kp * 4) = hi;
        }
      }
    } else {
      const int l0 = (c - 5) * 128;
      const float* ck = p.cache_k + ((size_t)b * 512 + l0) * 512 + head * 64;
      const float* cv = p.cache_v + ((size_t)b * 512 + l0) * 512 + head * 64;
#pragma unroll
      for (int i = 0; i < 4; ++i) {
        const int idx = tid + 256 * i, key = idx >> 3, seg = idx & 7;
        const f32x4 a = *(const f32x4*)(ck + (size_t)key * 512 + seg * 8), bq = *(const f32x4*)(ck + (size_t)key * 512 + seg * 8 + 4);
        *(u32x4*)(Ks + key * 128 + ((seg ^ ((key >> 1) & 7)) << 4)) = pack8(a, bq);
      }
#pragma unroll
      for (int i = 0; i < 2; ++i) {
        const int idx = tid + 256 * i, kp = idx >> 3, seg = idx & 7;
        const float* s0 = cv + (size_t)(2 * kp) * 512 + seg * 8;
        const float* s1 = s0 + 512;
#pragma unroll
        for (int h4 = 0; h4 < 2; ++h4) {
          const f32x4 a = *(const f32x4*)(s0 + 4 * h4), bq = *(const f32x4*)(s1 + 4 * h4);
#pragma unroll
          for (int e = 0; e < 4; ++e) *(unsigned*)(Vt + (seg * 8 + 4 * h4 + e) * 272 + kp * 4) = pack_bf16(a[e], bq[e]);
        }
      }
    }
    }
    __syncthreads();
    if (active)
#pragma unroll 1
    for (int kt = 0; kt < 4; ++kt) {
      int kr = 0;
      if (local) {
        kr = rowstart + 2 * c + (kt >> 1);
        if (kr < rs || kr >= rs + 8) continue;
      }
      f32x16 st;
#pragma unroll
      for (int i = 0; i < 16; ++i) st[i] = 0.f;
#pragma unroll
      for (int ks = 0; ks < 4; ++ks) {
        const int row = kt * 32 + lr;
        const bf16x8 kf = *(const bf16x8*)(Ks + row * 128 + (((ks * 2 + lh) ^ ((row >> 1) & 7)) << 4));
        st = __builtin_amdgcn_mfma_f32_32x32x16_bf16(kf, qf[ks], st, 0, 0, 0);
      }
      float s2[16];
      float tmax = -1e30f;
      if (local) {
        const float* rp = p.na_rpb + ((size_t)head * 15 + (kr - qr + 7)) * 31;
#pragma unroll
        for (int i = 0; i < 16; ++i) {
          const int kc = (kt & 1) * 32 + 8 * (i >> 2) + 4 * lh + (i & 3);
          const bool valid = kc >= cs && kc < cs + 16;
          float sv = -1e30f;
          if (valid) sv = (st[i] * 0.125f + rp[kc - qc + 15]) * LOG2E;
          s2[i] = sv;
          tmax = fmaxf(tmax, sv);
        }
      } else {
#pragma unroll
        for (int i = 0; i < 16; ++i) { s2[i] = st[i] * (0.125f * LOG2E); tmax = fmaxf(tmax, s2[i]); }
      }
      tmax = fmaxf(tmax, xor32(tmax));
      const float mnew = fmaxf(mrun, tmax);
      const float alpha = __builtin_amdgcn_exp2f(mrun - mnew);
      mrun = mnew;
      float psum = 0.f;
#pragma unroll
      for (int i = 0; i < 16; ++i) { s2[i] = __builtin_amdgcn_exp2f(s2[i] - mnew); psum += s2[i]; }
      lsum = lsum * alpha + psum;
#pragma unroll
      for (int i = 0; i < 16; ++i) { o[0][i] *= alpha; o[1][i] *= alpha; }
#pragma unroll
      for (int s = 0; s < 2; ++s) {
        u32x4 pk;
        pk[0] = pack_bf16(s2[8 * s + 0], s2[8 * s + 1]); pk[1] = pack_bf16(s2[8 * s + 2], s2[8 * s + 3]);
        pk[2] = pack_bf16(s2[8 * s + 4], s2[8 * s + 5]); pk[3] = pack_bf16(s2[8 * s + 6], s2[8 * s + 7]);
        const bf16x8 pf = as_bf16x8(pk);
#pragma unroll
        for (int dt = 0; dt < 2; ++dt) {
          const char* vp = Vt + (dt * 32 + lr) * 272 + (kt * 32 + 16 * s + 4 * lh) * 2;
          const u32x2 a0 = *(const u32x2*)vp, a1 = *(const u32x2*)(vp + 16);
          u32x4 vv; vv[0] = a0[0]; vv[1] = a0[1]; vv[2] = a1[0]; vv[3] = a1[1];
          o[dt] = __builtin_amdgcn_mfma_f32_32x32x16_bf16(as_bf16x8(vv), pf, o[dt], 0, 0, 0);
        }
      }
    }
  }
  float ltot = lsum + xor32(lsum);
  if (merge == 1) {
    __syncthreads();
    char* pb_ = smem + wid * 8704;
#pragma unroll
    for (int dt = 0; dt < 2; ++dt)
#pragma unroll
      for (int i = 0; i < 16; ++i) *(float*)(pb_ + (dt * 16 + i) * 256 + lane * 4) = o[dt][i];
    *(float*)(pb_ + 8192 + lane * 4) = mrun;
    *(float*)(pb_ + 8448 + lane * 4) = ltot;
    __syncthreads();
    return;
  }
  if (merge == 2) {
    __syncthreads();
    __syncthreads();
    const char* pb_ = smem_peer + wid * 8704;
    const float m1 = *(const float*)(pb_ + 8192 + lane * 4), l1 = *(const float*)(pb_ + 8448 + lane * 4);
    const float m = fmaxf(mrun, m1);
    const float a0 = __builtin_amdgcn_exp2f(mrun - m), a1 = __builtin_amdgcn_exp2f(m1 - m);
    ltot = ltot * a0 + l1 * a1;
#pragma unroll
    for (int dt = 0; dt < 2; ++dt)
#pragma unroll
      for (int i = 0; i < 16; ++i) o[dt][i] = o[dt][i] * a0 + *(const float*)(pb_ + (dt * 16 + i) * 256 + lane * 4) * a1;
  }
  const float inv = 1.0f / ltot;
#pragma unroll
  for (int dt = 0; dt < 2; ++dt)
#pragma unroll
    for (int g = 0; g < 4; ++g) {
      const int d = dt * 32 + 8 * g + 4 * lh;
      u32x2 w; w[0] = pack_bf16(o[dt][4 * g] * inv, o[dt][4 * g + 1] * inv); w[1] = pack_bf16(o[dt][4 * g + 2] * inv, o[dt][4 * g + 3] * inv);
      *(u32x2*)(CAT + (size_t)qrow * DM + head * 64 + d) = w;
    }
}

template <bool FULL>
__device__ __forceinline__ void s5_scan(const Params& p, int trow0, int dstep, int nch, int g, int d, float (&cr_)[2], float (&ci_)[2], char* xs) {
  const int lane = opaque_tid() & 63, lr = lane & 31, lh = lane >> 5;
  const bf16_t* U = (const bf16_t*)(p.ws + OFF_U);
  float* Y = (float*)(p.ws + (d ? OFF_YB : OFF_YF));
  const float* AR = (const float*)(p.ws + OFF_AR);
  const float* AI = (const float*)(p.ws + OFF_AI);
  const float* BB = (const float*)(p.ws + OFF_BBAR);
  const int dg = d * 32 + g;
  bf16x8 bfrag[4];
#pragma unroll
  for (int nb = 0; nb < 4; ++nb) {
    const int ri = nb >> 1, pb = nb & 1;
    const float* src = BB + ((size_t)(dg * 2 + ri) * 64 + pb * 32 + lr) * 16 + lh * 8;
    bfrag[nb] = as_bf16x8(pack8(*(const f32x4*)src, *(const f32x4*)(src + 4)));
  }
  bf16x8 cfrag[4];
  if (FULL) {
    const int hch = lane & 15, q4 = lane >> 4;
#pragma unroll
    for (int ks = 0; ks < 4; ++ks) {
      const int p0 = 16 * ks + 4 * q4;
      const f32x4 cr = *(const f32x4*)(p.c_re + ((size_t)dg * 16 + hch) * 64 + p0), ci = *(const f32x4*)(p.c_im + ((size_t)dg * 16 + hch) * 64 + p0);
      u32x4 t; t[0] = pack_bf16(cr[0], -ci[0]); t[1] = pack_bf16(cr[1], -ci[1]); t[2] = pack_bf16(cr[2], -ci[2]); t[3] = pack_bf16(cr[3], -ci[3]);
      cfrag[ks] = as_bf16x8(t);
    }
  }
  float a1r_[2], a1i_[2], a16r_[2], a16i_[2];
#pragma unroll
  for (int pb = 0; pb < 2; ++pb) {
    float ar = AR[dg * 64 + pb * 32 + lr], ai = AI[dg * 64 + pb * 32 + lr];
    a1r_[pb] = ar; a1i_[pb] = ai;
#pragma unroll
    for (int k = 0; k < 4; ++k) { const float nr = ar * ar - ai * ai, ni = 2.f * ar * ai; ar = nr; ai = ni; }
    a16r_[pb] = ar; a16i_[pb] = ai;
  }
  const int upos = 16 * ((lr >> 2) & 1) + 4 * (lr >> 3) + (lr & 3);
  const bf16_t* up0 = U + (size_t)g * ((size_t)NTOK * 16) + (size_t)(trow0 + dstep * upos) * 16 + lh * 8;
  const long ustep = (long)dstep * 32 * 16;
  u32x4 un = *(const u32x4*)up0;
  auto cproj = [&](int cprev, const char* xb) {
#pragma unroll
    for (int mt = 0; mt < 2; ++mt) {
      f32x4 ya = {0.f, 0.f, 0.f, 0.f};
#pragma unroll
      for (int ks = 0; ks < 4; ++ks) {
        const bf16x8 xf = *(const bf16x8*)(xb + (mt * 16 + (lane & 15)) * 272 + (32 * ks + 8 * (lane >> 4)) * 2);
        ya = __builtin_amdgcn_mfma_f32_16x16x32_bf16(cfrag[ks], xf, ya, 0, 0, 0);
      }
      const int sp = cprev * 32 + mt * 16 + (lane & 15);
      *(f32x4*)(Y + (size_t)g * ((size_t)NTOK * 16) + (size_t)(trow0 + dstep * sp) * 16 + (lane >> 4) * 4) = ya;
    }
  };
#pragma unroll 1
  for (int c = 0; c < nch; ++c) {
    const bf16x8 uf = as_bf16x8(un);
    if (c + 1 < nch) { const bf16_t* upn = up0 + (long)(c + 1) * ustep; un = *(const u32x4*)upn; }
    f32x16 xr[2], xi[2];
#pragma unroll
    for (int pb = 0; pb < 2; ++pb) {
#pragma unroll
      for (int i = 0; i < 16; ++i) { xr[pb][i] = 0.f; xi[pb][i] = 0.f; }
      xr[pb] = __builtin_amdgcn_mfma_f32_32x32x16_bf16(uf, bfrag[pb], xr[pb], 0, 0, 0);
      xi[pb] = __builtin_amdgcn_mfma_f32_32x32x16_bf16(uf, bfrag[2 + pb], xi[pb], 0, 0, 0);
    }
    if (FULL && c > 0) cproj(c - 1, xs + ((c - 1) & 1) * 8704);
    char* xw = xs + (c & 1) * 8704;
#pragma unroll
    for (int pb = 0; pb < 2; ++pb) {
      const float a1r = a1r_[pb], a1i = a1i_[pb];
      {
        const float c0r = lh ? 0.f : cr_[pb], c0i = lh ? 0.f : ci_[pb];
        xr[pb][0] += a1r * c0r - a1i * c0i;
        xi[pb][0] += a1r * c0i + a1i * c0r;
      }
#pragma unroll
      for (int i = 1; i < 16; ++i) {
        const float pr = xr[pb][i - 1], pi = xi[pb][i - 1];
        xr[pb][i] += a1r * pr - a1i * pi;
        xi[pb][i] += a1r * pi + a1i * pr;
      }
      const float hr = half_bcast(xr[pb][15], 0), hi = half_bcast(xi[pb][15], 0);
      const float c2r = lh ? hr : 0.f, c2i = lh ? hi : 0.f;
      if (FULL) {
        float fr_ = c2r, fi_ = c2i;
#pragma unroll
        for (int i = 0; i < 16; ++i) {
          const float nr = a1r * fr_ - a1i * fi_, ni = a1r * fi_ + a1i * fr_;
          fr_ = nr; fi_ = ni;
          xr[pb][i] += fr_;
          xi[pb][i] += fi_;
        }
      } else {
        xr[pb][15] += a16r_[pb] * c2r - a16i_[pb] * c2i;
        xi[pb][15] += a16r_[pb] * c2i + a16i_[pb] * c2r;
      }
      cr_[pb] = half_bcast(xr[pb][15], 1);
      ci_[pb] = half_bcast(xi[pb][15], 1);
      if (FULL) {
#pragma unroll
        for (int i = 0; i < 16; ++i) *(unsigned*)(xw + (16 * lh + i) * 272 + (pb * 32 + lr) * 4) = pack_bf16(xr[pb][i], xi[pb][i]);
      }
    }
    if (FULL) asm volatile("s_waitcnt lgkmcnt(0)" ::: "memory");
  }
  if (FULL) cproj(nch - 1, xs + ((nch - 1) & 1) * 8704);
}

__device__ __forceinline__ void s5_combine(const Params& p, int rowbase, int L, int g0, int ng) {
  const float* YF = (const float*)(p.ws + OFF_YF); const float* YB = (const float*)(p.ws + OFF_YB); const bf16_t* U = (const bf16_t*)(p.ws + OFF_U);
  bf16_t* YBF = (bf16_t*)(p.ws + OFF_YBF);
  const int T_ = opaque_tid(), l4 = L * 4;
#pragma unroll 1
  for (int bt = 0; bt < 2; ++bt) {
    f32x4 yf[4], yb[4], u[4], d[4]; size_t oo[4];
#pragma unroll
    for (int k = 0; k < 4; ++k) {
      const int i = T_ + 512 * (bt * 4 + k);
      const int q = i / l4, rem = i - q * l4, t = rem >> 2, c4 = (rem & 3) * 4;
      const size_t oi = (size_t)(g0 + q) * ((size_t)NTOK * 16) + (size_t)(rowbase + t) * 16 + c4;
      oo[k] = (size_t)(rowbase + t) * 512 + (g0 + q) * 16 + c4;
      yf[k] = *(const f32x4*)(YF + oi); yb[k] = *(const f32x4*)(YB + oi); { const u32x2 t = *(const u32x2*)(U + oi); u[k] = (f32x4){__uint_as_float(t[0] << 16), __uint_as_float(t[0] & 0xffff0000u), __uint_as_float(t[1] << 16), __uint_as_float(t[1] & 0xffff0000u)}; } d[k] = *(const f32x4*)(p.s5_d + (g0 + q) * 16 + c4);
    }
#pragma unroll
    for (int k = 0; k < 4; ++k) {
      float r[4];
#pragma unroll
      for (int e = 0; e < 4; ++e) r[e] = gelu_tanh(yf[k][e] + yb[k][e] + d[k][e] * u[k][e]);
      u32x2 w; w[0] = pack_bf16(r[0], r[1]); w[1] = pack_bf16(r[2], r[3]);
      *(u32x2*)(YBF + oo[k]) = w;
    }
  }
}

__device__ __forceinline__ void phase_mix0(const Params& p, char* smem, volatile LAS unsigned* st) {
  const int T_ = opaque_tid();
  const int wid = T_ >> 6, vb = T_ >> 8, vtid = T_ & 255, lane = T_ & 63, lr = lane & 31, lh = lane >> 5;
  unsigned* qctr = (unsigned*)(p.ws + OFF_BAR) + 16;
  float* ex = (float*)(smem + 8 * 17408);
  for (;;) {
    __syncthreads();
    if (T_ == 0) st[2] = __hip_atomic_fetch_add(qctr, 1u, __ATOMIC_RELAXED, __HIP_MEMORY_SCOPE_AGENT);
    __syncthreads();
    const int q_ = (int)st[2];
    if (q_ >= 768) break;
    const int item = q_ < 128 ? 384 + q_ : (q_ < 384 ? q_ : (q_ < 512 ? q_ - 384 : q_));
    if (item < 384) {
      const bool lat = item < 128;
      const int it = lat ? item : item - 128;
      const int d = lat ? (it & 1) : (wid & 1), seg = wid;
      const int b = lat ? (it >> 6) : (it >> 3);
      const int g0 = lat ? ((it >> 1) & 31) : (it & 7) * 4;
      const int g = lat ? g0 : g0 + (wid >> 1);
      const int rowbase = lat ? NP + b * LS : b * LP;
      const int trow0 = lat ? rowbase + (d ? LS - 1 - 128 * seg : 128 * seg) : rowbase + (d ? LP - 1 : 0);
      const int dstep = d ? -1 : 1, nch = lat ? 4 : 8;
      float cr_[2] = {0.f, 0.f}, ci_[2] = {0.f, 0.f};
      if (lat) {
        s5_scan<false>(p, trow0, dstep, nch, g, d, cr_, ci_, nullptr);
        if (lh == 0) {
#pragma unroll
          for (int pb = 0; pb < 2; ++pb) { ex[(seg * 2 + 0) * 64 + pb * 32 + lr] = cr_[pb]; ex[(seg * 2 + 1) * 64 + pb * 32 + lr] = ci_[pb]; }
        }
        __syncthreads();
        const float* AR = (const float*)(p.ws + OFF_AR); const float* AI = (const float*)(p.ws + OFF_AI);
        const float* s0 = p.state_s5 + (size_t)b * 8192;
#pragma unroll
        for (int pb = 0; pb < 2; ++pb) {
          const int pi = pb * 32 + lr;
          float ar = AR[(d * 32 + g) * 64 + pi], ai = AI[(d * 32 + g) * 64 + pi];
#pragma unroll
          for (int k = 0; k < 7; ++k) { const float nr = ar * ar - ai * ai, ni = 2.f * ar * ai; ar = nr; ai = ni; }
          float cr = s0[((d * 2 + 0) * 32 + g) * 64 + pi], ci = s0[((d * 2 + 1) * 32 + g) * 64 + pi];
          for (int j = 0; j < seg; ++j) {
            const float er = ex[(j * 2 + 0) * 64 + pi], ei = ex[(j * 2 + 1) * 64 + pi];
            const float nr = ar * cr - ai * ci + er, ni = ar * ci + ai * cr + ei;
            cr = nr; ci = ni;
          }
          cr_[pb] = cr; ci_[pb] = ci;
        }
      }
      s5_scan<true>(p, trow0, dstep, nch, g, d, cr_, ci_, smem + wid * 17408);
      if (!lat && lh == 0) {
        float* os = p.out + (size_t)NTOK * DM + (size_t)2 * NP * 512 + (size_t)b * 8192;
#pragma unroll
        for (int pb = 0; pb < 2; ++pb) { os[((d * 2 + 0) * 32 + g) * 64 + pb * 32 + lr] = cr_[pb]; os[((d * 2 + 1) * 32 + g) * 64 + pb * 32 + lr] = ci_[pb]; }
      }
      __syncthreads();
      if (!lat) s5_combine(p, rowbase, LP, g0, 4);
      else {
        asm volatile("s_waitcnt vmcnt(0)" ::: "memory");
        __syncthreads();
        if (T_ == 0) {
          __builtin_amdgcn_fence(__ATOMIC_RELEASE, "agent");
          asm volatile("s_waitcnt vmcnt(0)" ::: "memory");
          const unsigned old = __hip_atomic_fetch_add((unsigned*)(p.ws + OFF_BAR) + 32 + b * 32 + g0, 1u, __ATOMIC_RELAXED, __HIP_MEMORY_SCOPE_AGENT);
          __builtin_amdgcn_fence(__ATOMIC_ACQUIRE, "agent");
          asm volatile("s_waitcnt vmcnt(0)" ::: "memory");
          st[3] = old;
        }
        __syncthreads();
        if (st[3] == 1u) s5_combine(p, rowbase, LS, g0, 1);
      }
    } else {
      int vt = vtid; asm volatile("" : "+v"(vt));
      if (item < 512) {
        attn_item(p, item - 384, smem + vb * 34816, vt, vb ? 5 : 0, vb ? 9 : 5, 5, vb ? 1 : 2, smem + 34816);
      } else {
        attn_item(p, 128 + (item - 512) * 2 + vb, smem + vb * 34816, vt, 0, 2, 2, 0, nullptr);
      }
    }
  }
}

constexpr int LDS_GEMM = 131072;
constexpr int LDS_BYTES = 147456;

#define WSP ({ const unsigned long long _w = (unsigned long long)p.ws; unsigned _lo = __builtin_amdgcn_readfirstlane((unsigned)_w), _hi = __builtin_amdgcn_readfirstlane((unsigned)(_w >> 32)); asm volatile("" : "+s"(_lo), "+s"(_hi)); (char*)(((unsigned long long)_hi << 32) | _lo); })
#define MOD ((float*)(WSP + OFF_MOD))
#define SUMSQ ((float*)(WSP + OFF_SUMSQ))
#define GS ((const float*)(WSP + OFF_GS))
#define SHWGU ((const float*)(WSP + OFF_SHWGU))
#define SHWINO ((const float*)(WSP + OFF_SHWINO))
#define ABUF ((bf16_t*)(WSP + OFF_ABUF))
#define CAT ((bf16_t*)(WSP + OFF_CAT))
#define X ((bf16_t*)(WSP + OFF_X))
#define HFF ((bf16_t*)(WSP + OFF_HFF))
__global__ void __launch_bounds__(512, 2) mega(Params p) {
  extern __shared__ __attribute__((aligned(16))) unsigned char lds_raw[];
  LAS unsigned char* lds = (LAS unsigned char*)lds_raw;
  char* smem = (char*)lds_raw;
  volatile LAS unsigned* st = (volatile LAS unsigned*)(lds + LDS_BYTES - 256);
  if (threadIdx.x < 4) st[threadIdx.x] = 0u;
  __syncthreads();
  XcdBarrier bar = xcd_barrier_post((unsigned*)(WSP + OFF_BAR), st);
  SchedFlat sf;

  phase_prep(p, smem);
  xcd_barrier(bar);
  phase_norm(p, true, p.norm_mix_g, MOD + 0 * 3 * 6144 + 0 * 1024);
  xcd_barrier(bar);
  {
    EpiInEven ep{(bf16_t*)(WSP + OFF_QB), (bf16_t*)(WSP + OFF_KB), (bf16_t*)(WSP + OFF_VB), (float*)(WSP + OFF_U),
                 p.out + (size_t)NTOK * DM, p.out + (size_t)NTOK * DM + (size_t)NP * 512};
    sf.init(ABUF, DM, (const bf16_t*)(WSP + OFF_WT_IN), DM, NTOK, 2048, 0);
    gemm8(lds, DM, DM, DM, sf, ep);
  }
  phase_prep_late(p, smem, 0, 64);
  phase_prep_mod1(p, smem, 64);
  xcd_barrier(bar);
  phase_mix0(p, smem, st);
  xcd_barrier(bar);
  {
    const bf16_t* YBF = (const bf16_t*)(WSP + OFF_YBF);
    sf.init(YBF, 512, (const bf16_t*)(WSP + OFF_WT_GLU), 512, NTOK, 512, 0);
    gemm8<true>(lds, 512, 512, 512, SchedFlatTail{sf, 0}, EpiGlu<true>{YBF, p.glu_b, CAT});
  }
  phase_norm_consts(p, 0, 160);
  xcd_barrier(bar);
  sf.init(CAT, DM, (const bf16_t*)(WSP + OFF_WT_OUT), DM, NTOK, DM, 0);
  gemm8(lds, DM, DM, DM, sf, EpiResid{p.x_prompt, p.x_sample, nullptr, true, X, MOD + 2 * 1024, ABUF, GS, SUMSQ});
  phase_prep_dft(p, 160);
  phase_norm_consts(p, 1, 160);
  xcd_barrier(bar);
  sf.init(ABUF, DM, (const bf16_t*)(WSP + OFF_WT_GU), DM, NTOK, 5632, 0);
  sf.limit = 768;
  gemm8(lds, DM, DM, DM, sf, EpiSwiGLU<false>{HFF, SUMSQ, SHWGU});
  sf.limit = sf.nwg;
  gemm8<true>(lds, DM, DM, DM, SchedFlatTail{sf, 768}, EpiSwiGLU<true>{HFF, SUMSQ, SHWGU});
  xcd_barrier(bar);
  sf.init(HFF, DFF, (const bf16_t*)(WSP + OFF_WT_DN), DFF, NTOK, DM, 0);
  gemm8(lds, DFF, DFF, DFF, sf, EpiResid{p.x_prompt, p.x_sample, X, false, X, MOD + 5 * 1024, ABUF, GS + 3072, SUMSQ + NTOK});
  phase_prep_late(p, smem, 1, 160);
  xcd_barrier(bar);
  sf.init(ABUF, DM, (const bf16_t*)(WSP + OFF_WT_INO), DM, NTOK, DM, DM);
  gemm8(lds, DM, DM, DM, sf, EpiBf16Norm{(bf16_t*)(WSP + OFF_Z), SUMSQ + NTOK, SHWINO});
  phase_norm_consts(p, 2, 160);
  xcd_barrier(bar);
  gemm8(lds, 256, 256, DM, SchedF1{(const char*)(WSP + OFF_CS2), (const char*)(WSP + OFF_Z), (int)gridDim.x, (int)blockIdx.x}, EpiBf16{(bf16_t*)(WSP + OFF_OT)});
  xcd_barrier(bar);
  gemm8(lds, 512, 512, 512, SchedF2P{(const char*)(WSP + OFF_CL2P), (const char*)(WSP + OFF_OT), (int)blockIdx.x}, EpiBf16{CAT});
  gemm8<true>(lds, 2048, 2048, 2048, SchedF2S{(const char*)(WSP + OFF_CL2S), (const char*)(WSP + OFF_OT), (int)blockIdx.x}, EpiBf16Half{CAT});
  xcd_barrier(bar);
  sf.init(CAT, DM, (const bf16_t*)(WSP + OFF_WT_OUTO), DM, NTOK, DM, 0);
  gemm8(lds, DM, DM, DM, sf, EpiResid{p.x_prompt, p.x_sample, X, false, X, MOD + 3 * 6144 + 2 * 1024, ABUF, GS + 2 * 3072, SUMSQ + 2 * NTOK});
  xcd_barrier(bar);
  sf.init(ABUF, DM, (const bf16_t*)(WSP + OFF_WT_GU) + (size_t)5632 * 1024, DM, NTOK, 5632, 0);
  sf.limit = 768;
  gemm8(lds, DM, DM, DM, sf, EpiSwiGLU<false>{HFF, SUMSQ + 2 * NTOK, SHWGU + 3 * 5632});
  sf.limit = sf.nwg;
  gemm8<true>(lds, DM, DM, DM, SchedFlatTail{sf, 768}, EpiSwiGLU<true>{HFF, SUMSQ + 2 * NTOK, SHWGU + 3 * 5632});
  xcd_barrier(bar);
  sf.init(HFF, DFF, (const bf16_t*)(WSP + OFF_WT_DN) + (size_t)1024 * DFF, DFF, NTOK, DM, 0);
  gemm8(lds, DFF, DFF, DFF, sf, EpiFinal{X, MOD + 3 * 6144 + 5 * 1024, p.final_g, p.out, SUMSQ + 3 * NTOK, (unsigned*)(WSP + OFF_PCNT)});
}

extern "C" void kernel_launch(void* const* d_in, const int* in_sizes, int n_in, void* d_out, int out_size, void* d_ws, size_t ws_size, hipStream_t stream) {
  static int grid_blocks = 0;
  if (!grid_blocks) {
    int dev = 0, cus = 0, per_cu = 0;
    (void)hipGetDevice(&dev);
    (void)hipDeviceGetAttribute(&cus, hipDeviceAttributeMultiprocessorCount, dev);
    if (hipFuncSetAttribute((const void*)mega, hipFuncAttributeMaxDynamicSharedMemorySize, LDS_BYTES) != hipSuccess) fprintf(stderr, "hipFuncSetAttribute failed\n");
    (void)hipOccupancyMaxActiveBlocksPerMultiprocessor(&per_cu, mega, 512, LDS_BYTES);
    if (per_cu < 1) fprintf(stderr, "occupancy query reports %d blocks per CU\n", per_cu);
    (void)hipGetLastError();
    grid_blocks = cus;
  }
  if (ws_size < WS_NEED) { fprintf(stderr, "workspace too small: %zu < %zu\n", ws_size, (size_t)WS_NEED); return; }
  Params p{};
  const float** pp = (const float**)&p;
  for (int i = 0; i < 30; ++i) pp[i] = (const float*)d_in[i];
  p.out = (float*)d_out;
  p.ws = (char*)d_ws;
  (void)hipMemsetAsync((char*)d_ws + OFF_BAR, 0, ZERO_BYTES, stream);
  void* args[] = {&p};
  hipError_t e = hipLaunchCooperativeKernel((void*)mega, dim3(grid_blocks), dim3(512), args, LDS_BYTES, stream);
  if (e != hipSuccess) fprintf(stderr, "cooperative launch failed: %s (grid %d)\n", hipGetErrorString(e), grid_blocks);
}
```

```cpp
#include <hip/hip_runtime.h>
#include <cstdio>

typedef unsigned short bf16_t;
typedef short bf16x8 __attribute__((ext_vector_type(8)));
typedef float f32x4 __attribute__((ext_vector_type(4)));
typedef float f32x16 __attribute__((ext_vector_type(16)));
typedef unsigned u32x4 __attribute__((ext_vector_type(4)));
typedef unsigned u32x2 __attribute__((ext_vector_type(2)));

#ifndef N_LAUNCH_MODE
#define N_LAUNCH_MODE 1
#endif

constexpr int DM = 1024, NP = 8192, NL = 2048, NTOK = NP + NL, LP = 256, LS = 1024;
constexpr int DFF = 2816, NAW = 512, S5W = 512;
constexpr int NPHASE = 18;

constexpr size_t al256(size_t x) { return (x + 255) & ~(size_t)255; }
constexpr size_t OFF_MOD = 0;
constexpr size_t OFF_AR = al256(OFF_MOD + 2 * 3 * 6144 * 4);
constexpr size_t OFF_AI = al256(OFF_AR + 4096 * 4);
constexpr size_t OFF_BBAR = al256(OFF_AI + 4096 * 4);
constexpr size_t OFF_WT_IN = al256(OFF_BBAR + 131072 * 4);
constexpr size_t OFF_WT_GLU = al256(OFF_WT_IN + 2048 * 1024 * 2);
constexpr size_t OFF_WT_OUT = al256(OFF_WT_GLU + 512 * 512 * 2);
constexpr size_t OFF_WT_INO = al256(OFF_WT_OUT + 1024 * 1024 * 2);
constexpr size_t OFF_WT_OUTO = al256(OFF_WT_INO + 1024 * 1024 * 2);
constexpr size_t OFF_WT_GU = al256(OFF_WT_OUTO + 1024 * 1024 * 2);
constexpr size_t OFF_WT_DN = al256(OFF_WT_GU + (size_t)2 * 5632 * 1024 * 2);
constexpr size_t OFF_CS2 = al256(OFF_WT_DN + (size_t)2 * 1024 * 2816 * 2);
constexpr size_t OFF_CL2P = al256(OFF_CS2 + 512 * 256 * 2);
constexpr size_t OFF_CL2S = al256(OFF_CL2P + 256 * 512 * 2);
constexpr size_t OFF_ABUF = al256(OFF_CL2S + 1024 * 2048 * 2);
constexpr size_t OFF_CAT = al256(OFF_ABUF + (size_t)NTOK * 1024 * 2);
constexpr size_t OFF_X = al256(OFF_CAT + (size_t)NTOK * 1024 * 2);
constexpr size_t OFF_POOL = al256(OFF_X + (size_t)NTOK * 1024 * 4);
constexpr size_t OFF_QB = OFF_POOL;
constexpr size_t OFF_KB = OFF_QB + (size_t)NTOK * 512 * 2;
constexpr size_t OFF_VB = OFF_KB + (size_t)NTOK * 512 * 2;
constexpr size_t OFF_U = OFF_VB + (size_t)NTOK * 512 * 2;
constexpr size_t OFF_YF = OFF_U + (size_t)NTOK * 512 * 4;
constexpr size_t OFF_YB = OFF_YF + (size_t)NTOK * 512 * 4;
constexpr size_t POOL_END0 = OFF_YB + (size_t)NTOK * 512 * 4;
constexpr size_t OFF_HFF = OFF_POOL;
constexpr size_t OFF_Z = OFF_POOL;
constexpr size_t OFF_OT = OFF_Z + (size_t)NTOK * 1024 * 2;
constexpr size_t OFF_YBF = POOL_END0;
constexpr size_t OFF_BAR = al256(OFF_YBF + (size_t)NTOK * 512 * 2);
constexpr size_t OFF_SUMSQ = OFF_BAR + 16384;
constexpr size_t OFF_PCNT = OFF_SUMSQ + (size_t)4 * NTOK * 4;
constexpr size_t ZERO_BYTES = 16384 + (size_t)4 * NTOK * 4 + 40 * 256;
constexpr size_t OFF_GS = al256(OFF_PCNT + 40 * 256);
constexpr size_t OFF_SHWGU = al256(OFF_GS + 3 * 3 * 1024 * 4);
constexpr size_t OFF_SHWINO = al256(OFF_SHWGU + 2 * 3 * 5632 * 4);
constexpr size_t WS_NEED = al256(OFF_SHWINO + 3 * 1024 * 4);
static_assert(WS_NEED <= (size_t)256 * 1024 * 1024, "workspace");

struct Params {
  const float *x_prompt, *x_sample, *cache_k, *cache_v, *state_s5, *c, *c_ctx, *w_mod, *b_mod, *norm_mix_g, *norm_ffn_g,
      *w_in_even, *na_rpb, *lam_re, *lam_im, *log_step, *b_re, *b_im, *c_re, *c_im, *s5_d, *glu_w, *glu_b, *w_out_even,
      *w_in_odd, *w_out_odd, *w_gate, *w_up, *w_down, *final_g;
  float* out;
  char* ws;
};

typedef __bf16 bf16v2_t __attribute__((ext_vector_type(2)));
__device__ __forceinline__ unsigned pack_bf16(float lo, float hi) {
  bf16v2_t v = {(__bf16)lo, (__bf16)hi};
  return __builtin_bit_cast(unsigned, v);
}
__device__ __forceinline__ float bf2f(unsigned short h) { return __uint_as_float(((unsigned)h) << 16); }
__device__ __forceinline__ u32x4 pack8(f32x4 a, f32x4 b) {
  u32x4 r;
  r[0] = pack_bf16(a[0], a[1]); r[1] = pack_bf16(a[2], a[3]); r[2] = pack_bf16(b[0], b[1]); r[3] = pack_bf16(b[2], b[3]);
  return r;
}
__device__ __forceinline__ bf16x8 as_bf16x8(u32x4 v) { return __builtin_bit_cast(bf16x8, v); }
__device__ __forceinline__ float sigmoidf_(float x) { return 1.0f / (1.0f + __expf(-x)); }
__device__ __forceinline__ float siluf_(float x) { return x * sigmoidf_(x); }
__device__ __forceinline__ float gelu_tanh(float x) {
  const float u = 0.7978845608028654f * (x + 0.044715f * x * x * x);
  const float t = 1.0f - 2.0f / (1.0f + __expf(2.0f * u));
  return 0.5f * x * (1.0f + t);
}
__device__ __forceinline__ float half_bcast(float x, int which) {
  auto r = __builtin_amdgcn_permlane32_swap(__float_as_uint(x), __float_as_uint(x), false, false);
  return __uint_as_float(which ? r[1] : r[0]);
}
__device__ __forceinline__ float xor32(float x) {
  auto r = __builtin_amdgcn_permlane32_swap(__float_as_uint(x), __float_as_uint(x), false, false);
  return (threadIdx.x & 32) ? __uint_as_float(r[0]) : __uint_as_float(r[1]);
}
__device__ __forceinline__ int opaque_tid() { int t = threadIdx.x; asm volatile("" : "+v"(t)); return t; }
__device__ __forceinline__ int cond_index(int row) { return row < NP ? 0 : 1 + ((row - NP) >> 10); }
__device__ __forceinline__ const float* xin_row(const Params& p, int row) {
  return row < NP ? p.x_prompt + (size_t)row * DM : p.x_sample + (size_t)(row - NP) * DM;
}

#define LAS __attribute__((address_space(3)))
#define XB_TMO      128
#define XB_XCNT(j)  (256  + 64 * (j))
#define XB_XSUB(j)  (1280 + 64 * (j))
#define XB_XGEN(j)  (2304 + 64 * (j))
#define XB_TOP      3328
#define XB_TOPGEN   3392
#define XCD_BAR_WORDS 3456
#define XB_SPIN_CAP (1u << 22)
__device__ __forceinline__ unsigned xb_ld(unsigned* p)              { return __hip_atomic_load(p, __ATOMIC_RELAXED, __HIP_MEMORY_SCOPE_AGENT); }
__device__ __forceinline__ unsigned xb_add(unsigned* p, unsigned v) { return __hip_atomic_fetch_add(p, v, __ATOMIC_RELAXED, __HIP_MEMORY_SCOPE_AGENT); }
__device__ __forceinline__ unsigned xb_xcc_id() { return (unsigned)__builtin_amdgcn_s_getreg((3 << 11) | 20) & 0xFu; }
#define XB_SPIN(cond, bar) do { unsigned _sp = 0; while (cond) { __builtin_amdgcn_s_sleep(1); \
    if ((++_sp & 255u) == 0u) { if (xb_ld(&(bar)[XB_TMO])) break; if (_sp > XB_SPIN_CAP) { atomicAdd(&(bar)[XB_TMO], 1u); break; } } } } while (0)
struct XcdBarrier { unsigned* bar; unsigned x; volatile LAS unsigned* st; };
__device__ __forceinline__ XcdBarrier xcd_barrier_post(unsigned* bar, volatile LAS unsigned* st) {
  XcdBarrier b; b.bar = bar; b.x = xb_xcc_id(); b.st = st;
  if (threadIdx.x == 0) (void)xb_add(&bar[XB_XCNT(b.x)], 1u);
  return b;
}
__device__ __forceinline__ void xcd_barrier_complete(unsigned* bar, unsigned x, unsigned& nloc, unsigned& nx) {
  const unsigned G = gridDim.x * gridDim.y * gridDim.z;
  unsigned sum, cnt, mine, sp = 0u;
  for (;;) {
    sum = 0u; cnt = 0u; mine = 0u;
#pragma unroll
    for (unsigned j = 0; j < 16; ++j) { const unsigned c = xb_ld(&bar[XB_XCNT(j)]); sum += c; cnt += (c > 0u) ? 1u : 0u; mine = (j == x) ? c : mine; }
    if (sum == G) break;
    __builtin_amdgcn_s_sleep(1);
    if ((++sp & 255u) == 0u) { if (xb_ld(&bar[XB_TMO])) break; if (sp > XB_SPIN_CAP) { atomicAdd(&bar[XB_TMO], 1u); break; } }
  }
  nloc = mine > 0u ? mine : 1u; nx = cnt > 0u ? cnt : 1u;
}
__device__ __forceinline__ void xcd_barrier(const XcdBarrier& b) {
  asm volatile("s_waitcnt vmcnt(0)" ::: "memory");
  __syncthreads();
  if (threadIdx.x == 0) {
    unsigned* bar = b.bar;
    __builtin_amdgcn_s_waitcnt(0);
    unsigned nloc = b.st[0], nx = b.st[1];
    if (nloc == 0u) { xcd_barrier_complete(bar, b.x, nloc, nx); b.st[0] = nloc; b.st[1] = nx; }
    const unsigned old = xb_add(&bar[XB_XSUB(b.x)], 1u);
    const unsigned gen = old / nloc;
    if (old + 1u == (gen + 1u) * nloc) {
      __builtin_amdgcn_fence(__ATOMIC_RELEASE, "agent");
      asm volatile("s_waitcnt vmcnt(0)" ::: "memory");
      const unsigned og = xb_add(&bar[XB_TOP], 1u);
      const unsigned tg = og / nx;
      if (og + 1u == (tg + 1u) * nx) xb_add(&bar[XB_TOPGEN], 1u);
      else XB_SPIN(xb_ld(&bar[XB_TOPGEN]) == tg, bar);
      __builtin_amdgcn_fence(__ATOMIC_ACQUIRE, "agent");
      xb_add(&bar[XB_XGEN(b.x)], 1u);
      asm volatile("s_waitcnt vmcnt(0)" ::: "memory");
    } else {
      XB_SPIN(xb_ld(&bar[XB_XGEN(b.x)]) == gen, bar);
      __builtin_amdgcn_fence(__ATOMIC_ACQUIRE, "agent");
      asm volatile("s_waitcnt vmcnt(0)" ::: "memory");
    }
  }
  __syncthreads();
}

constexpr int G8_HTB = 128 * 64 * 2;
__device__ __forceinline__ int lds_byte(int r, int c) { const int st = (r >> 4) * 2 + (c >> 5), rr = r & 15, cc = c & 31, ob = rr * 64 + cc * 2; return st * 1024 + (ob ^ (((ob >> 9) & 1) << 5)); }
__device__ __forceinline__ void stage_rc(int b, int& R, int& C) { const int st = b / 1024, sb = b % 1024, swz = sb ^ (((sb >> 9) & 1) << 5); R = (st >> 1) * 16 + swz / 64; C = (st & 1) * 32 + (swz % 64) / 2; }
struct Unit { const char* a; const char* b; size_t cbase; int ldc; int pm, pn; int row0; };

template <bool HALF_M = false, class Epi, class Sched>
__device__ __forceinline__ void gemm8(LAS unsigned char* lds, int K, int lda, int ldb, const Sched& S, const Epi& E) {
  const int tid = opaque_tid(), wid = __builtin_amdgcn_readfirstlane(tid >> 6), lane = tid & 63, wr = wid >> 2, wc = wid & 3, fr = lane & 15, fq = lane >> 4;
  const int nt = K / 64;
  unsigned voffA[2], voffB[2];
#pragma unroll
  for (int i = 0; i < 2; ++i) { int R, C; stage_rc(tid * 16 + i * 8192, R, C);
    const int rho = R & 31, Rb = Epi::PERM ? ((R & ~31) + 8 * ((rho & 15) >> 2) + 4 * (rho >> 4) + (rho & 3)) : R;
    voffA[i] = (unsigned)(R * lda + C) * 2u; voffB[i] = (unsigned)(Rb * ldb + C) * 2u; }
  const size_t kstep = 128;
  const size_t hstepA = (size_t)128 * lda * 2, hstepB = (size_t)128 * ldb * 2;
  const unsigned ldsw = (unsigned)wid * 1024u;
  const int aoff = lds_byte(wr * 64 + fr, fq * 8), boff = lds_byte(wc * 32 + fr, fq * 8);
#define G8_SA(b, h) (((b) * 2 + (h)) * G8_HTB)
#define G8_SB(b, h) ((4 + (b) * 2 + (h)) * G8_HTB)
#define G8_STAGE(bufoff, gbase, voff) do { _Pragma("unroll") for (int _i = 0; _i < 2; ++_i) \
    __builtin_amdgcn_global_load_lds((const unsigned*)((const char*)(gbase) + (voff)[_i]), (LAS unsigned*)(lds + (bufoff) + ldsw + _i * 8192), 16, 0, 0); } while (0)
#define G8_LDA(dst, b, h) do { _Pragma("unroll") for (int m = 0; m < 4; ++m) _Pragma("unroll") for (int k = 0; k < 2; ++k) dst[m][k] = *(const LAS bf16x8*)(lds + G8_SA(b, h) + aoff + m * 2048 + k * 1024); } while (0)
#define G8_LDB(dst, b, h) do { _Pragma("unroll") for (int n = 0; n < 2; ++n) _Pragma("unroll") for (int k = 0; k < 2; ++k) dst[n][k] = *(const LAS bf16x8*)(lds + G8_SB(b, h) + boff + n * 2048 + k * 1024); } while (0)
#define G8_MMA(ai, bj, At, Bt) do { __builtin_amdgcn_s_setprio(1); _Pragma("unroll") for (int m = 0; m < 4; ++m) _Pragma("unroll") for (int n = 0; n < 2; ++n) _Pragma("unroll") for (int k = 0; k < 2; ++k) \
    acc[ai][bj][m][n] = __builtin_amdgcn_mfma_f32_16x16x32_bf16(Bt[n][k], At[m][k], acc[ai][bj][m][n], 0, 0, 0); __builtin_amdgcn_s_setprio(0); } while (0)
#define G8_WAIT_V(n) asm volatile("s_waitcnt vmcnt(" #n ")" ::: "memory")
#define G8_WAIT_L(n) asm volatile("s_waitcnt lgkmcnt(" #n ")" ::: "memory")
#define G8_BAR __builtin_amdgcn_s_barrier()
#define G8_SCHED __builtin_amdgcn_sched_barrier(0)
  Unit cur, nxt; int ui = 0;
  if (!S.next(0, cur)) return;
  f32x4 acc[2][2][4][2];
#pragma unroll
  for (int a = 0; a < 2; ++a)
#pragma unroll
    for (int b = 0; b < 2; ++b)
#pragma unroll
      for (int m = 0; m < 4; ++m)
#pragma unroll
        for (int n = 0; n < 2; ++n) acc[a][b][m][n] = (f32x4){0.f, 0.f, 0.f, 0.f};
  bf16x8 At[4][2], B0[2][2], B1[2][2];
  const char* cA = cur.a; const char* cB = cur.b;
  G8_STAGE(G8_SB(0, 0), cB, voffB); G8_STAGE(G8_SA(0, 0), cA, voffA); G8_STAGE(G8_SB(0, 1), cB + hstepB, voffB); G8_STAGE(G8_SA(0, 1), cA + hstepA, voffA);
  if (wr == 1) G8_BAR;
  G8_WAIT_V(4); G8_BAR;
  G8_STAGE(G8_SB(1, 0), cB + kstep, voffB); G8_STAGE(G8_SA(1, 0), cA + kstep, voffA); G8_STAGE(G8_SB(1, 1), cB + hstepB + kstep, voffB);
  G8_WAIT_V(6); G8_BAR;
  for (;;) {
    const bool has_next = S.next(ui + 1, nxt);
    const char* nA = has_next ? nxt.a : cA; const char* nB = has_next ? nxt.b : cB;
    for (int t = 0; t < nt; t += 2) {
      const bool last = (t == nt - 2);
      const char* a1 = cA + (size_t)(t + 1) * kstep;
      const char* a2 = last ? nA : cA + (size_t)(t + 2) * kstep; const char* b2 = last ? nB : cB + (size_t)(t + 2) * kstep;
      const char* a3 = a2 + kstep; const char* b3 = b2 + kstep;
      G8_LDB(B0, 0, 0); G8_SCHED; G8_LDA(At, 0, 0); G8_STAGE(G8_SA(1, 1), a1 + hstepA, voffA);
      G8_WAIT_L(8); G8_BAR; G8_WAIT_L(0); G8_MMA(0, 0, At, B0); G8_BAR; G8_SCHED;
      G8_LDB(B1, 0, 1); G8_STAGE(G8_SB(0, 0), b2, voffB);
      G8_BAR; G8_WAIT_L(0); G8_MMA(0, 1, At, B1); G8_BAR;
      if constexpr (!HALF_M) { G8_LDA(At, 0, 1); } G8_STAGE(G8_SA(0, 0), a2, voffA);
      G8_BAR; G8_WAIT_L(0); if constexpr (!HALF_M) { G8_MMA(1, 0, At, B0); } G8_BAR; G8_SCHED;
      G8_STAGE(G8_SB(0, 1), b2 + hstepB, voffB);
      G8_WAIT_V(6); G8_BAR; if constexpr (!HALF_M) { G8_MMA(1, 1, At, B1); } G8_BAR;
      G8_LDB(B0, 1, 0); G8_SCHED; G8_LDA(At, 1, 0); G8_STAGE(G8_SA(0, 1), a2 + hstepA, voffA);
      G8_WAIT_L(8); G8_BAR; G8_WAIT_L(0); G8_MMA(0, 0, At, B0); G8_BAR; G8_SCHED;
      G8_LDB(B1, 1, 1); G8_STAGE(G8_SB(1, 0), b3, voffB);
      G8_BAR; G8_WAIT_L(0); G8_MMA(0, 1, At, B1); G8_BAR;
      if constexpr (!HALF_M) { G8_LDA(At, 1, 1); } G8_STAGE(G8_SA(1, 0), a3, voffA);
      G8_BAR; G8_WAIT_L(0); if constexpr (!HALF_M) { G8_MMA(1, 0, At, B0); } G8_BAR; G8_SCHED;
      G8_STAGE(G8_SB(1, 1), b3 + hstepB, voffB);
      G8_WAIT_V(6); G8_BAR; if constexpr (!HALF_M) { G8_MMA(1, 1, At, B1); } G8_BAR;
    }
    if constexpr (!Epi::AFTER_DRAIN) E(acc, cur, wr, wc, fr, fq);
    if (!has_next) break;
#pragma unroll
    for (int a = 0; a < 2; ++a)
#pragma unroll
      for (int b = 0; b < 2; ++b)
#pragma unroll
        for (int m = 0; m < 4; ++m)
#pragma unroll
          for (int n = 0; n < 2; ++n) acc[a][b][m][n] = (f32x4){0.f, 0.f, 0.f, 0.f};
    cur = nxt; cA = nA; cB = nB; ++ui;
  }
  G8_WAIT_V(0);
  if (wr == 0) G8_BAR;
  G8_BAR;
  if constexpr (Epi::AFTER_DRAIN) E(acc, cur, wr, wc, fr, fq);
#undef G8_SA
#undef G8_SB
#undef G8_STAGE
#undef G8_LDA
#undef G8_LDB
#undef G8_MMA
#undef G8_WAIT_V
#undef G8_WAIT_L
#undef G8_BAR
#undef G8_SCHED
}

struct SchedFlat {
  const char *A, *B; size_t atstep, btstep; int ldc; int nM, nN, nwg, G, c, limit;
  __device__ __forceinline__ void init(const bf16_t* A_, int lda, const bf16_t* B_, int ldb, int M, int N, int ldc_) {
    A = (const char*)A_; B = (const char*)B_; atstep = (size_t)256 * lda * 2; btstep = (size_t)256 * ldb * 2; ldc = ldc_;
    nM = M / 256; nN = N / 256; nwg = nM * nN; G = gridDim.x; c = blockIdx.x; limit = nwg;
  }
  __device__ __forceinline__ void unit_at(int L, Unit& u) const {
    int wgid = L; { const int q = nwg / 8, r = nwg % 8, xcd = wgid % 8, off = wgid / 8; wgid = (xcd < r ? xcd * (q + 1) : r * (q + 1) + (xcd - r) * q) + off; }
    const int nig = 8 * nN, gid = wgid / nig, fm = gid * 8, gsz = (nM - fm) < 8 ? (nM - fm) : 8;
    u.pm = fm + ((wgid % nig) % gsz); u.pn = (wgid % nig) / gsz;
    u.a = A + (size_t)u.pm * atstep; u.b = B + (size_t)u.pn * btstep; u.ldc = ldc; u.cbase = (size_t)u.pm * 256 * ldc + (size_t)u.pn * 256; u.row0 = u.pm * 256;
  }
  __device__ __forceinline__ bool next(int i, Unit& u) const {
    const long L = (long)i * G + c; if (L >= limit) return false;
    unit_at((int)L, u);
    return true;
  }
};
struct SchedFlatTail {
  SchedFlat f; int first;
  __device__ __forceinline__ bool next(int i, Unit& u) const {
    const int Lh = i * f.G + f.c; if (Lh >= 2 * (f.nwg - first)) return false;
    f.unit_at(first + (Lh >> 1), u);
    if (Lh & 1) { u.a += f.atstep / 2; u.row0 += 128; u.cbase += (size_t)128 * f.ldc; }
    return true;
  }
};
struct SchedF1 {
  const char *CS2, *Z; int G, c;
  __device__ __forceinline__ bool next(int i, Unit& u) const {
    const int L = i * G + c; if (L >= 320) return false;
    int bg, pm, pn, Lseq, rowb; size_t obase;
    if (L < 256) { bg = L >> 1; pm = L & 1; pn = 0; Lseq = LP; rowb = (bg >> 2) * LP; obase = (size_t)bg * 512 * LP; }
    else { const int t = L - 256; bg = t >> 3; pm = (t >> 2) & 1; pn = t & 3; Lseq = LS; rowb = NP + (bg >> 2) * LS; obase = (size_t)128 * 512 * LP + (size_t)bg * 512 * LS; }
    u.pm = pm; u.pn = pn; u.ldc = Lseq;
    u.a = CS2 + (size_t)pm * 256 * 256 * 2;
    u.b = Z + ((size_t)(rowb + pn * 256) * DM + (bg & 3) * 256) * 2;
    u.cbase = obase + (size_t)pm * 256 * Lseq + (size_t)pn * 256;
    return true;
  }
};
struct SchedF2P {
  const char *CL, *OT; int c;
  __device__ __forceinline__ bool next(int i, Unit& u) const {
    if (i > 0 || c >= 128) return false;
    const int b = c >> 2, pn = c & 3;
    u.pm = 0; u.pn = pn; u.ldc = DM;
    u.a = CL; u.b = OT + ((size_t)b * 4 * 512 * LP + (size_t)pn * 256 * 512) * 2;
    u.cbase = (size_t)(b * LP) * DM + (size_t)pn * 256;
    return true;
  }
};
struct SchedF2S {
  const char *CL, *OT; int c;
  __device__ __forceinline__ bool next(int i, Unit& u) const {
    const int t = c - 128;
    if (i > 0 || t < 0 || t >= 64) return false;
    const int b = t >> 5, ph = (t >> 2) & 7, pn = t & 3;
    u.pm = ph; u.pn = pn; u.ldc = DM;
    u.a = CL + (size_t)ph * 128 * 2048 * 2;
    u.b = OT + ((size_t)128 * 512 * LP + (size_t)b * 4 * 512 * LS + (size_t)pn * 256 * 2048) * 2;
    u.cbase = (size_t)(NP + b * LS + ph * 128) * DM + (size_t)pn * 256;
    return true;
  }
};

template <class F>
__device__ __forceinline__ void epi_foreach(const f32x4 (&acc)[2][2][4][2], int wr, int wc, int fr, int fq, const F& f) {
#pragma unroll
  for (int ai = 0; ai < 2; ++ai)
#pragma unroll
    for (int m = 0; m < 4; ++m)
#pragma unroll
      for (int bj = 0; bj < 2; ++bj)
#pragma unroll
        for (int n = 0; n < 2; ++n) f(128 * ai + 64 * wr + 16 * m + fr, 128 * bj + 32 * wc + 16 * n + 4 * fq, acc[ai][bj][m][n]);
}
struct EpiBf16 {
  static constexpr bool AFTER_DRAIN = false, PERM = true;
  bf16_t* C;
  __device__ __forceinline__ void operator()(const f32x4 (&acc)[2][2][4][2], const Unit& u, int wr, int wc, int fr, int fq) const {
    bf16_t* base = C + u.cbase; const int ldc = u.ldc;
#pragma unroll
    for (int ai = 0; ai < 2; ++ai)
#pragma unroll
      for (int m = 0; m < 4; ++m)
#pragma unroll
        for (int bj = 0; bj < 2; ++bj) {
          const f32x4 v0 = acc[ai][bj][m][0], v1 = acc[ai][bj][m][1];
          u32x4 o; o[0] = pack_bf16(v0[0], v0[1]); o[1] = pack_bf16(v0[2], v0[3]); o[2] = pack_bf16(v1[0], v1[1]); o[3] = pack_bf16(v1[2], v1[3]);
          *(u32x4*)(base + (size_t)(128 * ai + 64 * wr + 16 * m + fr) * ldc + 128 * bj + 32 * wc + 8 * fq) = o;
        }
  }
};
struct EpiBf16Half {
  static constexpr bool AFTER_DRAIN = false, PERM = false;
  bf16_t* C;
  __device__ __forceinline__ void operator()(const f32x4 (&acc)[2][2][4][2], const Unit& u, int wr, int wc, int fr, int fq) const {
    bf16_t* base = C + u.cbase; const int ldc = u.ldc;
#pragma unroll
    for (int m = 0; m < 4; ++m)
#pragma unroll
      for (int bj = 0; bj < 2; ++bj)
#pragma unroll
        for (int n = 0; n < 2; ++n) {
          const f32x4 v = acc[0][bj][m][n];
          u32x2 o; o[0] = pack_bf16(v[0], v[1]); o[1] = pack_bf16(v[2], v[3]);
          *(u32x2*)(base + (size_t)(64 * wr + 16 * m + fr) * ldc + 128 * bj + 32 * wc + 16 * n + 4 * fq) = o;
        }
  }
};
struct EpiInEven {
  static constexpr bool AFTER_DRAIN = false, PERM = false;
  bf16_t *Q, *Kb, *Vb; float *U, *outk, *outv;
  __device__ __forceinline__ void operator()(const f32x4 (&acc)[2][2][4][2], const Unit& u, int wr, int wc, int fr, int fq) const {
    const int region = u.pn >> 1, cb = (u.pn & 1) * 256, rb = u.pm * 256;
    epi_foreach(acc, wr, wc, fr, fq, [&](int r, int c, f32x4 v) {
      const int row = rb + r, col = cb + c;
      if (region == 3) {
        { u32x2 uw; uw[0] = pack_bf16(v[0], v[1]); uw[1] = pack_bf16(v[2], v[3]); *(u32x2*)((bf16_t*)U + (size_t)(col >> 4) * ((size_t)NTOK * 16) + (size_t)row * 16 + (col & 15)) = uw; }
      } else {
        u32x2 o; o[0] = pack_bf16(v[0], v[1]); o[1] = pack_bf16(v[2], v[3]);
        bf16_t* dst = region == 0 ? Q : (region == 1 ? Kb : Vb);
        *(u32x2*)(dst + (size_t)row * 512 + col) = o;
        if (region != 0 && row < NP) {
          float* od = region == 1 ? outk : outv;
          *(f32x4*)(od + (size_t)row * 512 + col) = v;
        }
      }
    });
  }
};
template <bool FROM_INPUT>
struct EpiResid {
  static constexpr bool AFTER_DRAIN = false, PERM = true;
  const float *xp, *xs; const bf16_t* Xin; bf16_t* Xout; const float* gate;
  bf16_t* AB; const float* gs; float* sumsq;
  __device__ __forceinline__ void operator()(const f32x4 (&acc)[2][2][4][2], const Unit& u, int wr, int wc, int fr, int fq) const {
    const int rb = u.pm * 256, cb = u.pn * 256;
    const int ci = cond_index(rb);
    const int c0 = cb + 32 * wc + 8 * fq;
    f32x4 gt[2][2], g4[2][2];
#pragma unroll
    for (int bj = 0; bj < 2; ++bj)
#pragma unroll
      for (int n = 0; n < 2; ++n) {
        gt[bj][n] = *(const f32x4*)(gate + ci * 6144 + c0 + 128 * bj + 4 * n);
        g4[bj][n] = AB ? *(const f32x4*)(gs + ci * 1024 + c0 + 128 * bj + 4 * n) : (f32x4){0.f, 0.f, 0.f, 0.f};
      }
    const float* xbase = rb < NP ? xp + (size_t)rb * DM : xs + (size_t)(rb - NP) * DM;
    const bf16_t* xbb = Xin + (size_t)rb * DM;
    constexpr int RB = FROM_INPUT ? 2 : 4;
#pragma unroll
    for (int bt = 0; bt < 8 / RB; ++bt) {
      f32x4 xf[FROM_INPUT ? RB : 1][2][2];
      u32x4 xr[FROM_INPUT ? 1 : RB][2];
#pragma unroll
      for (int k = 0; k < RB; ++k)
#pragma unroll
        for (int bj = 0; bj < 2; ++bj) {
          const int lrow = bt * RB + k, ai = lrow >> 2, m = lrow & 3;
          const size_t xo = (size_t)(128 * ai + 64 * wr + 16 * m + fr) * DM + c0 + 128 * bj;
          if constexpr (FROM_INPUT) { xf[k][bj][0] = *(const f32x4*)(xbase + xo); xf[k][bj][1] = *(const f32x4*)(xbase + xo + 4); }
          else xr[k][bj] = *(const u32x4*)(xbb + xo);
        }
#pragma unroll
      for (int k = 0; k < RB; ++k) {
        const int lrow = bt * RB + k, ai = lrow >> 2, m = lrow & 3;
        const int row = rb + 128 * ai + 64 * wr + 16 * m + fr;
        float ss = 0.f;
#pragma unroll
        for (int bj = 0; bj < 2; ++bj) {
          const int col = c0 + 128 * bj;
          f32x4 x0, x1;
          if constexpr (FROM_INPUT) { x0 = xf[k][bj][0]; x1 = xf[k][bj][1]; }
          else {
            const u32x4 t = xr[k][bj];
            x0 = (f32x4){__uint_as_float(t[0] << 16), __uint_as_float(t[0] & 0xffff0000u), __uint_as_float(t[1] << 16), __uint_as_float(t[1] & 0xffff0000u)};
            x1 = (f32x4){__uint_as_float(t[2] << 16), __uint_as_float(t[2] & 0xffff0000u), __uint_as_float(t[3] << 16), __uint_as_float(t[3] & 0xffff0000u)};
          }
          f32x4 o[2];
#pragma unroll
          for (int e = 0; e < 4; ++e) { o[0][e] = x0[e] + gt[bj][0][e] * acc[ai][bj][m][0][e]; o[1][e] = x1[e] + gt[bj][1][e] * acc[ai][bj][m][1][e]; }
          { u32x4 xw; xw[0] = pack_bf16(o[0][0], o[0][1]); xw[1] = pack_bf16(o[0][2], o[0][3]); xw[2] = pack_bf16(o[1][0], o[1][1]); xw[3] = pack_bf16(o[1][2], o[1][3]);
            *(u32x4*)(Xout + (size_t)row * DM + col) = xw; }
          if (AB) {
#pragma unroll
            for (int n = 0; n < 2; ++n)
#pragma unroll
              for (int e = 0; e < 4; ++e) ss += o[n][e] * o[n][e];
            u32x4 w;
            w[0] = pack_bf16(o[0][0] * g4[bj][0][0], o[0][1] * g4[bj][0][1]); w[1] = pack_bf16(o[0][2] * g4[bj][0][2], o[0][3] * g4[bj][0][3]);
            w[2] = pack_bf16(o[1][0] * g4[bj][1][0], o[1][1] * g4[bj][1][1]); w[3] = pack_bf16(o[1][2] * g4[bj][1][2], o[1][3] * g4[bj][1][3]);
            *(u32x4*)(AB + (size_t)row * DM + col) = w;
          }
        }
        if (AB) {
          ss += __shfl_xor(ss, 16);
          ss += __shfl_xor(ss, 32);
          if (fq == 0) atomicAdd(sumsq + row, ss);
        }
      }
    }
  }
};
struct EpiFinal {
  static constexpr bool AFTER_DRAIN = true, PERM = true;
  const bf16_t* Xin; const float* gate; const float* gfin; float* out; float* sumsq; unsigned* pcnt;
  __device__ __forceinline__ void operator()(f32x4 (&acc)[2][2][4][2], const Unit& u, int wr, int wc, int fr, int fq) const {
    const int rb = u.pm * 256, cb = u.pn * 256;
    const int ci = cond_index(rb);
    const int c0 = cb + 32 * wc + 8 * fq;
    f32x4 gt[2][2];
#pragma unroll
    for (int bj = 0; bj < 2; ++bj)
#pragma unroll
      for (int n = 0; n < 2; ++n) gt[bj][n] = *(const f32x4*)(gate + ci * 6144 + c0 + 128 * bj + 4 * n);
    const bf16_t* xbase = Xin + (size_t)rb * DM;
#pragma unroll
    for (int am = 0; am < 4; ++am) {
      const int ai = am >> 1, m0 = (am & 1) * 2;
      f32x4 x[2][2][2];
#pragma unroll
      for (int mm = 0; mm < 2; ++mm)
#pragma unroll
        for (int bj = 0; bj < 2; ++bj) {
          const u32x4 t = *(const u32x4*)(xbase + (size_t)(128 * ai + 64 * wr + 16 * (m0 + mm) + fr) * DM + c0 + 128 * bj);
          x[mm][bj][0] = (f32x4){__uint_as_float(t[0] << 16), __uint_as_float(t[0] & 0xffff0000u), __uint_as_float(t[1] << 16), __uint_as_float(t[1] & 0xffff0000u)};
          x[mm][bj][1] = (f32x4){__uint_as_float(t[2] << 16), __uint_as_float(t[2] & 0xffff0000u), __uint_as_float(t[3] << 16), __uint_as_float(t[3] & 0xffff0000u)};
        }
#pragma unroll
      for (int mm = 0; mm < 2; ++mm) {
        const int m = m0 + mm;
        float ss = 0.f;
#pragma unroll
        for (int bj = 0; bj < 2; ++bj)
#pragma unroll
          for (int n = 0; n < 2; ++n) {
            f32x4 o;
#pragma unroll
            for (int e = 0; e < 4; ++e) { o[e] = x[mm][bj][n][e] + gt[bj][n][e] * acc[ai][bj][m][n][e]; ss += o[e] * o[e]; }
            acc[ai][bj][m][n] = o;
          }
        ss += __shfl_xor(ss, 16);
        ss += __shfl_xor(ss, 32);
        if (fq == 0) atomicAdd(sumsq + rb + 128 * ai + 64 * wr + 16 * m + fr, ss);
      }
    }
    asm volatile("s_waitcnt vmcnt(0)" ::: "memory");
    unsigned* pc = pcnt + u.pm * 64;
    if ((threadIdx.x & 63) == 0) __hip_atomic_fetch_add(pc, 1u, __ATOMIC_RELAXED, __HIP_MEMORY_SCOPE_AGENT);
    {
      unsigned spins = 0;
      while ((unsigned)__builtin_amdgcn_readfirstlane(__hip_atomic_load(pc, __ATOMIC_RELAXED, __HIP_MEMORY_SCOPE_AGENT)) < 32u) {
        __builtin_amdgcn_s_sleep(2);
        if (++spins > (1u << 22)) break;
      }
    }
    f32x4 gf[2][2];
#pragma unroll
    for (int bj = 0; bj < 2; ++bj)
#pragma unroll
      for (int n = 0; n < 2; ++n) gf[bj][n] = *(const f32x4*)(gfin + c0 + 128 * bj + 4 * n);
    float sq[2][4];
#pragma unroll
    for (int ai = 0; ai < 2; ++ai)
#pragma unroll
      for (int m = 0; m < 4; ++m) sq[ai][m] = __hip_atomic_load(sumsq + rb + 128 * ai + 64 * wr + 16 * m + fr, __ATOMIC_RELAXED, __HIP_MEMORY_SCOPE_AGENT);
#pragma unroll
    for (int ai = 0; ai < 2; ++ai)
#pragma unroll
      for (int m = 0; m < 4; ++m) {
        const int row = rb + 128 * ai + 64 * wr + 16 * m + fr;
        const float rs = rsqrtf(sq[ai][m] * (1.0f / DM) + 1e-6f);
#pragma unroll
        for (int bj = 0; bj < 2; ++bj)
#pragma unroll
          for (int n = 0; n < 2; ++n) {
            f32x4 y;
#pragma unroll
            for (int e = 0; e < 4; ++e) y[e] = acc[ai][bj][m][n][e] * rs * gf[bj][n][e];
            *(f32x4*)(out + (size_t)row * DM + c0 + 128 * bj + 4 * n) = y;
          }
      }
  }
};
template <bool HALF>
struct EpiSwiGLU {
  static constexpr bool AFTER_DRAIN = false, PERM = false;
  bf16_t* H; const float* sumsq; const float* shw;
  __device__ __forceinline__ void operator()(const f32x4 (&acc)[2][2][4][2], const Unit& u, int wr, int wc, int fr, int fq) const {
    const int rb = u.row0;
    const float* sw = shw + cond_index(rb) * 5632 + u.pn * 256 + 32 * wc + 4 * fq;
    f32x4 sg[2], su[2];
#pragma unroll
    for (int bj = 0; bj < 2; ++bj) { sg[bj] = *(const f32x4*)(sw + 128 * bj); su[bj] = *(const f32x4*)(sw + 128 * bj + 16); }
    float rstd[2][4];
#pragma unroll
    for (int ai = 0; ai < (HALF ? 1 : 2); ++ai)
#pragma unroll
      for (int m = 0; m < 4; ++m) rstd[ai][m] = sumsq[rb + 128 * ai + 64 * wr + 16 * m + fr];
#pragma unroll
    for (int ai = 0; ai < (HALF ? 1 : 2); ++ai)
#pragma unroll
      for (int m = 0; m < 4; ++m) {
        const int row = rb + 128 * ai + 64 * wr + 16 * m + fr;
        const float rs = rsqrtf(rstd[ai][m] * (1.0f / DM) + 1e-6f);
#pragma unroll
        for (int bj = 0; bj < 2; ++bj) {
          const int col = (u.pn * 256 + 128 * bj + 32 * wc) / 2 + 4 * fq;
          float o[4];
#pragma unroll
          for (int e = 0; e < 4; ++e) o[e] = siluf_(rs * acc[ai][bj][m][0][e] + sg[bj][e]) * (rs * acc[ai][bj][m][1][e] + su[bj][e]);
          u32x2 w; w[0] = pack_bf16(o[0], o[1]); w[1] = pack_bf16(o[2], o[3]);
          *(u32x2*)(H + (size_t)row * DFF + col) = w;
        }
      }
  }
};
struct EpiBf16Norm {
  static constexpr bool AFTER_DRAIN = false, PERM = true;
  bf16_t* C; const float* sumsq; const float* shw;
  __device__ __forceinline__ void operator()(const f32x4 (&acc)[2][2][4][2], const Unit& u, int wr, int wc, int fr, int fq) const {
    const int rb = u.pm * 256, c0 = u.pn * 256 + 32 * wc + 8 * fq;
    const float* sw = shw + cond_index(rb) * 1024 + c0;
    f32x4 sh[2][2];
#pragma unroll
    for (int bj = 0; bj < 2; ++bj)
#pragma unroll
      for (int n = 0; n < 2; ++n) sh[bj][n] = *(const f32x4*)(sw + 128 * bj + 4 * n);
    float rstd[2][4];
#pragma unroll
    for (int ai = 0; ai < 2; ++ai)
#pragma unroll
      for (int m = 0; m < 4; ++m) rstd[ai][m] = sumsq[rb + 128 * ai + 64 * wr + 16 * m + fr];
#pragma unroll
    for (int ai = 0; ai < 2; ++ai)
#pragma unroll
      for (int m = 0; m < 4; ++m) {
        const int row = rb + 128 * ai + 64 * wr + 16 * m + fr;
        const float rs = rsqrtf(rstd[ai][m] * (1.0f / DM) + 1e-6f);
#pragma unroll
        for (int bj = 0; bj < 2; ++bj) {
          const f32x4 v0 = acc[ai][bj][m][0], v1 = acc[ai][bj][m][1];
          u32x4 w;
          w[0] = pack_bf16(rs * v0[0] + sh[bj][0][0], rs * v0[1] + sh[bj][0][1]); w[1] = pack_bf16(rs * v0[2] + sh[bj][0][2], rs * v0[3] + sh[bj][0][3]);
          w[2] = pack_bf16(rs * v1[0] + sh[bj][1][0], rs * v1[1] + sh[bj][1][1]); w[3] = pack_bf16(rs * v1[2] + sh[bj][1][2], rs * v1[3] + sh[bj][1][3]);
          *(u32x4*)(C + (size_t)row * DM + c0 + 128 * bj) = w;
        }
      }
  }
};
template <bool HALF>
struct EpiGlu {
  static constexpr bool AFTER_DRAIN = false, PERM = true;
  const bf16_t* YBF; const float* bias; bf16_t* CAT;
  __device__ __forceinline__ void operator()(const f32x4 (&acc)[2][2][4][2], const Unit& u, int wr, int wc, int fr, int fq) const {
    const int rb = u.row0, c0 = u.pn * 256 + 32 * wc + 8 * fq;
    f32x4 bb[2][2];
#pragma unroll
    for (int bj = 0; bj < 2; ++bj)
#pragma unroll
      for (int n = 0; n < 2; ++n) bb[bj][n] = *(const f32x4*)(bias + c0 + 128 * bj + 4 * n);
#pragma unroll
    for (int ai = 0; ai < (HALF ? 1 : 2); ++ai) {
      u32x4 yy[4][2];
#pragma unroll
      for (int m = 0; m < 4; ++m)
#pragma unroll
        for (int bj = 0; bj < 2; ++bj) yy[m][bj] = *(const u32x4*)(YBF + (size_t)(rb + 128 * ai + 64 * wr + 16 * m + fr) * 512 + c0 + 128 * bj);
#pragma unroll
      for (int m = 0; m < 4; ++m) {
        const int row = rb + 128 * ai + 64 * wr + 16 * m + fr;
#pragma unroll
        for (int bj = 0; bj < 2; ++bj) {
          u32x4 w;
#pragma unroll
          for (int n = 0; n < 2; ++n) {
            const f32x4 v = acc[ai][bj][m][n]; const f32x4 b = bb[bj][n];
            const unsigned ya = yy[m][bj][2 * n], yb = yy[m][bj][2 * n + 1];
            const float y0 = __uint_as_float(ya << 16), y1 = __uint_as_float(ya & 0xffff0000u), y2 = __uint_as_float(yb << 16), y3 = __uint_as_float(yb & 0xffff0000u);
            w[2 * n] = pack_bf16(y0 * sigmoidf_(v[0] + b[0]), y1 * sigmoidf_(v[1] + b[1]));
            w[2 * n + 1] = pack_bf16(y2 * sigmoidf_(v[2] + b[2]), y3 * sigmoidf_(v[3] + b[3]));
          }
          *(u32x4*)(CAT + (size_t)row * DM + 512 + c0 + 128 * bj) = w;
        }
      }
    }
  }
};

__device__ __forceinline__ void prep_mod_item(const Params& p, int item, char* smem, int tid) {
  const int layer = item / 96, cg64 = item % 96;
  const int kg = tid >> 4, l16 = tid & 15;
  float* sc = (float*)smem;
  float* red = (float*)(smem + 12288);
  __syncthreads();
  for (int i = tid; i < 3072; i += 256) {
    const int ci = i >> 10, k = i & 1023;
    const float cv = ci == 0 ? p.c_ctx[k] : p.c[(ci - 1) * DM + k];
    sc[i] = siluf_(cv);
  }
  __syncthreads();
  const int col = cg64 * 64 + l16 * 4;
  const float* w = p.w_mod + ((size_t)layer * DM + kg * 64) * 6144 + col;
  float a[3][4];
#pragma unroll
  for (int ci = 0; ci < 3; ++ci)
#pragma unroll
    for (int e = 0; e < 4; ++e) a[ci][e] = 0.f;
#pragma unroll 8
  for (int r = 0; r < 64; ++r) {
    const f32x4 wv = *(const f32x4*)(w + (size_t)r * 6144);
#pragma unroll
    for (int ci = 0; ci < 3; ++ci) {
      const float s = sc[ci * 1024 + kg * 64 + r];
#pragma unroll
      for (int e = 0; e < 4; ++e) a[ci][e] += s * wv[e];
    }
  }
#pragma unroll
  for (int ci = 0; ci < 3; ++ci)
#pragma unroll
    for (int e = 0; e < 4; ++e) red[(kg * 3 + ci) * 64 + l16 * 4 + e] = a[ci][e];
  __syncthreads();
  if (tid < 192) {
    const int ci = tid >> 6, c = tid & 63;
    float sum = p.b_mod[layer * 6144 + cg64 * 64 + c];
#pragma unroll
    for (int k2 = 0; k2 < 16; ++k2) sum += red[(k2 * 3 + ci) * 64 + c];
    ((float*)(p.ws + OFF_MOD))[(size_t)(layer * 3 + ci) * 6144 + cg64 * 64 + c] = sum;
  }
}

__device__ __forceinline__ void prep_transpose_tile(const float* src, int K, int N, bf16_t* dst, int kt, int nt, int mapmode, char* smem, int tid) {
  float* T = (float*)smem;
  __syncthreads();
#pragma unroll
  for (int i = 0; i < 4; ++i) {
    const int idx = tid + 256 * i, kr = idx >> 4, c4 = idx & 15;
    const f32x4 v = *(const f32x4*)(src + (size_t)(kt * 64 + kr) * N + nt * 64 + c4 * 4);
#pragma unroll
    for (int e = 0; e < 4; ++e) T[kr * 65 + c4 * 4 + e] = v[e];
  }
  __syncthreads();
#pragma unroll
  for (int i = 0; i < 2; ++i) {
    const int idx = tid + 256 * i, nr = idx >> 3, seg = idx & 7;
    f32x4 a, b;
#pragma unroll
    for (int e = 0; e < 4; ++e) { a[e] = T[(seg * 8 + e) * 65 + nr]; b[e] = T[(seg * 8 + 4 + e) * 65 + nr]; }
    const int n = nt * 64 + nr;
    int drow = n;
    if (mapmode == 1) drow = (n >> 4) * 32 + (n & 15);
    else if (mapmode == 2) drow = (n >> 4) * 32 + 16 + (n & 15);
    *(u32x4*)(dst + (size_t)drow * K + kt * 64 + seg * 8) = pack8(a, b);
  }
}

__device__ __forceinline__ void prep_s5_item(const Params& p, int item, int tid) {
  const int idx = item * 256 + tid;
  const int d = idx >> 11, g = (idx >> 6) & 31;
  const float lr = fminf(p.lam_re[idx], -1e-4f), li = p.lam_im[idx];
  const float dt = expf(p.log_step[d * 32 + g]);
  const float mag = expf(lr * dt);
  const float ar = mag * cosf(li * dt), ai = mag * sinf(li * dt);
  const float den = lr * lr + li * li, nr = ar - 1.0f, ni = ai;
  const float cr = (nr * lr + ni * li) / den, ci = (ni * lr - nr * li) / den;
  ((float*)(p.ws + OFF_AR))[idx] = ar;
  ((float*)(p.ws + OFF_AI))[idx] = ai;
  float* bb = (float*)(p.ws + OFF_BBAR);
  const int pp = idx & 63;
  const size_t o0 = ((size_t)((d * 32 + g) * 2 + 0) * 64 + pp) * 16, o1 = ((size_t)((d * 32 + g) * 2 + 1) * 64 + pp) * 16;
  for (int h = 0; h < 16; ++h) {
    const float br = p.b_re[(size_t)idx * 16 + h], bi = p.b_im[(size_t)idx * 16 + h];
    bb[o0 + h] = cr * br - ci * bi;
    bb[o1 + h] = cr * bi + ci * br;
  }
}

__device__ __forceinline__ void prep_dft_item(const Params& p, int item, int tid) {
  bf16_t* dst; int e0;
  int mode;
  if (item < 64) { dst = (bf16_t*)(p.ws + OFF_CS2); e0 = item * 2048 + tid * 8; mode = 0; }
  else if (item < 128) { dst = (bf16_t*)(p.ws + OFF_CL2P); e0 = (item - 64) * 2048 + tid * 8; mode = 1; }
  else { dst = (bf16_t*)(p.ws + OFF_CL2S); e0 = (item - 128) * 2048 + tid * 8; mode = 2; }
  float v[8];
#pragma unroll
  for (int j = 0; j < 8; ++j) {
    const int e = e0 + j;
    float s, c;
    if (mode == 0) {
      const int row = e >> 8, cc = e & 255, kc = row >> 1, cs = row & 1;
      const int ph = (kc * cc) & 255;
      sincospif((float)ph * (2.0f / 256.0f), &s, &c);
      v[j] = (cs ? s : c) * (1.0f / 16.0f);
    } else if (mode == 1) {
      const int kl = e >> 9, r = e & 511, cs = r >> 8, l = r & 255;
      const int ph = (kl * l) & 255;
      sincospif((float)ph * (2.0f / 256.0f), &s, &c);
      v[j] = (cs ? -s : c) * (1.0f / 16.0f);
    } else {
      const int kl = e >> 11, r = e & 2047, cs = r >> 10, l = r & 1023;
      const int ph = (kl * l) & 1023;
      sincospif((float)ph * (2.0f / 1024.0f), &s, &c);
      v[j] = (cs ? -s : c) * (1.0f / 32.0f);
    }
  }
  u32x4 o; o[0] = pack_bf16(v[0], v[1]); o[1] = pack_bf16(v[2], v[3]); o[2] = pack_bf16(v[4], v[5]); o[3] = pack_bf16(v[6], v[7]);
  *(u32x4*)(dst + e0) = o;
}

__device__ __forceinline__ void prep_transpose_job(const Params& p, int job, int t, char* smem, int tid) {
  if (job == 0) prep_transpose_tile(p.w_in_even, 1024, 2048, (bf16_t*)(p.ws + OFF_WT_IN), t / 32, t % 32, 0, smem, tid);
  else if (job == 1) prep_transpose_tile(p.glu_w, 512, 512, (bf16_t*)(p.ws + OFF_WT_GLU), t / 8, t % 8, 0, smem, tid);
  else if (job <= 4) {
    const float* src = job == 2 ? p.w_out_even : (job == 3 ? p.w_in_odd : p.w_out_odd);
    const size_t off = job == 2 ? OFF_WT_OUT : (job == 3 ? OFF_WT_INO : OFF_WT_OUTO);
    prep_transpose_tile(src, 1024, 1024, (bf16_t*)(p.ws + off), t / 16, t % 16, 0, smem, tid);
  } else if (job <= 8) {
    const int layer = (job - 5) & 1, isup = (job - 5) >> 1;
    const float* src = (isup ? p.w_up : p.w_gate) + (size_t)layer * 1024 * DFF;
    prep_transpose_tile(src, 1024, DFF, (bf16_t*)(p.ws + OFF_WT_GU) + (size_t)layer * 5632 * 1024, t / 44, t % 44, 1 + isup, smem, tid);
  } else {
    const int layer = job - 9;
    prep_transpose_tile(p.w_down + (size_t)layer * DFF * 1024, DFF, 1024, (bf16_t*)(p.ws + OFF_WT_DN) + (size_t)layer * 1024 * DFF, t / 16, t % 16, 0, smem, tid);
  }
}
constexpr int TR_EARLY = 512;
constexpr int TR_MID = 64 + 256 + 256 + 3 * 704;
constexpr int TR_LATE = 256 + 3 * 704;
__device__ __forceinline__ void prep_transpose_early(const Params& p, int t, char* smem, int tid) {
  prep_transpose_job(p, 0, t, smem, tid);
}
__device__ __forceinline__ void prep_transpose_mid(const Params& p, int t, char* smem, int tid) {
  int job;
  if (t < 64) job = 1; else if ((t -= 64) < 256) job = 2; else if ((t -= 256) < 256) job = 3;
  else if ((t -= 256) < 704) job = 5; else if ((t -= 704) < 704) job = 7; else { t -= 704; job = 9; }
  prep_transpose_job(p, job, t, smem, tid);
}
__device__ __forceinline__ void prep_transpose_late(const Params& p, int t, char* smem, int tid) {
  int job;
  if (t < 256) job = 4; else if ((t -= 256) < 704) job = 6; else if ((t -= 704) < 704) job = 8; else { t -= 704; job = 10; }
  prep_transpose_job(p, job, t, smem, tid);
}

__device__ __forceinline__ void phase_prep(const Params& p, char* smem0) {
  constexpr int T0 = 96;
  constexpr int S0 = T0 + TR_EARLY, TOTAL = S0 + 16;
  static_assert((T0 % 2) == 0 && (TR_EARLY % 2) == 0 && (TOTAL % 2) == 0, "even");
  const int T_ = opaque_tid();
  const int vb = T_ >> 8, tid = T_ & 255;
  char* smem = smem0 + vb * 32768;
  for (int item0 = blockIdx.x * 2; item0 < TOTAL; item0 += gridDim.x * 2) {
    const int item = item0 + vb;
    if (item < T0) prep_mod_item(p, item, smem, tid);
    else if (item < S0) prep_transpose_early(p, item - T0, smem, tid);
    else prep_s5_item(p, item - S0, tid);
  }
}
__device__ __forceinline__ void phase_prep_mod1(const Params& p, char* smem0, int first_block) {
  if ((int)blockIdx.x < first_block) return;
  const int T_ = opaque_tid();
  const int vb = T_ >> 8, tid = T_ & 255;
  char* smem = smem0 + vb * 32768;
  const int nb = gridDim.x - first_block;
  for (int item0 = ((int)blockIdx.x - first_block) * 2; item0 < 96; item0 += nb * 2) prep_mod_item(p, 96 + item0 + vb, smem, tid);
}
__device__ __forceinline__ void phase_prep_dft(const Params& p, int first_block) {
  if ((int)blockIdx.x < first_block) return;
  const int T_ = opaque_tid();
  const int vb = T_ >> 8, tid = T_ & 255;
  const int nb = gridDim.x - first_block;
  for (int item0 = ((int)blockIdx.x - first_block) * 2; item0 < 1152; item0 += nb * 2) prep_dft_item(p, item0 + vb, tid);
}
__device__ __forceinline__ void phase_prep_late(const Params& p, char* smem0, int which, int first_block) {
  if ((int)blockIdx.x < first_block) return;
  const int T_ = opaque_tid();
  const int vb = T_ >> 8, tid = T_ & 255;
  char* smem = smem0 + vb * 32768;
  const int nb = gridDim.x - first_block, total = which ? TR_LATE : TR_MID;
  for (int item0 = ((int)blockIdx.x - first_block) * 2; item0 < total; item0 += nb * 2) {
    if (which) prep_transpose_late(p, item0 + vb, smem, tid); else prep_transpose_mid(p, item0 + vb, smem, tid);
  }
}

__device__ __forceinline__ void phase_norm(const Params& p, bool from_input, const float* gvec, const float* modbase  ) {
  const int T_ = opaque_tid();
  const int lane = T_ & 63, wid = T_ >> 6;
  const float* X = (const float*)(p.ws + OFF_X);
  bf16_t* A = (bf16_t*)(p.ws + OFF_ABUF);
  for (int row = blockIdx.x * 8 + wid; row < NTOK; row += gridDim.x * 8) {
    const float* xr = from_input ? xin_row(p, row) : X + (size_t)row * DM;
    f32x4 v[4];
    float ss = 0.f;
#pragma unroll
    for (int i = 0; i < 4; ++i) {
      v[i] = *(const f32x4*)(xr + i * 256 + lane * 4);
#pragma unroll
      for (int e = 0; e < 4; ++e) ss += v[i][e] * v[i][e];
    }
#pragma unroll
    for (int o = 32; o >= 1; o >>= 1) ss += __shfl_xor(ss, o);
    const float rstd = rsqrtf(ss * (1.0f / DM) + 1e-6f);
    const float* mb = modbase + cond_index(row) * 6144;
#pragma unroll
    for (int i = 0; i < 4; ++i) {
      const int k = i * 256 + lane * 4;
      const f32x4 g = *(const f32x4*)(gvec + k), sh = *(const f32x4*)(mb + k), sc = *(const f32x4*)(mb + 1024 + k);
      float o[4];
#pragma unroll
      for (int e = 0; e < 4; ++e) o[e] = v[i][e] * rstd * g[e] * (1.0f + sc[e]) + sh[e];
      u32x2 w; w[0] = pack_bf16(o[0], o[1]); w[1] = pack_bf16(o[2], o[3]);
      *(u32x2*)(A + (size_t)row * DM + k) = w;
    }
  }
}
__device__ __forceinline__ void phase_norm_consts(const Params& p, int part, int first_block) {
  const int T_ = opaque_tid();
  const int lane = T_ & 63, wid = T_ >> 6;
  const float* MOD = (const float*)(p.ws + OFF_MOD);
  float* GS = (float*)(p.ws + OFF_GS);
  const int nblk = (int)gridDim.x - first_block, blk = (int)blockIdx.x - first_block;
  if (blk < 0) return;
  if (part < 2) {
    const int i0 = part == 0 ? 0 : 3072, i1 = part == 0 ? 3072 : 9216;
    for (int i = i0 + blk * 512 + T_; i < i1; i += nblk * 512) {
      const int uu = i / 3072, ci = (i >> 10) % 3, k = i & 1023;
      const float* gvec = uu == 0 ? p.norm_ffn_g : (uu == 1 ? p.norm_mix_g + DM : p.norm_ffn_g + DM);
      const int layer = uu == 0 ? 0 : 1, j = uu == 1 ? 1 : 4;
      GS[i] = gvec[k] * (1.0f + MOD[(size_t)(layer * 3 + ci) * 6144 + j * 1024 + k]);
    }
  }
  const int rbase = part == 0 ? 0 : (part == 2 ? 5632 : 11264), rcnt = part == 1 ? 1024 : 5632;
  for (int r0 = blk * 8 + wid; r0 < rcnt; r0 += nblk * 8) {
    const int row = rbase + r0;
    const bf16_t* wrow; const float* sh; float* dst; int dstride;
    if (row < 2 * 5632) {
      const int layer = row / 5632, n = row - layer * 5632;
      wrow = (const bf16_t*)(p.ws + OFF_WT_GU) + (size_t)row * 1024;
      sh = MOD + (size_t)layer * 3 * 6144 + 3 * 1024;
      dst = (float*)(p.ws + OFF_SHWGU) + (size_t)layer * 3 * 5632 + n; dstride = 5632;
    } else {
      const int n = row - 2 * 5632;
      wrow = (const bf16_t*)(p.ws + OFF_WT_INO) + (size_t)n * 1024;
      sh = MOD + (size_t)3 * 6144;
      dst = (float*)(p.ws + OFF_SHWINO) + n; dstride = 1024;
    }
    const u32x4 w0 = *(const u32x4*)(wrow + lane * 16), w1 = *(const u32x4*)(wrow + lane * 16 + 8);
    float wf[16];
#pragma unroll
    for (int q = 0; q < 4; ++q) { wf[2 * q] = __uint_as_float(w0[q] << 16); wf[2 * q + 1] = __uint_as_float(w0[q] & 0xffff0000u); wf[8 + 2 * q] = __uint_as_float(w1[q] << 16); wf[8 + 2 * q + 1] = __uint_as_float(w1[q] & 0xffff0000u); }
#pragma unroll
    for (int ci = 0; ci < 3; ++ci) {
      float acc = 0.f;
#pragma unroll
      for (int q = 0; q < 4; ++q) {
        const f32x4 sv = *(const f32x4*)(sh + ci * 6144 + lane * 16 + q * 4);
#pragma unroll
        for (int e = 0; e < 4; ++e) acc += wf[q * 4 + e] * sv[e];
      }
#pragma unroll
      for (int o = 32; o >= 1; o >>= 1) acc += __shfl_xor(acc, o);
      if (lane == 0) dst[ci * dstride] = acc;
    }
  }
}

__device__ __forceinline__ void phase_final_norm(const Params& p) {
  const int T_ = opaque_tid();
  const int lane = T_ & 63, wid = T_ >> 6;
  const float* X = (const float*)(p.ws + OFF_X);
  for (int row = blockIdx.x * 8 + wid; row < NTOK; row += gridDim.x * 8) {
    const float* xr = X + (size_t)row * DM;
    f32x4 v[4];
    float ss = 0.f;
#pragma unroll
    for (int i = 0; i < 4; ++i) {
      v[i] = *(const f32x4*)(xr + i * 256 + lane * 4);
#pragma unroll
      for (int e = 0; e < 4; ++e) ss += v[i][e] * v[i][e];
    }
#pragma unroll
    for (int o = 32; o >= 1; o >>= 1) ss += __shfl_xor(ss, o);
    const float rstd = rsqrtf(ss * (1.0f / DM) + 1e-6f);
#pragma unroll
    for (int i = 0; i < 4; ++i) {
      const int k = i * 256 + lane * 4;
      const f32x4 g = *(const f32x4*)(p.final_g + k);
      f32x4 o;
#pragma unroll
      for (int e = 0; e < 4; ++e) o[e] = v[i][e] * rstd * g[e];
      *(f32x4*)(p.out + (size_t)row * DM + k) = o;
    }
  }
}

__device__ __forceinline__ void attn_item(const Params& p, int item, char* smem, int tid, int c_lo, int c_hi, int ntrips, int merge, char* smem_peer) {
  const int lane = tid & 63, wid = tid >> 6, lr = lane & 31, lh = lane >> 5;
  const bf16_t* QB = (const bf16_t*)(p.ws + OFF_QB);
  const bf16_t* KB = (const bf16_t*)(p.ws + OFF_KB);
  const bf16_t* VB = (const bf16_t*)(p.ws + OFF_VB);
  bf16_t* CAT = (bf16_t*)(p.ws + OFF_CAT);
  bool latent; int b, head, qrow0, nchunks, r0 = 0, rowstart = 0;
  if (item < 128) { latent = true; b = item >> 6; head = (item >> 3) & 7; const int rp = item & 7; r0 = rp * 2; qrow0 = NP + b * LS + r0 * 64; nchunks = 9;
    int rs0 = r0 - 4; rs0 = rs0 < 0 ? 0 : (rs0 > 8 ? 8 : rs0); rowstart = rs0 < 6 ? rs0 : 6; }
  else { latent = false; const int it = item - 128; b = it >> 4; head = (it >> 1) & 7; qrow0 = b * LP + (it & 1) * 128; nchunks = 2; }
  const int qrow = qrow0 + wid * 32 + lr;
  bf16x8 qf[4];
#pragma unroll
  for (int ks = 0; ks < 4; ++ks) qf[ks] = *(const bf16x8*)(QB + (size_t)qrow * 512 + head * 64 + ks * 16 + lh * 8);
  f32x16 o[2];
#pragma unroll
  for (int i = 0; i < 16; ++i) { o[0][i] = 0.f; o[1][i] = 0.f; }
  float mrun = -1e30f, lsum = 0.f;
  const int qr = r0 + (wid >> 1), qc = (wid & 1) * 32 + lr;
  int rs = qr - 4; rs = rs < 0 ? 0 : (rs > 8 ? 8 : rs);
  int cs = qc - 8; cs = cs < 0 ? 0 : (cs > 48 ? 48 : cs);
  char* Ks = smem;
  char* Vt = smem + 16384;
  const float LOG2E = 1.4426950408889634f;
  (void)nchunks;
  for (int tr = 0; tr < ntrips; ++tr) {
    const int c = c_lo + tr;
    const bool active = c < c_hi;
    const bool local = latent && c < 5;
    __syncthreads();
    if (active) {
    if (!latent || local) {
      const int krow0 = latent ? NP + b * LS + (rowstart + 2 * c) * 64 : b * LP + c * 128;
#pragma unroll
      for (int i = 0; i < 4; ++i) {
        const int idx = tid + 256 * i, key = idx >> 3, seg = idx & 7;
        const u32x4 v = *(const u32x4*)(KB + (size_t)(krow0 + key) * 512 + head * 64 + seg * 8);
        *(u32x4*)(Ks + key * 128 + ((seg ^ ((key >> 1) & 7)) << 4)) = v;
      }
#pragma unroll
      for (int i = 0; i < 2; ++i) {
        const int idx = tid + 256 * i, kp = idx >> 3, seg = idx & 7;
        const u32x4 v0 = *(const u32x4*)(VB + (size_t)(krow0 + 2 * kp) * 512 + head * 64 + seg * 8);
        const u32x4 v1 = *(const u32x4*)(VB + (size_t)(krow0 + 2 * kp + 1) * 512 + head * 64 + seg * 8);
#pragma unroll
        for (int j = 0; j < 4; ++j) {
          const unsigned lo = (v0[j] & 0xffffu) | (v1[j] << 16), hi = (v0[j] >> 16) | (v1[j] & 0xffff0000u);
          *(unsigned*)(Vt + (seg * 8 + 2 * j) * 272 + kp * 4) = lo;
          *(unsigned*)(Vt + (seg * 8 + 2 * j + 1) * 272 + kp * 4) = hi;
        }
      }
    } else {
      const int l0 = (c - 5) * 128;
      const float* ck = p.cache_k + ((size_t)b * 512 + l0) * 512 + head * 64;
      const float* cv = p.cache_v + ((size_t)b * 512 + l0) * 512 + head * 64;
#pragma unroll
      for (int i = 0; i < 4; ++i) {
        const int idx = tid + 256 * i, key = idx >> 3, seg = idx & 7;
        const f32x4 a = *(const f32x4*)(ck + (size_t)key * 512 + seg * 8), bq = *(const f32x4*)(ck + (size_t)key * 512 + seg * 8 + 4);
        *(u32x4*)(Ks + key * 128 + ((seg ^ ((key >> 1) & 7)) << 4)) = pack8(a, bq);
      }
#pragma unroll
      for (int i = 0; i < 2; ++i) {
        const int idx = tid + 256 * i, kp = idx >> 3, seg = idx & 7;
        const float* s0 = cv + (size_t)(2 * kp) * 512 + seg * 8;
        const float* s1 = s0 + 512;
#pragma unroll
        for (int h4 = 0; h4 < 2; ++h4) {
          const f32x4 a = *(const f32x4*)(s0 + 4 * h4), bq = *(const f32x4*)(s1 + 4 * h4);
#pragma unroll
          for (int e = 0; e < 4; ++e) *(unsigned*)(Vt + (seg * 8 + 4 * h4 + e) * 272 + kp * 4) = pack_bf16(a[e], bq[e]);
        }
      }
    }
    }
    __syncthreads();
    if (active)
#pragma unroll 1
    for (int kt = 0; kt < 4; ++kt) {
      int kr = 0;
      if (local) {
        kr = rowstart + 2 * c + (kt >> 1);
        if (kr < rs || kr >= rs + 8) continue;
      }
      f32x16 st;
#pragma unroll
      for (int i = 0; i < 16; ++i) st[i] = 0.f;
#pragma unroll
      for (int ks = 0; ks < 4; ++ks) {
        const int row = kt * 32 + lr;
        const bf16x8 kf = *(const bf16x8*)(Ks + row * 128 + (((ks * 2 + lh) ^ ((row >> 1) & 7)) << 4));
        st = __builtin_amdgcn_mfma_f32_32x32x16_bf16(kf, qf[ks], st, 0, 0, 0);
      }
      float s2[16];
      float tmax = -1e30f;
      if (local) {
        const float* rp = p.na_rpb + ((size_t)head * 15 + (kr - qr + 7)) * 31;
#pragma unroll
        for (int i = 0; i < 16; ++i) {
          const int kc = (kt & 1) * 32 + 8 * (i >> 2) + 4 * lh + (i & 3);
          const bool valid = kc >= cs && kc < cs + 16;
          float sv = -1e30f;
          if (valid) sv = (st[i] * 0.125f + rp[kc - qc + 15]) * LOG2E;
          s2[i] = sv;
          tmax = fmaxf(tmax, sv);
        }
      } else {
#pragma unroll
        for (int i = 0; i < 16; ++i) { s2[i] = st[i] * (0.125f * LOG2E); tmax = fmaxf(tmax, s2[i]); }
      }
      tmax = fmaxf(tmax, xor32(tmax));
      const float mnew = fmaxf(mrun, tmax);
      const float alpha = __builtin_amdgcn_exp2f(mrun - mnew);
      mrun = mnew;
      float psum = 0.f;
#pragma unroll
      for (int i = 0; i < 16; ++i) { s2[i] = __builtin_amdgcn_exp2f(s2[i] - mnew); psum += s2[i]; }
      lsum = lsum * alpha + psum;
#pragma unroll
      for (int i = 0; i < 16; ++i) { o[0][i] *= alpha; o[1][i] *= alpha; }
#pragma unroll
      for (int s = 0; s < 2; ++s) {
        u32x4 pk;
        pk[0] = pack_bf16(s2[8 * s + 0], s2[8 * s + 1]); pk[1] = pack_bf16(s2[8 * s + 2], s2[8 * s + 3]);
        pk[2] = pack_bf16(s2[8 * s + 4], s2[8 * s + 5]); pk[3] = pack_bf16(s2[8 * s + 6], s2[8 * s + 7]);
        const bf16x8 pf = as_bf16x8(pk);
#pragma unroll
        for (int dt = 0; dt < 2; ++dt) {
          const char* vp = Vt + (dt * 32 + lr) * 272 + (kt * 32 + 16 * s + 4 * lh) * 2;
          const u32x2 a0 = *(const u32x2*)vp, a1 = *(const u32x2*)(vp + 16);
          u32x4 vv; vv[0] = a0[0]; vv[1] = a0[1]; vv[2] = a1[0]; vv[3] = a1[1];
          o[dt] = __builtin_amdgcn_mfma_f32_32x32x16_bf16(as_bf16x8(vv), pf, o[dt], 0, 0, 0);
        }
      }
    }
  }
  float ltot = lsum + xor32(lsum);
  if (merge == 1) {
    __syncthreads();
    char* pb_ = smem + wid * 8704;
#pragma unroll
    for (int dt = 0; dt < 2; ++dt)
#pragma unroll
      for (int i = 0; i < 16; ++i) *(float*)(pb_ + (dt * 16 + i) * 256 + lane * 4) = o[dt][i];
    *(float*)(pb_ + 8192 + lane * 4) = mrun;
    *(float*)(pb_ + 8448 + lane * 4) = ltot;
    __syncthreads();
    return;
  }
  if (merge == 2) {
    __syncthreads();
    __syncthreads();
    const char* pb_ = smem_peer + wid * 8704;
    const float m1 = *(const float*)(pb_ + 8192 + lane * 4), l1 = *(const float*)(pb_ + 8448 + lane * 4);
    const float m = fmaxf(mrun, m1);
    const float a0 = __builtin_amdgcn_exp2f(mrun - m), a1 = __builtin_amdgcn_exp2f(m1 - m);
    ltot = ltot * a0 + l1 * a1;
#pragma unroll
    for (int dt = 0; dt < 2; ++dt)
#pragma unroll
      for (int i = 0; i < 16; ++i) o[dt][i] = o[dt][i] * a0 + *(const float*)(pb_ + (dt * 16 + i) * 256 + lane * 4) * a1;
  }
  const float inv = 1.0f / ltot;
#pragma unroll
  for (int dt = 0; dt < 2; ++dt)
#pragma unroll
    for (int g = 0; g < 4; ++g) {
      const int d = dt * 32 + 8 * g + 4 * lh;
      u32x2 w; w[0] = pack_bf16(o[dt][4 * g] * inv, o[dt][4 * g + 1] * inv); w[1] = pack_bf16(o[dt][4 * g + 2] * inv, o[dt][4 * g + 3] * inv);
      *(u32x2*)(CAT + (size_t)qrow * DM + head * 64 + d) = w;
    }
}

template <bool FULL>
__device__ __forceinline__ void s5_scan(const Params& p, int trow0, int dstep, int nch, int g, int d, float (&cr_)[2], float (&ci_)[2], char* xs) {
  const int lane = opaque_tid() & 63, lr = lane & 31, lh = lane >> 5;
  const bf16_t* U = (const bf16_t*)(p.ws + OFF_U);
  float* Y = (float*)(p.ws + (d ? OFF_YB : OFF_YF));
  const float* AR = (const float*)(p.ws + OFF_AR);
  const float* AI = (const float*)(p.ws + OFF_AI);
  const float* BB = (const float*)(p.ws + OFF_BBAR);
  const int dg = d * 32 + g;
  bf16x8 bfrag[4];
#pragma unroll
  for (int nb = 0; nb < 4; ++nb) {
    const int ri = nb >> 1, pb = nb & 1;
    const float* src = BB + ((size_t)(dg * 2 + ri) * 64 + pb * 32 + lr) * 16 + lh * 8;
    bfrag[nb] = as_bf16x8(pack8(*(const f32x4*)src, *(const f32x4*)(src + 4)));
  }
  bf16x8 cfrag[4];
  if (FULL) {
    const int hch = lane & 15, q4 = lane >> 4;
#pragma unroll
    for (int ks = 0; ks < 4; ++ks) {
      const int p0 = 16 * ks + 4 * q4;
      const f32x4 cr = *(const f32x4*)(p.c_re + ((size_t)dg * 16 + hch) * 64 + p0), ci = *(const f32x4*)(p.c_im + ((size_t)dg * 16 + hch) * 64 + p0);
      u32x4 t; t[0] = pack_bf16(cr[0], -ci[0]); t[1] = pack_bf16(cr[1], -ci[1]); t[2] = pack_bf16(cr[2], -ci[2]); t[3] = pack_bf16(cr[3], -ci[3]);
      cfrag[ks] = as_bf16x8(t);
    }
  }
  float a1r_[2], a1i_[2], a16r_[2], a16i_[2];
#pragma unroll
  for (int pb = 0; pb < 2; ++pb) {
    float ar = AR[dg * 64 + pb * 32 + lr], ai = AI[dg * 64 + pb * 32 + lr];
    a1r_[pb] = ar; a1i_[pb] = ai;
#pragma unroll
    for (int k = 0; k < 4; ++k) { const float nr = ar * ar - ai * ai, ni = 2.f * ar * ai; ar = nr; ai = ni; }
    a16r_[pb] = ar; a16i_[pb] = ai;
  }
  const int upos = 16 * ((lr >> 2) & 1) + 4 * (lr >> 3) + (lr & 3);
  const bf16_t* up0 = U + (size_t)g * ((size_t)NTOK * 16) + (size_t)(trow0 + dstep * upos) * 16 + lh * 8;
  const long ustep = (long)dstep * 32 * 16;
  u32x4 un = *(const u32x4*)up0;
  auto cproj = [&](int cprev, const char* xb) {
#pragma unroll
    for (int mt = 0; mt < 2; ++mt) {
      f32x4 ya = {0.f, 0.f, 0.f, 0.f};
#pragma unroll
      for (int ks = 0; ks < 4; ++ks) {
        const bf16x8 xf = *(const bf16x8*)(xb + (mt * 16 + (lane & 15)) * 272 + (32 * ks + 8 * (lane >> 4)) * 2);
        ya = __builtin_amdgcn_mfma_f32_16x16x32_bf16(cfrag[ks], xf, ya, 0, 0, 0);
      }
      const int sp = cprev * 32 + mt * 16 + (lane & 15);
      *(f32x4*)(Y + (size_t)g * ((size_t)NTOK * 16) + (size_t)(trow0 + dstep * sp) * 16 + (lane >> 4) * 4) = ya;
    }
  };
#pragma unroll 1
  for (int c = 0; c < nch; ++c) {
    const bf16x8 uf = as_bf16x8(un);
    if (c + 1 < nch) { const bf16_t* upn = up0 + (long)(c + 1) * ustep; un = *(const u32x4*)upn; }
    f32x16 xr[2], xi[2];
#pragma unroll
    for (int pb = 0; pb < 2; ++pb) {
#pragma unroll
      for (int i = 0; i < 16; ++i) { xr[pb][i] = 0.f; xi[pb][i] = 0.f; }
      xr[pb] = __builtin_amdgcn_mfma_f32_32x32x16_bf16(uf, bfrag[pb], xr[pb], 0, 0, 0);
      xi[pb] = __builtin_amdgcn_mfma_f32_32x32x16_bf16(uf, bfrag[2 + pb], xi[pb], 0, 0, 0);
    }
    if (FULL && c > 0) cproj(c - 1, xs + ((c - 1) & 1) * 8704);
    char* xw = xs + (c & 1) * 8704;
#pragma unroll
    for (int pb = 0; pb < 2; ++pb) {
      const float a1r = a1r_[pb], a1i = a1i_[pb];
      {
        const float c0r = lh ? 0.f : cr_[pb], c0i = lh ? 0.f : ci_[pb];
        xr[pb][0] += a1r * c0r - a1i * c0i;
        xi[pb][0] += a1r * c0i + a1i * c0r;
      }
#pragma unroll
      for (int i = 1; i < 16; ++i) {
        const float pr = xr[pb][i - 1], pi = xi[pb][i - 1];
        xr[pb][i] += a1r * pr - a1i * pi;
        xi[pb][i] += a1r * pi + a1i * pr;
      }
      const float hr = half_bcast(xr[pb][15], 0), hi = half_bcast(xi[pb][15], 0);
      const float c2r = lh ? hr : 0.f, c2i = lh ? hi : 0.f;
      if (FULL) {
        float fr_ = c2r, fi_ = c2i;
#pragma unroll
        for (int i = 0; i < 16; ++i) {
          const float nr = a1r * fr_ - a1i * fi_, ni = a1r * fi_ + a1i * fr_;
          fr_ = nr; fi_ = ni;
          xr[pb][i] += fr_;
          xi[pb][i] += fi_;
        }
      } else {
        xr[pb][15] += a16r_[pb] * c2r - a16i_[pb] * c2i;
        xi[pb][15] += a16r_[pb] * c2i + a16i_[pb] * c2r;
      }
      cr_[pb] = half_bcast(xr[pb][15], 1);
      ci_[pb] = half_bcast(xi[pb][15], 1);
      if (FULL) {
#pragma unroll
        for (int i = 0; i < 16; ++i) *(unsigned*)(xw + (16 * lh + i) * 272 + (pb * 32 + lr) * 4) = pack_bf16(xr[pb][i], xi[pb][i]);
      }
    }
    if (FULL) asm volatile("s_waitcnt lgkmcnt(0)" ::: "memory");
  }
  if (FULL) cproj(nch - 1, xs + ((nch - 1) & 1) * 8704);
}

__device__ __forceinline__ void s5_combine(const Params& p, int rowbase, int L, int g0, int ng) {
  const float* YF = (const float*)(p.ws + OFF_YF); const float* YB = (const float*)(p.ws + OFF_YB); const bf16_t* U = (const bf16_t*)(p.ws + OFF_U);
  bf16_t* YBF = (bf16_t*)(p.ws + OFF_YBF);
  const int T_ = opaque_tid(), l4 = L * 4;
#pragma unroll 1
  for (int bt = 0; bt < 2; ++bt) {
    f32x4 yf[4], yb[4], u[4], d[4]; size_t oo[4];
#pragma unroll
    for (int k = 0; k < 4; ++k) {
      const int i = T_ + 512 * (bt * 4 + k);
      const int q = i / l4, rem = i - q * l4, t = rem >> 2, c4 = (rem & 3) * 4;
      const size_t oi = (size_t)(g0 + q) * ((size_t)NTOK * 16) + (size_t)(rowbase + t) * 16 + c4;
      oo[k] = (size_t)(rowbase + t) * 512 + (g0 + q) * 16 + c4;
      yf[k] = *(const f32x4*)(YF + oi); yb[k] = *(const f32x4*)(YB + oi); { const u32x2 t = *(const u32x2*)(U + oi); u[k] = (f32x4){__uint_as_float(t[0] << 16), __uint_as_float(t[0] & 0xffff0000u), __uint_as_float(t[1] << 16), __uint_as_float(t[1] & 0xffff0000u)}; } d[k] = *(const f32x4*)(p.s5_d + (g0 + q) * 16 + c4);
    }
#pragma unroll
    for (int k = 0; k < 4; ++k) {
      float r[4];
#pragma unroll
      for (int e = 0; e < 4; ++e) r[e] = gelu_tanh(yf[k][e] + yb[k][e] + d[k][e] * u[k][e]);
      u32x2 w; w[0] = pack_bf16(r[0], r[1]); w[1] = pack_bf16(r[2], r[3]);
      *(u32x2*)(YBF + oo[k]) = w;
    }
  }
}

__device__ __forceinline__ void phase_mix0(const Params& p, char* smem, volatile LAS unsigned* st) {
  const int T_ = opaque_tid();
  const int wid = T_ >> 6, vb = T_ >> 8, vtid = T_ & 255, lane = T_ & 63, lr = lane & 31, lh = lane >> 5;
  unsigned* qctr = (unsigned*)(p.ws + OFF_BAR) + 16;
  float* ex = (float*)(smem + 8 * 17408);
  for (;;) {
    __syncthreads();
    if (T_ == 0) st[2] = __hip_atomic_fetch_add(qctr, 1u, __ATOMIC_RELAXED, __HIP_MEMORY_SCOPE_AGENT);
    __syncthreads();
    const int q_ = (int)st[2];
    if (q_ >= 768) break;
    const int item = q_ < 128 ? 384 + q_ : (q_ < 384 ? q_ : (q_ < 512 ? q_ - 384 : q_));
    if (item < 384) {
      const bool lat = item < 128;
      const int it = lat ? item : item - 128;
      const int d = lat ? (it & 1) : (wid & 1), seg = wid;
      const int b = lat ? (it >> 6) : (it >> 3);
      const int g0 = lat ? ((it >> 1) & 31) : (it & 7) * 4;
      const int g = lat ? g0 : g0 + (wid >> 1);
      const int rowbase = lat ? NP + b * LS : b * LP;
      const int trow0 = lat ? rowbase + (d ? LS - 1 - 128 * seg : 128 * seg) : rowbase + (d ? LP - 1 : 0);
      const int dstep = d ? -1 : 1, nch = lat ? 4 : 8;
      float cr_[2] = {0.f, 0.f}, ci_[2] = {0.f, 0.f};
      if (lat) {
        s5_scan<false>(p, trow0, dstep, nch, g, d, cr_, ci_, nullptr);
        if (lh == 0) {
#pragma unroll
          for (int pb = 0; pb < 2; ++pb) { ex[(seg * 2 + 0) * 64 + pb * 32 + lr] = cr_[pb]; ex[(seg * 2 + 1) * 64 + pb * 32 + lr] = ci_[pb]; }
        }
        __syncthreads();
        const float* AR = (const float*)(p.ws + OFF_AR); const float* AI = (const float*)(p.ws + OFF_AI);
        const float* s0 = p.state_s5 + (size_t)b * 8192;
#pragma unroll
        for (int pb = 0; pb < 2; ++pb) {
          const int pi = pb * 32 + lr;
          float ar = AR[(d * 32 + g) * 64 + pi], ai = AI[(d * 32 + g) * 64 + pi];
#pragma unroll
          for (int k = 0; k < 7; ++k) { const float nr = ar * ar - ai * ai, ni = 2.f * ar * ai; ar = nr; ai = ni; }
          float cr = s0[((d * 2 + 0) * 32 + g) * 64 + pi], ci = s0[((d * 2 + 1) * 32 + g) * 64 + pi];
          for (int j = 0; j < seg; ++j) {
            const float er = ex[(j * 2 + 0) * 64 + pi], ei = ex[(j * 2 + 1) * 64 + pi];
            const float nr = ar * cr - ai * ci + er, ni = ar * ci + ai * cr + ei;
            cr = nr; ci = ni;
          }
          cr_[pb] = cr; ci_[pb] = ci;
        }
      }
      s5_scan<true>(p, trow0, dstep, nch, g, d, cr_, ci_, smem + wid * 17408);
      if (!lat && lh == 0) {
        float* os = p.out + (size_t)NTOK * DM + (size_t)2 * NP * 512 + (size_t)b * 8192;
#pragma unroll
        for (int pb = 0; pb < 2; ++pb) { os[((d * 2 + 0) * 32 + g) * 64 + pb * 32 + lr] = cr_[pb]; os[((d * 2 + 1) * 32 + g) * 64 + pb * 32 + lr] = ci_[pb]; }
      }
      __syncthreads();
      if (!lat) s5_combine(p, rowbase, LP, g0, 4);
      else {
        asm volatile("s_waitcnt vmcnt(0)" ::: "memory");
        __syncthreads();
        if (T_ == 0) {
          __builtin_amdgcn_fence(__ATOMIC_RELEASE, "agent");
          asm volatile("s_waitcnt vmcnt(0)" ::: "memory");
          const unsigned old = __hip_atomic_fetch_add((unsigned*)(p.ws + OFF_BAR) + 32 + b * 32 + g0, 1u, __ATOMIC_RELAXED, __HIP_MEMORY_SCOPE_AGENT);
          __builtin_amdgcn_fence(__ATOMIC_ACQUIRE, "agent");
          asm volatile("s_waitcnt vmcnt(0)" ::: "memory");
          st[3] = old;
        }
        __syncthreads();
        if (st[3] == 1u) s5_combine(p, rowbase, LS, g0, 1);
      }
    } else {
      int vt = vtid; asm volatile("" : "+v"(vt));
      if (item < 512) {
        attn_item(p, item - 384, smem + vb * 34816, vt, vb ? 5 : 0, vb ? 9 : 5, 5, vb ? 1 : 2, smem + 34816);
      } else {
        attn_item(p, 128 + (item - 512) * 2 + vb, smem + vb * 34816, vt, 0, 2, 2, 0, nullptr);
      }
    }
  }
}

constexpr int LDS_GEMM = 131072;
constexpr int LDS_BYTES = 147456;

#define WSP ({ const unsigned long long _w = (unsigned long long)p.ws; unsigned _lo = __builtin_amdgcn_readfirstlane((unsigned)_w), _hi = __builtin_amdgcn_readfirstlane((unsigned)(_w >> 32)); asm volatile("" : "+s"(_lo), "+s"(_hi)); (char*)(((unsigned long long)_hi << 32) | _lo); })
#define MOD ((float*)(WSP + OFF_MOD))
#define SUMSQ ((float*)(WSP + OFF_SUMSQ))
#define GS ((const float*)(WSP + OFF_GS))
#define SHWGU ((const float*)(WSP + OFF_SHWGU))
#define SHWINO ((const float*)(WSP + OFF_SHWINO))
#define ABUF ((bf16_t*)(WSP + OFF_ABUF))
#define CAT ((bf16_t*)(WSP + OFF_CAT))
#define X ((bf16_t*)(WSP + OFF_X))
#define HFF ((bf16_t*)(WSP + OFF_HFF))
__global__ void __launch_bounds__(512, 2) mega(Params p) {
  extern __shared__ __attribute__((aligned(16))) unsigned char lds_raw[];
  LAS unsigned char* lds = (LAS unsigned char*)lds_raw;
  char* smem = (char*)lds_raw;
  volatile LAS unsigned* st = (volatile LAS unsigned*)(lds + LDS_BYTES - 256);
  if (threadIdx.x < 4) st[threadIdx.x] = 0u;
  __syncthreads();
  XcdBarrier bar = xcd_barrier_post((unsigned*)(WSP + OFF_BAR), st);
  SchedFlat sf;

  phase_prep(p, smem);
  xcd_barrier(bar);
  phase_norm(p, true, p.norm_mix_g, MOD + 0 * 3 * 6144 + 0 * 1024);
  xcd_barrier(bar);
  {
    EpiInEven ep{(bf16_t*)(WSP + OFF_QB), (bf16_t*)(WSP + OFF_KB), (bf16_t*)(WSP + OFF_VB), (float*)(WSP + OFF_U),
                 p.out + (size_t)NTOK * DM, p.out + (size_t)NTOK * DM + (size_t)NP * 512};
    sf.init(ABUF, DM, (const bf16_t*)(WSP + OFF_WT_IN), DM, NTOK, 2048, 0);
    gemm8(lds, DM, DM, DM, sf, ep);
  }
  phase_prep_late(p, smem, 0, 64);
  phase_prep_mod1(p, smem, 64);
  xcd_barrier(bar);
  phase_mix0(p, smem, st);
  xcd_barrier(bar);
  {
    const bf16_t* YBF = (const bf16_t*)(WSP + OFF_YBF);
    sf.init(YBF, 512, (const bf16_t*)(WSP + OFF_WT_GLU), 512, NTOK, 512, 0);
    gemm8<true>(lds, 512, 512, 512, SchedFlatTail{sf, 0}, EpiGlu<true>{YBF, p.glu_b, CAT});
  }
  phase_norm_consts(p, 0, 160);
  xcd_barrier(bar);
  sf.init(CAT, DM, (const bf16_t*)(WSP + OFF_WT_OUT), DM, NTOK, DM, 0);
  gemm8(lds, DM, DM, DM, sf, EpiResid<true>{p.x_prompt, p.x_sample, nullptr, X, MOD + 2 * 1024, ABUF, GS, SUMSQ});
  phase_prep_dft(p, 160);
  phase_norm_consts(p, 1, 160);
  xcd_barrier(bar);
  sf.init(ABUF, DM, (const bf16_t*)(WSP + OFF_WT_GU), DM, NTOK, 5632, 0);
  sf.limit = 768;
  gemm8(lds, DM, DM, DM, sf, EpiSwiGLU<false>{HFF, SUMSQ, SHWGU});
  sf.limit = sf.nwg;
  gemm8<true>(lds, DM, DM, DM, SchedFlatTail{sf, 768}, EpiSwiGLU<true>{HFF, SUMSQ, SHWGU});
  xcd_barrier(bar);
  sf.init(HFF, DFF, (const bf16_t*)(WSP + OFF_WT_DN), DFF, NTOK, DM, 0);
  gemm8(lds, DFF, DFF, DFF, sf, EpiResid<false>{p.x_prompt, p.x_sample, X, X, MOD + 5 * 1024, ABUF, GS + 3072, SUMSQ + NTOK});
  phase_prep_late(p, smem, 1, 160);
  xcd_barrier(bar);
  sf.init(ABUF, DM, (const bf16_t*)(WSP + OFF_WT_INO), DM, NTOK, DM, DM);
  gemm8(lds, DM, DM, DM, sf, EpiBf16Norm{(bf16_t*)(WSP + OFF_Z), SUMSQ + NTOK, SHWINO});
  phase_norm_consts(p, 2, 160);
  xcd_barrier(bar);
  gemm8(lds, 256, 256, DM, SchedF1{(const char*)(WSP + OFF_CS2), (const char*)(WSP + OFF_Z), (int)gridDim.x, (int)blockIdx.x}, EpiBf16{(bf16_t*)(WSP + OFF_OT)});
  xcd_barrier(bar);
  gemm8(lds, 512, 512, 512, SchedF2P{(const char*)(WSP + OFF_CL2P), (const char*)(WSP + OFF_OT), (int)blockIdx.x}, EpiBf16{CAT});
  gemm8<true>(lds, 2048, 2048, 2048, SchedF2S{(const char*)(WSP + OFF_CL2S), (const char*)(WSP + OFF_OT), (int)blockIdx.x}, EpiBf16Half{CAT});
  xcd_barrier(bar);
  sf.init(CAT, DM, (const bf16_t*)(WSP + OFF_WT_OUTO), DM, NTOK, DM, 0);
  gemm8(lds, DM, DM, DM, sf, EpiResid<false>{p.x_prompt, p.x_sample, X, X, MOD + 3 * 6144 + 2 * 1024, ABUF, GS + 2 * 3072, SUMSQ + 2 * NTOK});
  xcd_barrier(bar);
  sf.init(ABUF, DM, (const bf16_t*)(WSP + OFF_WT_GU) + (size_t)5632 * 1024, DM, NTOK, 5632, 0);
  sf.limit = 768;
  gemm8(lds, DM, DM, DM, sf, EpiSwiGLU<false>{HFF, SUMSQ + 2 * NTOK, SHWGU + 3 * 5632});
  sf.limit = sf.nwg;
  gemm8<true>(lds, DM, DM, DM, SchedFlatTail{sf, 768}, EpiSwiGLU<true>{HFF, SUMSQ + 2 * NTOK, SHWGU + 3 * 5632});
  xcd_barrier(bar);
  sf.init(HFF, DFF, (const bf16_t*)(WSP + OFF_WT_DN) + (size_t)1024 * DFF, DFF, NTOK, DM, 0);
  gemm8(lds, DFF, DFF, DFF, sf, EpiFinal{X, MOD + 3 * 6144 + 5 * 1024, p.final_g, p.out, SUMSQ + 3 * NTOK, (unsigned*)(WSP + OFF_PCNT)});
}

extern "C" void kernel_launch(void* const* d_in, const int* in_sizes, int n_in, void* d_out, int out_size, void* d_ws, size_t ws_size, hipStream_t stream) {
  static int grid_blocks = 0;
  if (!grid_blocks) {
    int dev = 0, cus = 0, per_cu = 0;
    (void)hipGetDevice(&dev);
    (void)hipDeviceGetAttribute(&cus, hipDeviceAttributeMultiprocessorCount, dev);
    if (hipFuncSetAttribute((const void*)mega, hipFuncAttributeMaxDynamicSharedMemorySize, LDS_BYTES) != hipSuccess) fprintf(stderr, "hipFuncSetAttribute failed\n");
    (void)hipOccupancyMaxActiveBlocksPerMultiprocessor(&per_cu, mega, 512, LDS_BYTES);
    if (per_cu < 1) fprintf(stderr, "occupancy query reports %d blocks per CU\n", per_cu);
    (void)hipGetLastError();
    grid_blocks = cus;
  }
  if (ws_size < WS_NEED) { fprintf(stderr, "workspace too small: %zu < %zu\n", ws_size, (size_t)WS_NEED); return; }
  Params p{};
  const float** pp = (const float**)&p;
  for (int i = 0; i < 30; ++i) pp[i] = (const float*)d_in[i];
  p.out = (float*)d_out;
  p.ws = (char*)d_ws;
  (void)hipMemsetAsync((char*)d_ws + OFF_BAR, 0, ZERO_BYTES, stream);
  void* args[] = {&p};
  hipError_t e = hipLaunchCooperativeKernel((void*)mega, dim3(grid_blocks), dim3(512), args, LDS_BYTES, stream);
  if (e != hipSuccess) fprintf(stderr, "cooperative launch failed: %s (grid %d)\n", hipGetErrorString(e), grid_blocks);
}
```

```cpp
#include <hip/hip_runtime.h>
#include <cstdio>

typedef unsigned short bf16_t;
typedef short bf16x8 __attribute__((ext_vector_type(8)));
typedef float f32x4 __attribute__((ext_vector_type(4)));
typedef float f32x16 __attribute__((ext_vector_type(16)));
typedef unsigned u32x4 __attribute__((ext_vector_type(4)));
typedef unsigned u32x2 __attribute__((ext_vector_type(2)));

#ifndef N_LAUNCH_MODE
#define N_LAUNCH_MODE 1
#endif

constexpr int DM = 1024, NP = 8192, NL = 2048, NTOK = NP + NL, LP = 256, LS = 1024;
constexpr int DFF = 2816, NAW = 512, S5W = 512;
constexpr int NPHASE = 18;

constexpr size_t al256(size_t x) { return (x + 255) & ~(size_t)255; }
constexpr size_t OFF_MOD = 0;
constexpr size_t OFF_AR = al256(OFF_MOD + 2 * 3 * 6144 * 4);
constexpr size_t OFF_AI = al256(OFF_AR + 4096 * 4);
constexpr size_t OFF_BBAR = al256(OFF_AI + 4096 * 4);
constexpr size_t OFF_WT_IN = al256(OFF_BBAR + 131072 * 4);
constexpr size_t OFF_WT_GLU = al256(OFF_WT_IN + 2048 * 1024 * 2);
constexpr size_t OFF_WT_OUT = al256(OFF_WT_GLU + 512 * 512 * 2);
constexpr size_t OFF_WT_INO = al256(OFF_WT_OUT + 1024 * 1024 * 2);
constexpr size_t OFF_WT_OUTO = al256(OFF_WT_INO + 1024 * 1024 * 2);
constexpr size_t OFF_WT_GU = al256(OFF_WT_OUTO + 1024 * 1024 * 2);
constexpr size_t OFF_WT_DN = al256(OFF_WT_GU + (size_t)2 * 5632 * 1024 * 2);
constexpr size_t OFF_CS2 = al256(OFF_WT_DN + (size_t)2 * 1024 * 2816 * 2);
constexpr size_t OFF_CL2P = al256(OFF_CS2 + 512 * 256 * 2);
constexpr size_t OFF_CL2S = al256(OFF_CL2P + 256 * 512 * 2);
constexpr size_t OFF_ABUF = al256(OFF_CL2S + 1024 * 2048 * 2);
constexpr size_t OFF_CAT = al256(OFF_ABUF + (size_t)NTOK * 1024 * 2);
constexpr size_t OFF_X = al256(OFF_CAT + (size_t)NTOK * 1024 * 2);
constexpr size_t OFF_POOL = al256(OFF_X + (size_t)NTOK * 1024 * 4);
constexpr size_t OFF_QB = OFF_POOL;
constexpr size_t OFF_KB = OFF_QB + (size_t)NTOK * 512 * 2;
constexpr size_t OFF_VB = OFF_KB + (size_t)NTOK * 512 * 2;
constexpr size_t OFF_U = OFF_VB + (size_t)NTOK * 512 * 2;
constexpr size_t OFF_YF = OFF_U + (size_t)NTOK * 512 * 4;
constexpr size_t OFF_YB = OFF_YF + (size_t)NTOK * 512 * 4;
constexpr size_t POOL_END0 = OFF_YB + (size_t)NTOK * 512 * 4;
constexpr size_t OFF_HFF = OFF_POOL;
constexpr size_t OFF_Z = OFF_POOL;
constexpr size_t OFF_OT = OFF_Z + (size_t)NTOK * 1024 * 2;
constexpr size_t OFF_YBF = POOL_END0;
constexpr size_t OFF_BAR = al256(OFF_YBF + (size_t)NTOK * 512 * 2);
constexpr size_t OFF_SUMSQ = OFF_BAR + 16384;
constexpr size_t OFF_PCNT = OFF_SUMSQ + (size_t)4 * NTOK * 4;
constexpr size_t ZERO_BYTES = 16384 + (size_t)4 * NTOK * 4 + 40 * 256;
constexpr size_t OFF_GS = al256(OFF_PCNT + 40 * 256);
constexpr size_t OFF_SHWGU = al256(OFF_GS + 3 * 3 * 1024 * 4);
constexpr size_t OFF_SHWINO = al256(OFF_SHWGU + 2 * 3 * 5632 * 4);
constexpr size_t WS_NEED = al256(OFF_SHWINO + 3 * 1024 * 4);
static_assert(WS_NEED <= (size_t)256 * 1024 * 1024, "workspace");

struct Params {
  const float *x_prompt, *x_sample, *cache_k, *cache_v, *state_s5, *c, *c_ctx, *w_mod, *b_mod, *norm_mix_g, *norm_ffn_g,
      *w_in_even, *na_rpb, *lam_re, *lam_im, *log_step, *b_re, *b_im, *c_re, *c_im, *s5_d, *glu_w, *glu_b, *w_out_even,
      *w_in_odd, *w_out_odd, *w_gate, *w_up, *w_down, *final_g;
  float* out;
  char* ws;
};

typedef __bf16 bf16v2_t __attribute__((ext_vector_type(2)));
__device__ __forceinline__ unsigned pack_bf16(float lo, float hi) {
  bf16v2_t v = {(__bf16)lo, (__bf16)hi};
  return __builtin_bit_cast(unsigned, v);
}
__device__ __forceinline__ float bf2f(unsigned short h) { return __uint_as_float(((unsigned)h) << 16); }
__device__ __forceinline__ u32x4 pack8(f32x4 a, f32x4 b) {
  u32x4 r;
  r[0] = pack_bf16(a[0], a[1]); r[1] = pack_bf16(a[2], a[3]); r[2] = pack_bf16(b[0], b[1]); r[3] = pack_bf16(b[2], b[3]);
  return r;
}
__device__ __forceinline__ bf16x8 as_bf16x8(u32x4 v) { return __builtin_bit_cast(bf16x8, v); }
__device__ __forceinline__ float sigmoidf_(float x) { return 1.0f / (1.0f + __expf(-x)); }
__device__ __forceinline__ float siluf_(float x) { return x * sigmoidf_(x); }
__device__ __forceinline__ float gelu_tanh(float x) {
  const float u = 0.7978845608028654f * (x + 0.044715f * x * x * x);
  const float t = 1.0f - 2.0f / (1.0f + __expf(2.0f * u));
  return 0.5f * x * (1.0f + t);
}
__device__ __forceinline__ float half_bcast(float x, int which) {
  auto r = __builtin_amdgcn_permlane32_swap(__float_as_uint(x), __float_as_uint(x), false, false);
  return __uint_as_float(which ? r[1] : r[0]);
}
__device__ __forceinline__ float xor32(float x) {
  auto r = __builtin_amdgcn_permlane32_swap(__float_as_uint(x), __float_as_uint(x), false, false);
  return (threadIdx.x & 32) ? __uint_as_float(r[0]) : __uint_as_float(r[1]);
}
__device__ __forceinline__ int opaque_tid() { int t = threadIdx.x; asm volatile("" : "+v"(t)); return t; }
__device__ __forceinline__ int cond_index(int row) { return row < NP ? 0 : 1 + ((row - NP) >> 10); }
__device__ __forceinline__ const float* xin_row(const Params& p, int row) {
  return row < NP ? p.x_prompt + (size_t)row * DM : p.x_sample + (size_t)(row - NP) * DM;
}

#define LAS __attribute__((address_space(3)))
#define XB_TMO      128
#define XB_XCNT(j)  (256  + 64 * (j))
#define XB_XSUB(j)  (1280 + 64 * (j))
#define XB_XGEN(j)  (2304 + 64 * (j))
#define XB_TOP      3328
#define XB_TOPGEN   3392
#define XCD_BAR_WORDS 3456
#define XB_SPIN_CAP (1u << 22)
__device__ __forceinline__ unsigned xb_ld(unsigned* p)              { return __hip_atomic_load(p, __ATOMIC_RELAXED, __HIP_MEMORY_SCOPE_AGENT); }
__device__ __forceinline__ unsigned xb_add(unsigned* p, unsigned v) { return __hip_atomic_fetch_add(p, v, __ATOMIC_RELAXED, __HIP_MEMORY_SCOPE_AGENT); }
__device__ __forceinline__ unsigned xb_xcc_id() { return (unsigned)__builtin_amdgcn_s_getreg((3 << 11) | 20) & 0xFu; }
#define XB_SPIN(cond, bar) do { unsigned _sp = 0; while (cond) { __builtin_amdgcn_s_sleep(1); \
    if ((++_sp & 255u) == 0u) { if (xb_ld(&(bar)[XB_TMO])) break; if (_sp > XB_SPIN_CAP) { atomicAdd(&(bar)[XB_TMO], 1u); break; } } } } while (0)
struct XcdBarrier { unsigned* bar; unsigned x; volatile LAS unsigned* st; };
__device__ __forceinline__ XcdBarrier xcd_barrier_post(unsigned* bar, volatile LAS unsigned* st) {
  XcdBarrier b; b.bar = bar; b.x = xb_xcc_id(); b.st = st;
  if (threadIdx.x == 0) (void)xb_add(&bar[XB_XCNT(b.x)], 1u);
  return b;
}
__device__ __forceinline__ void xcd_barrier_complete(unsigned* bar, unsigned x, unsigned& nloc, unsigned& nx) {
  const unsigned G = gridDim.x * gridDim.y * gridDim.z;
  unsigned sum, cnt, mine, sp = 0u;
  for (;;) {
    sum = 0u; cnt = 0u; mine = 0u;
#pragma unroll
    for (unsigned j = 0; j < 16; ++j) { const unsigned c = xb_ld(&bar[XB_XCNT(j)]); sum += c; cnt += (c > 0u) ? 1u : 0u; mine = (j == x) ? c : mine; }
    if (sum == G) break;
    __builtin_amdgcn_s_sleep(1);
    if ((++sp & 255u) == 0u) { if (xb_ld(&bar[XB_TMO])) break; if (sp > XB_SPIN_CAP) { atomicAdd(&bar[XB_TMO], 1u); break; } }
  }
  nloc = mine > 0u ? mine : 1u; nx = cnt > 0u ? cnt : 1u;
}
__device__ __forceinline__ void xcd_barrier(const XcdBarrier& b) {
  asm volatile("s_waitcnt vmcnt(0)" ::: "memory");
  __syncthreads();
  if (threadIdx.x == 0) {
    unsigned* bar = b.bar;
    __builtin_amdgcn_s_waitcnt(0);
    unsigned nloc = b.st[0], nx = b.st[1];
    if (nloc == 0u) { xcd_barrier_complete(bar, b.x, nloc, nx); b.st[0] = nloc; b.st[1] = nx; }
    const unsigned old = xb_add(&bar[XB_XSUB(b.x)], 1u);
    const unsigned gen = old / nloc;
    if (old + 1u == (gen + 1u) * nloc) {
      __builtin_amdgcn_fence(__ATOMIC_RELEASE, "agent");
      asm volatile("s_waitcnt vmcnt(0)" ::: "memory");
      const unsigned og = xb_add(&bar[XB_TOP], 1u);
      const unsigned tg = og / nx;
      if (og + 1u == (tg + 1u) * nx) xb_add(&bar[XB_TOPGEN], 1u);
      else XB_SPIN(xb_ld(&bar[XB_TOPGEN]) == tg, bar);
      __builtin_amdgcn_fence(__ATOMIC_ACQUIRE, "agent");
      xb_add(&bar[XB_XGEN(b.x)], 1u);
      asm volatile("s_waitcnt vmcnt(0)" ::: "memory");
    } else {
      XB_SPIN(xb_ld(&bar[XB_XGEN(b.x)]) == gen, bar);
      __builtin_amdgcn_fence(__ATOMIC_ACQUIRE, "agent");
      asm volatile("s_waitcnt vmcnt(0)" ::: "memory");
    }
  }
  __syncthreads();
}

constexpr int G8_HTB = 128 * 64 * 2;
__device__ __forceinline__ int lds_byte(int r, int c) { const int st = (r >> 4) * 2 + (c >> 5), rr = r & 15, cc = c & 31, ob = rr * 64 + cc * 2; return st * 1024 + (ob ^ (((ob >> 9) & 1) << 5)); }
__device__ __forceinline__ void stage_rc(int b, int& R, int& C) { const int st = b / 1024, sb = b % 1024, swz = sb ^ (((sb >> 9) & 1) << 5); R = (st >> 1) * 16 + swz / 64; C = (st & 1) * 32 + (swz % 64) / 2; }
struct Unit { const char* a; const char* b; size_t cbase; int ldc; int pm, pn; int row0; };

template <bool HALF_M = false, class Epi, class Sched>
__device__ __forceinline__ void gemm8(LAS unsigned char* lds, int K, int lda, int ldb, const Sched& S, const Epi& E) {
  const int tid = opaque_tid(), wid = __builtin_amdgcn_readfirstlane(tid >> 6), lane = tid & 63, wr = wid >> 2, wc = wid & 3, fr = lane & 15, fq = lane >> 4;
  const int nt = K / 64;
  unsigned voffA[2], voffB[2];
#pragma unroll
  for (int i = 0; i < 2; ++i) { int R, C; stage_rc(tid * 16 + i * 8192, R, C);
    const int rho = R & 31, Rb = Epi::PERM ? ((R & ~31) + 8 * ((rho & 15) >> 2) + 4 * (rho >> 4) + (rho & 3)) : R;
    voffA[i] = (unsigned)(R * lda + C) * 2u; voffB[i] = (unsigned)(Rb * ldb + C) * 2u; }
  const size_t kstep = 128;
  const size_t hstepA = (size_t)128 * lda * 2, hstepB = (size_t)128 * ldb * 2;
  const unsigned ldsw = (unsigned)wid * 1024u;
  const int aoff = lds_byte(wr * 64 + fr, fq * 8), boff = lds_byte(wc * 32 + fr, fq * 8);
#define G8_SA(b, h) (((b) * 2 + (h)) * G8_HTB)
#define G8_SB(b, h) ((4 + (b) * 2 + (h)) * G8_HTB)
#define G8_STAGE(bufoff, gbase, voff) do { _Pragma("unroll") for (int _i = 0; _i < 2; ++_i) \
    __builtin_amdgcn_global_load_lds((const unsigned*)((const char*)(gbase) + (voff)[_i]), (LAS unsigned*)(lds + (bufoff) + ldsw + _i * 8192), 16, 0, 0); } while (0)
#define G8_LDA(dst, b, h) do { _Pragma("unroll") for (int m = 0; m < 4; ++m) _Pragma("unroll") for (int k = 0; k < 2; ++k) dst[m][k] = *(const LAS bf16x8*)(lds + G8_SA(b, h) + aoff + m * 2048 + k * 1024); } while (0)
#define G8_LDB(dst, b, h) do { _Pragma("unroll") for (int n = 0; n < 2; ++n) _Pragma("unroll") for (int k = 0; k < 2; ++k) dst[n][k] = *(const LAS bf16x8*)(lds + G8_SB(b, h) + boff + n * 2048 + k * 1024); } while (0)
#define G8_MMA(ai, bj, At, Bt) do { __builtin_amdgcn_s_setprio(1); _Pragma("unroll") for (int m = 0; m < 4; ++m) _Pragma("unroll") for (int n = 0; n < 2; ++n) _Pragma("unroll") for (int k = 0; k < 2; ++k) \
    acc[ai][bj][m][n] = __builtin_amdgcn_mfma_f32_16x16x32_bf16(Bt[n][k], At[m][k], acc[ai][bj][m][n], 0, 0, 0); __builtin_amdgcn_s_setprio(0); } while (0)
#define G8_WAIT_V(n) asm volatile("s_waitcnt vmcnt(" #n ")" ::: "memory")
#define G8_WAIT_L(n) asm volatile("s_waitcnt lgkmcnt(" #n ")" ::: "memory")
#define G8_BAR __builtin_amdgcn_s_barrier()
#define G8_SCHED __builtin_amdgcn_sched_barrier(0)
  Unit cur, nxt; int ui = 0;
  if (!S.next(0, cur)) return;
  f32x4 acc[2][2][4][2];
#pragma unroll
  for (int a = 0; a < 2; ++a)
#pragma unroll
    for (int b = 0; b < 2; ++b)
#pragma unroll
      for (int m = 0; m < 4; ++m)
#pragma unroll
        for (int n = 0; n < 2; ++n) acc[a][b][m][n] = (f32x4){0.f, 0.f, 0.f, 0.f};
  bf16x8 At[4][2], B0[2][2], B1[2][2];
  const char* cA = cur.a; const char* cB = cur.b;
  G8_STAGE(G8_SB(0, 0), cB, voffB); G8_STAGE(G8_SA(0, 0), cA, voffA); G8_STAGE(G8_SB(0, 1), cB + hstepB, voffB); G8_STAGE(G8_SA(0, 1), cA + hstepA, voffA);
  if (wr == 1) G8_BAR;
  G8_WAIT_V(4); G8_BAR;
  G8_STAGE(G8_SB(1, 0), cB + kstep, voffB); G8_STAGE(G8_SA(1, 0), cA + kstep, voffA); G8_STAGE(G8_SB(1, 1), cB + hstepB + kstep, voffB);
  G8_WAIT_V(6); G8_BAR;
  for (;;) {
    const bool has_next = S.next(ui + 1, nxt);
    const char* nA = has_next ? nxt.a : cA; const char* nB = has_next ? nxt.b : cB;
    for (int t = 0; t < nt; t += 2) {
      const bool last = (t == nt - 2);
      const char* a1 = cA + (size_t)(t + 1) * kstep;
      const char* a2 = last ? nA : cA + (size_t)(t + 2) * kstep; const char* b2 = last ? nB : cB + (size_t)(t + 2) * kstep;
      const char* a3 = a2 + kstep; const char* b3 = b2 + kstep;
      G8_LDB(B0, 0, 0); G8_SCHED; G8_LDA(At, 0, 0); G8_STAGE(G8_SA(1, 1), a1 + hstepA, voffA);
      G8_WAIT_L(8); G8_BAR; G8_WAIT_L(0); G8_MMA(0, 0, At, B0); G8_BAR; G8_SCHED;
      G8_LDB(B1, 0, 1); G8_STAGE(G8_SB(0, 0), b2, voffB);
      G8_BAR; G8_WAIT_L(0); G8_MMA(0, 1, At, B1); G8_BAR;
      if constexpr (!HALF_M) { G8_LDA(At, 0, 1); } G8_STAGE(G8_SA(0, 0), a2, voffA);
      G8_BAR; G8_WAIT_L(0); if constexpr (!HALF_M) { G8_MMA(1, 0, At, B0); } G8_BAR; G8_SCHED;
      G8_STAGE(G8_SB(0, 1), b2 + hstepB, voffB);
      G8_WAIT_V(6); G8_BAR; if constexpr (!HALF_M) { G8_MMA(1, 1, At, B1); } G8_BAR;
      G8_LDB(B0, 1, 0); G8_SCHED; G8_LDA(At, 1, 0); G8_STAGE(G8_SA(0, 1), a2 + hstepA, voffA);
      G8_WAIT_L(8); G8_BAR; G8_WAIT_L(0); G8_MMA(0, 0, At, B0); G8_BAR; G8_SCHED;
      G8_LDB(B1, 1, 1); G8_STAGE(G8_SB(1, 0), b3, voffB);
      G8_BAR; G8_WAIT_L(0); G8_MMA(0, 1, At, B1); G8_BAR;
      if constexpr (!HALF_M) { G8_LDA(At, 1, 1); } G8_STAGE(G8_SA(1, 0), a3, voffA);
      G8_BAR; G8_WAIT_L(0); if constexpr (!HALF_M) { G8_MMA(1, 0, At, B0); } G8_BAR; G8_SCHED;
      G8_STAGE(G8_SB(1, 1), b3 + hstepB, voffB);
      G8_WAIT_V(6); G8_BAR; if constexpr (!HALF_M) { G8_MMA(1, 1, At, B1); } G8_BAR;
    }
    if constexpr (!Epi::AFTER_DRAIN) E(acc, cur, wr, wc, fr, fq);
    if (!has_next) break;
#pragma unroll
    for (int a = 0; a < 2; ++a)
#pragma unroll
      for (int b = 0; b < 2; ++b)
#pragma unroll
        for (int m = 0; m < 4; ++m)
#pragma unroll
          for (int n = 0; n < 2; ++n) acc[a][b][m][n] = (f32x4){0.f, 0.f, 0.f, 0.f};
    cur = nxt; cA = nA; cB = nB; ++ui;
  }
  G8_WAIT_V(0);
  if (wr == 0) G8_BAR;
  G8_BAR;
  if constexpr (Epi::AFTER_DRAIN) E(acc, cur, wr, wc, fr, fq);
#undef G8_SA
#undef G8_SB
#undef G8_STAGE
#undef G8_LDA
#undef G8_LDB
#undef G8_MMA
#undef G8_WAIT_V
#undef G8_WAIT_L
#undef G8_BAR
#undef G8_SCHED
}

struct SchedFlat {
  const char *A, *B; size_t atstep, btstep; int ldc; int nM, nN, nwg, G, c, limit;
  __device__ __forceinline__ void init(const bf16_t* A_, int lda, const bf16_t* B_, int ldb, int M, int N, int ldc_) {
    A = (const char*)A_; B = (const char*)B_; atstep = (size_t)256 * lda * 2; btstep = (size_t)256 * ldb * 2; ldc = ldc_;
    nM = M / 256; nN = N / 256; nwg = nM * nN; G = gridDim.x; c = blockIdx.x; limit = nwg;
  }
  __device__ __forceinline__ void unit_at(int L, Unit& u) const {
    int wgid = L; { const int q = nwg / 8, r = nwg % 8, xcd = wgid % 8, off = wgid / 8; wgid = (xcd < r ? xcd * (q + 1) : r * (q + 1) + (xcd - r) * q) + off; }
    const int nig = 8 * nN, gid = wgid / nig, fm = gid * 8, gsz = (nM - fm) < 8 ? (nM - fm) : 8;
    u.pm = fm + ((wgid % nig) % gsz); u.pn = (wgid % nig) / gsz;
    u.a = A + (size_t)u.pm * atstep; u.b = B + (size_t)u.pn * btstep; u.ldc = ldc; u.cbase = (size_t)u.pm * 256 * ldc + (size_t)u.pn * 256; u.row0 = u.pm * 256;
  }
  __device__ __forceinline__ bool next(int i, Unit& u) const {
    const long L = (long)i * G + c; if (L >= limit) return false;
    unit_at((int)L, u);
    return true;
  }
};
struct SchedFlatTail {
  SchedFlat f; int first;
  __device__ __forceinline__ bool next(int i, Unit& u) const {
    const int Lh = i * f.G + f.c; if (Lh >= 2 * (f.nwg - first)) return false;
    f.unit_at(first + (Lh >> 1), u);
    if (Lh & 1) { u.a += f.atstep / 2; u.row0 += 128; u.cbase += (size_t)128 * f.ldc; }
    return true;
  }
};
struct SchedF1 {
  const char *CS2, *Z; int G, c;
  __device__ __forceinline__ bool next(int i, Unit& u) const {
    const int L = i * G + c; if (L >= 320) return false;
    int bg, pm, pn, Lseq, rowb; size_t obase;
    if (L < 256) { bg = L >> 1; pm = L & 1; pn = 0; Lseq = LP; rowb = (bg >> 2) * LP; obase = (size_t)bg * 512 * LP; }
    else { const int t = L - 256; bg = t >> 3; pm = (t >> 2) & 1; pn = t & 3; Lseq = LS; rowb = NP + (bg >> 2) * LS; obase = (size_t)128 * 512 * LP + (size_t)bg * 512 * LS; }
    u.pm = pm; u.pn = pn; u.ldc = Lseq;
    u.a = CS2 + (size_t)pm * 256 * 256 * 2;
    u.b = Z + ((size_t)(rowb + pn * 256) * DM + (bg & 3) * 256) * 2;
    u.cbase = obase + (size_t)pm * 256 * Lseq + (size_t)pn * 256;
    return true;
  }
};
struct SchedF1Own {
  const char *CS2, *Z; int pm_tok, g; bool have;
  __device__ __forceinline__ bool next(int i, Unit& u) const {
    if (!have || i > 1) return false;
    int bg, pn, Lseq, rowb; size_t obase;
    if (pm_tok < NP / 256) { const int b = pm_tok; bg = b * 4 + g; pn = 0; Lseq = LP; rowb = b * LP; obase = (size_t)bg * 512 * LP; }
    else { const int t = pm_tok - NP / 256, b = t >> 2; pn = t & 3; bg = b * 4 + g; Lseq = LS; rowb = NP + b * LS; obase = (size_t)128 * 512 * LP + (size_t)bg * 512 * LS; }
    u.pm = i; u.pn = pn; u.ldc = Lseq; u.row0 = 0;
    u.a = CS2 + (size_t)i * 256 * 256 * 2;
    u.b = Z + ((size_t)(rowb + pn * 256) * DM + g * 256) * 2;
    u.cbase = obase + (size_t)i * 256 * Lseq + (size_t)pn * 256;
    return true;
  }
};
struct SchedF2P {
  const char *CL, *OT; int c;
  __device__ __forceinline__ bool next(int i, Unit& u) const {
    if (i > 0 || c >= 128) return false;
    const int b = c >> 2, pn = c & 3;
    u.pm = 0; u.pn = pn; u.ldc = DM;
    u.a = CL; u.b = OT + ((size_t)b * 4 * 512 * LP + (size_t)pn * 256 * 512) * 2;
    u.cbase = (size_t)(b * LP) * DM + (size_t)pn * 256;
    return true;
  }
};
struct SchedF2S {
  const char *CL, *OT; int c;
  __device__ __forceinline__ bool next(int i, Unit& u) const {
    const int t = c - 128;
    if (i > 0 || t < 0 || t >= 64) return false;
    const int b = t >> 5, ph = (t >> 2) & 7, pn = t & 3;
    u.pm = ph; u.pn = pn; u.ldc = DM;
    u.a = CL + (size_t)ph * 128 * 2048 * 2;
    u.b = OT + ((size_t)128 * 512 * LP + (size_t)b * 4 * 512 * LS + (size_t)pn * 256 * 2048) * 2;
    u.cbase = (size_t)(NP + b * LS + ph * 128) * DM + (size_t)pn * 256;
    return true;
  }
};

template <class F>
__device__ __forceinline__ void epi_foreach(const f32x4 (&acc)[2][2][4][2], int wr, int wc, int fr, int fq, const F& f) {
#pragma unroll
  for (int ai = 0; ai < 2; ++ai)
#pragma unroll
    for (int m = 0; m < 4; ++m)
#pragma unroll
      for (int bj = 0; bj < 2; ++bj)
#pragma unroll
        for (int n = 0; n < 2; ++n) f(128 * ai + 64 * wr + 16 * m + fr, 128 * bj + 32 * wc + 16 * n + 4 * fq, acc[ai][bj][m][n]);
}
struct EpiBf16 {
  static constexpr bool AFTER_DRAIN = false, PERM = true;
  bf16_t* C;
  __device__ __forceinline__ void operator()(const f32x4 (&acc)[2][2][4][2], const Unit& u, int wr, int wc, int fr, int fq) const {
    bf16_t* base = C + u.cbase; const int ldc = u.ldc;
#pragma unroll
    for (int ai = 0; ai < 2; ++ai)
#pragma unroll
      for (int m = 0; m < 4; ++m)
#pragma unroll
        for (int bj = 0; bj < 2; ++bj) {
          const f32x4 v0 = acc[ai][bj][m][0], v1 = acc[ai][bj][m][1];
          u32x4 o; o[0] = pack_bf16(v0[0], v0[1]); o[1] = pack_bf16(v0[2], v0[3]); o[2] = pack_bf16(v1[0], v1[1]); o[3] = pack_bf16(v1[2], v1[3]);
          *(u32x4*)(base + (size_t)(128 * ai + 64 * wr + 16 * m + fr) * ldc + 128 * bj + 32 * wc + 8 * fq) = o;
        }
  }
};
struct EpiBf16Half {
  static constexpr bool AFTER_DRAIN = false, PERM = false;
  bf16_t* C;
  __device__ __forceinline__ void operator()(const f32x4 (&acc)[2][2][4][2], const Unit& u, int wr, int wc, int fr, int fq) const {
    bf16_t* base = C + u.cbase; const int ldc = u.ldc;
#pragma unroll
    for (int m = 0; m < 4; ++m)
#pragma unroll
      for (int bj = 0; bj < 2; ++bj)
#pragma unroll
        for (int n = 0; n < 2; ++n) {
          const f32x4 v = acc[0][bj][m][n];
          u32x2 o; o[0] = pack_bf16(v[0], v[1]); o[1] = pack_bf16(v[2], v[3]);
          *(u32x2*)(base + (size_t)(64 * wr + 16 * m + fr) * ldc + 128 * bj + 32 * wc + 16 * n + 4 * fq) = o;
        }
  }
};
struct EpiInEven {
  static constexpr bool AFTER_DRAIN = false, PERM = false;
  bf16_t *Q, *Kb, *Vb; float *U, *outk, *outv;
  __device__ __forceinline__ void operator()(const f32x4 (&acc)[2][2][4][2], const Unit& u, int wr, int wc, int fr, int fq) const {
    const int region = u.pn >> 1, cb = (u.pn & 1) * 256, rb = u.pm * 256;
    epi_foreach(acc, wr, wc, fr, fq, [&](int r, int c, f32x4 v) {
      const int row = rb + r, col = cb + c;
      if (region == 3) {
        { u32x2 uw; uw[0] = pack_bf16(v[0], v[1]); uw[1] = pack_bf16(v[2], v[3]); *(u32x2*)((bf16_t*)U + (size_t)(col >> 4) * ((size_t)NTOK * 16) + (size_t)row * 16 + (col & 15)) = uw; }
      } else {
        u32x2 o; o[0] = pack_bf16(v[0], v[1]); o[1] = pack_bf16(v[2], v[3]);
        bf16_t* dst = region == 0 ? Q : (region == 1 ? Kb : Vb);
        *(u32x2*)(dst + (size_t)row * 512 + col) = o;
        if (region != 0 && row < NP) {
          float* od = region == 1 ? outk : outv;
          *(f32x4*)(od + (size_t)row * 512 + col) = v;
        }
      }
    });
  }
};
template <bool FROM_INPUT>
struct EpiResid {
  static constexpr bool AFTER_DRAIN = false, PERM = true;
  const float *xp, *xs; const bf16_t* Xin; bf16_t* Xout; const float* gate;
  bf16_t* AB; const float* gs; float* sumsq;
  __device__ __forceinline__ void operator()(const f32x4 (&acc)[2][2][4][2], const Unit& u, int wr, int wc, int fr, int fq) const {
    const int rb = u.pm * 256, cb = u.pn * 256;
    const int ci = cond_index(rb);
    const int c0 = cb + 32 * wc + 8 * fq;
    f32x4 gt[2][2], g4[2][2];
#pragma unroll
    for (int bj = 0; bj < 2; ++bj)
#pragma unroll
      for (int n = 0; n < 2; ++n) {
        gt[bj][n] = *(const f32x4*)(gate + ci * 6144 + c0 + 128 * bj + 4 * n);
        g4[bj][n] = AB ? *(const f32x4*)(gs + ci * 1024 + c0 + 128 * bj + 4 * n) : (f32x4){0.f, 0.f, 0.f, 0.f};
      }
    const float* xbase = rb < NP ? xp + (size_t)rb * DM : xs + (size_t)(rb - NP) * DM;
    const bf16_t* xbb = Xin + (size_t)rb * DM;
    constexpr int RB = FROM_INPUT ? 2 : 4;
#pragma unroll
    for (int bt = 0; bt < 8 / RB; ++bt) {
      f32x4 xf[FROM_INPUT ? RB : 1][2][2];
      u32x4 xr[FROM_INPUT ? 1 : RB][2];
#pragma unroll
      for (int k = 0; k < RB; ++k)
#pragma unroll
        for (int bj = 0; bj < 2; ++bj) {
          const int lrow = bt * RB + k, ai = lrow >> 2, m = lrow & 3;
          const size_t xo = (size_t)(128 * ai + 64 * wr + 16 * m + fr) * DM + c0 + 128 * bj;
          if constexpr (FROM_INPUT) { xf[k][bj][0] = *(const f32x4*)(xbase + xo); xf[k][bj][1] = *(const f32x4*)(xbase + xo + 4); }
          else xr[k][bj] = *(const u32x4*)(xbb + xo);
        }
#pragma unroll
      for (int k = 0; k < RB; ++k) {
        const int lrow = bt * RB + k, ai = lrow >> 2, m = lrow & 3;
        const int row = rb + 128 * ai + 64 * wr + 16 * m + fr;
        float ss = 0.f;
#pragma unroll
        for (int bj = 0; bj < 2; ++bj) {
          const int col = c0 + 128 * bj;
          f32x4 x0, x1;
          if constexpr (FROM_INPUT) { x0 = xf[k][bj][0]; x1 = xf[k][bj][1]; }
          else {
            const u32x4 t = xr[k][bj];
            x0 = (f32x4){__uint_as_float(t[0] << 16), __uint_as_float(t[0] & 0xffff0000u), __uint_as_float(t[1] << 16), __uint_as_float(t[1] & 0xffff0000u)};
            x1 = (f32x4){__uint_as_float(t[2] << 16), __uint_as_float(t[2] & 0xffff0000u), __uint_as_float(t[3] << 16), __uint_as_float(t[3] & 0xffff0000u)};
          }
          f32x4 o[2];
#pragma unroll
          for (int e = 0; e < 4; ++e) { o[0][e] = x0[e] + gt[bj][0][e] * acc[ai][bj][m][0][e]; o[1][e] = x1[e] + gt[bj][1][e] * acc[ai][bj][m][1][e]; }
          { u32x4 xw; xw[0] = pack_bf16(o[0][0], o[0][1]); xw[1] = pack_bf16(o[0][2], o[0][3]); xw[2] = pack_bf16(o[1][0], o[1][1]); xw[3] = pack_bf16(o[1][2], o[1][3]);
            *(u32x4*)(Xout + (size_t)row * DM + col) = xw; }
          if (AB) {
#pragma unroll
            for (int n = 0; n < 2; ++n)
#pragma unroll
              for (int e = 0; e < 4; ++e) ss += o[n][e] * o[n][e];
            u32x4 w;
            w[0] = pack_bf16(o[0][0] * g4[bj][0][0], o[0][1] * g4[bj][0][1]); w[1] = pack_bf16(o[0][2] * g4[bj][0][2], o[0][3] * g4[bj][0][3]);
            w[2] = pack_bf16(o[1][0] * g4[bj][1][0], o[1][1] * g4[bj][1][1]); w[3] = pack_bf16(o[1][2] * g4[bj][1][2], o[1][3] * g4[bj][1][3]);
            *(u32x4*)(AB + (size_t)row * DM + col) = w;
          }
        }
        if (AB) {
          ss += __shfl_xor(ss, 16);
          ss += __shfl_xor(ss, 32);
          if (fq == 0) atomicAdd(sumsq + row, ss);
        }
      }
    }
  }
};
struct EpiFinal {
  static constexpr bool AFTER_DRAIN = true, PERM = true;
  const bf16_t* Xin; const float* gate; const float* gfin; float* out; float* sumsq; unsigned* pcnt;
  __device__ __forceinline__ void operator()(f32x4 (&acc)[2][2][4][2], const Unit& u, int wr, int wc, int fr, int fq) const {
    const int rb = u.pm * 256, cb = u.pn * 256;
    const int ci = cond_index(rb);
    const int c0 = cb + 32 * wc + 8 * fq;
    f32x4 gt[2][2];
#pragma unroll
    for (int bj = 0; bj < 2; ++bj)
#pragma unroll
      for (int n = 0; n < 2; ++n) gt[bj][n] = *(const f32x4*)(gate + ci * 6144 + c0 + 128 * bj + 4 * n);
    const bf16_t* xbase = Xin + (size_t)rb * DM;
#pragma unroll
    for (int am = 0; am < 4; ++am) {
      const int ai = am >> 1, m0 = (am & 1) * 2;
      f32x4 x[2][2][2];
#pragma unroll
      for (int mm = 0; mm < 2; ++mm)
#pragma unroll
        for (int bj = 0; bj < 2; ++bj) {
          const u32x4 t = *(const u32x4*)(xbase + (size_t)(128 * ai + 64 * wr + 16 * (m0 + mm) + fr) * DM + c0 + 128 * bj);
          x[mm][bj][0] = (f32x4){__uint_as_float(t[0] << 16), __uint_as_float(t[0] & 0xffff0000u), __uint_as_float(t[1] << 16), __uint_as_float(t[1] & 0xffff0000u)};
          x[mm][bj][1] = (f32x4){__uint_as_float(t[2] << 16), __uint_as_float(t[2] & 0xffff0000u), __uint_as_float(t[3] << 16), __uint_as_float(t[3] & 0xffff0000u)};
        }
#pragma unroll
      for (int mm = 0; mm < 2; ++mm) {
        const int m = m0 + mm;
        float ss = 0.f;
#pragma unroll
        for (int bj = 0; bj < 2; ++bj)
#pragma unroll
          for (int n = 0; n < 2; ++n) {
            f32x4 o;
#pragma unroll
            for (int e = 0; e < 4; ++e) { o[e] = x[mm][bj][n][e] + gt[bj][n][e] * acc[ai][bj][m][n][e]; ss += o[e] * o[e]; }
            acc[ai][bj][m][n] = o;
          }
        ss += __shfl_xor(ss, 16);
        ss += __shfl_xor(ss, 32);
        if (fq == 0) atomicAdd(sumsq + rb + 128 * ai + 64 * wr + 16 * m + fr, ss);
      }
    }
    asm volatile("s_waitcnt vmcnt(0)" ::: "memory");
    unsigned* pc = pcnt + u.pm * 64;
    if ((threadIdx.x & 63) == 0) __hip_atomic_fetch_add(pc, 1u, __ATOMIC_RELAXED, __HIP_MEMORY_SCOPE_AGENT);
    {
      unsigned spins = 0;
      while ((unsigned)__builtin_amdgcn_readfirstlane(__hip_atomic_load(pc, __ATOMIC_RELAXED, __HIP_MEMORY_SCOPE_AGENT)) < 32u) {
        __builtin_amdgcn_s_sleep(2);
        if (++spins > (1u << 22)) break;
      }
    }
    f32x4 gf[2][2];
#pragma unroll
    for (int bj = 0; bj < 2; ++bj)
#pragma unroll
      for (int n = 0; n < 2; ++n) gf[bj][n] = *(const f32x4*)(gfin + c0 + 128 * bj + 4 * n);
    float sq[2][4];
#pragma unroll
    for (int ai = 0; ai < 2; ++ai)
#pragma unroll
      for (int m = 0; m < 4; ++m) sq[ai][m] = __hip_atomic_load(sumsq + rb + 128 * ai + 64 * wr + 16 * m + fr, __ATOMIC_RELAXED, __HIP_MEMORY_SCOPE_AGENT);
#pragma unroll
    for (int ai = 0; ai < 2; ++ai)
#pragma unroll
      for (int m = 0; m < 4; ++m) {
        const int row = rb + 128 * ai + 64 * wr + 16 * m + fr;
        const float rs = rsqrtf(sq[ai][m] * (1.0f / DM) + 1e-6f);
#pragma unroll
        for (int bj = 0; bj < 2; ++bj)
#pragma unroll
          for (int n = 0; n < 2; ++n) {
            f32x4 y;
#pragma unroll
            for (int e = 0; e < 4; ++e) y[e] = acc[ai][bj][m][n][e] * rs * gf[bj][n][e];
            *(f32x4*)(out + (size_t)row * DM + c0 + 128 * bj + 4 * n) = y;
          }
      }
  }
};
template <bool HALF>
struct EpiSwiGLU {
  static constexpr bool AFTER_DRAIN = false, PERM = false;
  bf16_t* H; const float* sumsq; const float* shw;
  __device__ __forceinline__ void operator()(const f32x4 (&acc)[2][2][4][2], const Unit& u, int wr, int wc, int fr, int fq) const {
    const int rb = u.row0;
    const float* sw = shw + cond_index(rb) * 5632 + u.pn * 256 + 32 * wc + 4 * fq;
    f32x4 sg[2], su[2];
#pragma unroll
    for (int bj = 0; bj < 2; ++bj) { sg[bj] = *(const f32x4*)(sw + 128 * bj); su[bj] = *(const f32x4*)(sw + 128 * bj + 16); }
    float rstd[2][4];
#pragma unroll
    for (int ai = 0; ai < (HALF ? 1 : 2); ++ai)
#pragma unroll
      for (int m = 0; m < 4; ++m) rstd[ai][m] = sumsq[rb + 128 * ai + 64 * wr + 16 * m + fr];
#pragma unroll
    for (int ai = 0; ai < (HALF ? 1 : 2); ++ai)
#pragma unroll
      for (int m = 0; m < 4; ++m) {
        const int row = rb + 128 * ai + 64 * wr + 16 * m + fr;
        const float rs = rsqrtf(rstd[ai][m] * (1.0f / DM) + 1e-6f);
#pragma unroll
        for (int bj = 0; bj < 2; ++bj) {
          const int col = (u.pn * 256 + 128 * bj + 32 * wc) / 2 + 4 * fq;
          float o[4];
#pragma unroll
          for (int e = 0; e < 4; ++e) o[e] = siluf_(rs * acc[ai][bj][m][0][e] + sg[bj][e]) * (rs * acc[ai][bj][m][1][e] + su[bj][e]);
          u32x2 w; w[0] = pack_bf16(o[0], o[1]); w[1] = pack_bf16(o[2], o[3]);
          *(u32x2*)(H + (size_t)row * DFF + col) = w;
        }
      }
  }
};
struct EpiBf16Norm {
  static constexpr bool AFTER_DRAIN = false, PERM = true;
  bf16_t* C; const float* sumsq; const float* shw;
  __device__ __forceinline__ void operator()(const f32x4 (&acc)[2][2][4][2], const Unit& u, int wr, int wc, int fr, int fq) const {
    const int rb = u.pm * 256, c0 = u.pn * 256 + 32 * wc + 8 * fq;
    const float* sw = shw + cond_index(rb) * 1024 + c0;
    f32x4 sh[2][2];
#pragma unroll
    for (int bj = 0; bj < 2; ++bj)
#pragma unroll
      for (int n = 0; n < 2; ++n) sh[bj][n] = *(const f32x4*)(sw + 128 * bj + 4 * n);
    float rstd[2][4];
#pragma unroll
    for (int ai = 0; ai < 2; ++ai)
#pragma unroll
      for (int m = 0; m < 4; ++m) rstd[ai][m] = sumsq[rb + 128 * ai + 64 * wr + 16 * m + fr];
#pragma unroll
    for (int ai = 0; ai < 2; ++ai)
#pragma unroll
      for (int m = 0; m < 4; ++m) {
        const int row = rb + 128 * ai + 64 * wr + 16 * m + fr;
        const float rs = rsqrtf(rstd[ai][m] * (1.0f / DM) + 1e-6f);
#pragma unroll
        for (int bj = 0; bj < 2; ++bj) {
          const f32x4 v0 = acc[ai][bj][m][0], v1 = acc[ai][bj][m][1];
          u32x4 w;
          w[0] = pack_bf16(rs * v0[0] + sh[bj][0][0], rs * v0[1] + sh[bj][0][1]); w[1] = pack_bf16(rs * v0[2] + sh[bj][0][2], rs * v0[3] + sh[bj][0][3]);
          w[2] = pack_bf16(rs * v1[0] + sh[bj][1][0], rs * v1[1] + sh[bj][1][1]); w[3] = pack_bf16(rs * v1[2] + sh[bj][1][2], rs * v1[3] + sh[bj][1][3]);
          *(u32x4*)(C + (size_t)row * DM + c0 + 128 * bj) = w;
        }
      }
  }
};
template <bool HALF>
struct EpiGlu {
  static constexpr bool AFTER_DRAIN = false, PERM = true;
  const bf16_t* YBF; const float* bias; bf16_t* CAT;
  __device__ __forceinline__ void operator()(const f32x4 (&acc)[2][2][4][2], const Unit& u, int wr, int wc, int fr, int fq) const {
    const int rb = u.row0, c0 = u.pn * 256 + 32 * wc + 8 * fq;
    f32x4 bb[2][2];
#pragma unroll
    for (int bj = 0; bj < 2; ++bj)
#pragma unroll
      for (int n = 0; n < 2; ++n) bb[bj][n] = *(const f32x4*)(bias + c0 + 128 * bj + 4 * n);
#pragma unroll
    for (int ai = 0; ai < (HALF ? 1 : 2); ++ai) {
      u32x4 yy[4][2];
#pragma unroll
      for (int m = 0; m < 4; ++m)
#pragma unroll
        for (int bj = 0; bj < 2; ++bj) yy[m][bj] = *(const u32x4*)(YBF + (size_t)(rb + 128 * ai + 64 * wr + 16 * m + fr) * 512 + c0 + 128 * bj);
#pragma unroll
      for (int m = 0; m < 4; ++m) {
        const int row = rb + 128 * ai + 64 * wr + 16 * m + fr;
#pragma unroll
        for (int bj = 0; bj < 2; ++bj) {
          u32x4 w;
#pragma unroll
          for (int n = 0; n < 2; ++n) {
            const f32x4 v = acc[ai][bj][m][n]; const f32x4 b = bb[bj][n];
            const unsigned ya = yy[m][bj][2 * n], yb = yy[m][bj][2 * n + 1];
            const float y0 = __uint_as_float(ya << 16), y1 = __uint_as_float(ya & 0xffff0000u), y2 = __uint_as_float(yb << 16), y3 = __uint_as_float(yb & 0xffff0000u);
            w[2 * n] = pack_bf16(y0 * sigmoidf_(v[0] + b[0]), y1 * sigmoidf_(v[1] + b[1]));
            w[2 * n + 1] = pack_bf16(y2 * sigmoidf_(v[2] + b[2]), y3 * sigmoidf_(v[3] + b[3]));
          }
          *(u32x4*)(CAT + (size_t)row * DM + 512 + c0 + 128 * bj) = w;
        }
      }
    }
  }
};

__device__ __forceinline__ void prep_mod_item(const Params& p, int item, char* smem, int tid) {
  const int layer = item / 96, cg64 = item % 96;
  const int kg = tid >> 4, l16 = tid & 15;
  float* sc = (float*)smem;
  float* red = (float*)(smem + 12288);
  __syncthreads();
  for (int i = tid; i < 3072; i += 256) {
    const int ci = i >> 10, k = i & 1023;
    const float cv = ci == 0 ? p.c_ctx[k] : p.c[(ci - 1) * DM + k];
    sc[i] = siluf_(cv);
  }
  __syncthreads();
  const int col = cg64 * 64 + l16 * 4;
  const float* w = p.w_mod + ((size_t)layer * DM + kg * 64) * 6144 + col;
  float a[3][4];
#pragma unroll
  for (int ci = 0; ci < 3; ++ci)
#pragma unroll
    for (int e = 0; e < 4; ++e) a[ci][e] = 0.f;
#pragma unroll 8
  for (int r = 0; r < 64; ++r) {
    const f32x4 wv = *(const f32x4*)(w + (size_t)r * 6144);
#pragma unroll
    for (int ci = 0; ci < 3; ++ci) {
      const float s = sc[ci * 1024 + kg * 64 + r];
#pragma unroll
      for (int e = 0; e < 4; ++e) a[ci][e] += s * wv[e];
    }
  }
#pragma unroll
  for (int ci = 0; ci < 3; ++ci)
#pragma unroll
    for (int e = 0; e < 4; ++e) red[(kg * 3 + ci) * 64 + l16 * 4 + e] = a[ci][e];
  __syncthreads();
  if (tid < 192) {
    const int ci = tid >> 6, c = tid & 63;
    float sum = p.b_mod[layer * 6144 + cg64 * 64 + c];
#pragma unroll
    for (int k2 = 0; k2 < 16; ++k2) sum += red[(k2 * 3 + ci) * 64 + c];
    ((float*)(p.ws + OFF_MOD))[(size_t)(layer * 3 + ci) * 6144 + cg64 * 64 + c] = sum;
  }
}

__device__ __forceinline__ void prep_transpose_tile(const float* src, int K, int N, bf16_t* dst, int kt, int nt, int mapmode, char* smem, int tid) {
  float* T = (float*)smem;
  __syncthreads();
#pragma unroll
  for (int i = 0; i < 4; ++i) {
    const int idx = tid + 256 * i, kr = idx >> 4, c4 = idx & 15;
    const f32x4 v = *(const f32x4*)(src + (size_t)(kt * 64 + kr) * N + nt * 64 + c4 * 4);
#pragma unroll
    for (int e = 0; e < 4; ++e) T[kr * 65 + c4 * 4 + e] = v[e];
  }
  __syncthreads();
#pragma unroll
  for (int i = 0; i < 2; ++i) {
    const int idx = tid + 256 * i, nr = idx >> 3, seg = idx & 7;
    f32x4 a, b;
#pragma unroll
    for (int e = 0; e < 4; ++e) { a[e] = T[(seg * 8 + e) * 65 + nr]; b[e] = T[(seg * 8 + 4 + e) * 65 + nr]; }
    const int n = nt * 64 + nr;
    int drow = n;
    if (mapmode == 1) drow = (n >> 4) * 32 + (n & 15);
    else if (mapmode == 2) drow = (n >> 4) * 32 + 16 + (n & 15);
    *(u32x4*)(dst + (size_t)drow * K + kt * 64 + seg * 8) = pack8(a, b);
  }
}

__device__ __forceinline__ void prep_s5_item(const Params& p, int item, int tid) {
  const int idx = item * 256 + tid;
  const int d = idx >> 11, g = (idx >> 6) & 31;
  const float lr = fminf(p.lam_re[idx], -1e-4f), li = p.lam_im[idx];
  const float dt = expf(p.log_step[d * 32 + g]);
  const float mag = expf(lr * dt);
  const float ar = mag * cosf(li * dt), ai = mag * sinf(li * dt);
  const float den = lr * lr + li * li, nr = ar - 1.0f, ni = ai;
  const float cr = (nr * lr + ni * li) / den, ci = (ni * lr - nr * li) / den;
  ((float*)(p.ws + OFF_AR))[idx] = ar;
  ((float*)(p.ws + OFF_AI))[idx] = ai;
  float* bb = (float*)(p.ws + OFF_BBAR);
  const int pp = idx & 63;
  const size_t o0 = ((size_t)((d * 32 + g) * 2 + 0) * 64 + pp) * 16, o1 = ((size_t)((d * 32 + g) * 2 + 1) * 64 + pp) * 16;
  for (int h = 0; h < 16; ++h) {
    const float br = p.b_re[(size_t)idx * 16 + h], bi = p.b_im[(size_t)idx * 16 + h];
    bb[o0 + h] = cr * br - ci * bi;
    bb[o1 + h] = cr * bi + ci * br;
  }
}

__device__ __forceinline__ void prep_dft_item(const Params& p, int item, int tid) {
  bf16_t* dst; int e0;
  int mode;
  if (item < 64) { dst = (bf16_t*)(p.ws + OFF_CS2); e0 = item * 2048 + tid * 8; mode = 0; }
  else if (item < 128) { dst = (bf16_t*)(p.ws + OFF_CL2P); e0 = (item - 64) * 2048 + tid * 8; mode = 1; }
  else { dst = (bf16_t*)(p.ws + OFF_CL2S); e0 = (item - 128) * 2048 + tid * 8; mode = 2; }
  float v[8];
#pragma unroll
  for (int j = 0; j < 8; ++j) {
    const int e = e0 + j;
    float s, c;
    if (mode == 0) {
      const int row = e >> 8, cc = e & 255, kc = row >> 1, cs = row & 1;
      const int ph = (kc * cc) & 255;
      sincospif((float)ph * (2.0f / 256.0f), &s, &c);
      v[j] = (cs ? s : c) * (1.0f / 16.0f);
    } else if (mode == 1) {
      const int kl = e >> 9, r = e & 511, cs = r >> 8, l = r & 255;
      const int ph = (kl * l) & 255;
      sincospif((float)ph * (2.0f / 256.0f), &s, &c);
      v[j] = (cs ? -s : c) * (1.0f / 16.0f);
    } else {
      const int kl = e >> 11, r = e & 2047, cs = r >> 10, l = r & 1023;
      const int ph = (kl * l) & 1023;
      sincospif((float)ph * (2.0f / 1024.0f), &s, &c);
      v[j] = (cs ? -s : c) * (1.0f / 32.0f);
    }
  }
  u32x4 o; o[0] = pack_bf16(v[0], v[1]); o[1] = pack_bf16(v[2], v[3]); o[2] = pack_bf16(v[4], v[5]); o[3] = pack_bf16(v[6], v[7]);
  *(u32x4*)(dst + e0) = o;
}

__device__ __forceinline__ void prep_transpose_job(const Params& p, int job, int t, char* smem, int tid) {
  if (job == 0) prep_transpose_tile(p.w_in_even, 1024, 2048, (bf16_t*)(p.ws + OFF_WT_IN), t / 32, t % 32, 0, smem, tid);
  else if (job == 1) prep_transpose_tile(p.glu_w, 512, 512, (bf16_t*)(p.ws + OFF_WT_GLU), t / 8, t % 8, 0, smem, tid);
  else if (job <= 4) {
    const float* src = job == 2 ? p.w_out_even : (job == 3 ? p.w_in_odd : p.w_out_odd);
    const size_t off = job == 2 ? OFF_WT_OUT : (job == 3 ? OFF_WT_INO : OFF_WT_OUTO);
    prep_transpose_tile(src, 1024, 1024, (bf16_t*)(p.ws + off), t / 16, t % 16, 0, smem, tid);
  } else if (job <= 8) {
    const int layer = (job - 5) & 1, isup = (job - 5) >> 1;
    const float* src = (isup ? p.w_up : p.w_gate) + (size_t)layer * 1024 * DFF;
    prep_transpose_tile(src, 1024, DFF, (bf16_t*)(p.ws + OFF_WT_GU) + (size_t)layer * 5632 * 1024, t / 44, t % 44, 1 + isup, smem, tid);
  } else {
    const int layer = job - 9;
    prep_transpose_tile(p.w_down + (size_t)layer * DFF * 1024, DFF, 1024, (bf16_t*)(p.ws + OFF_WT_DN) + (size_t)layer * 1024 * DFF, t / 16, t % 16, 0, smem, tid);
  }
}
constexpr int TR_EARLY = 512;
constexpr int TR_MID = 64 + 256 + 256 + 3 * 704;
constexpr int TR_LATE = 256 + 3 * 704;
__device__ __forceinline__ void prep_transpose_early(const Params& p, int t, char* smem, int tid) {
  prep_transpose_job(p, 0, t, smem, tid);
}
__device__ __forceinline__ void prep_transpose_mid(const Params& p, int t, char* smem, int tid) {
  int job;
  if (t < 64) job = 1; else if ((t -= 64) < 256) job = 2; else if ((t -= 256) < 256) job = 3;
  else if ((t -= 256) < 704) job = 5; else if ((t -= 704) < 704) job = 7; else { t -= 704; job = 9; }
  prep_transpose_job(p, job, t, smem, tid);
}
__device__ __forceinline__ void prep_transpose_late(const Params& p, int t, char* smem, int tid) {
  int job;
  if (t < 256) job = 4; else if ((t -= 256) < 704) job = 6; else if ((t -= 704) < 704) job = 8; else { t -= 704; job = 10; }
  prep_transpose_job(p, job, t, smem, tid);
}

__device__ __forceinline__ void phase_prep(const Params& p, char* smem0) {
  constexpr int T0 = 96;
  constexpr int S0 = T0 + TR_EARLY, TOTAL = S0 + 16;
  static_assert((T0 % 2) == 0 && (TR_EARLY % 2) == 0 && (TOTAL % 2) == 0, "even");
  const int T_ = opaque_tid();
  const int vb = T_ >> 8, tid = T_ & 255;
  char* smem = smem0 + vb * 32768;
  for (int item0 = blockIdx.x * 2; item0 < TOTAL; item0 += gridDim.x * 2) {
    const int item = item0 + vb;
    if (item < T0) prep_mod_item(p, item, smem, tid);
    else if (item < S0) prep_transpose_early(p, item - T0, smem, tid);
    else prep_s5_item(p, item - S0, tid);
  }
}
__device__ __forceinline__ void phase_prep_mod1(const Params& p, char* smem0, int first_block) {
  if ((int)blockIdx.x < first_block) return;
  const int T_ = opaque_tid();
  const int vb = T_ >> 8, tid = T_ & 255;
  char* smem = smem0 + vb * 32768;
  const int nb = gridDim.x - first_block;
  for (int item0 = ((int)blockIdx.x - first_block) * 2; item0 < 96; item0 += nb * 2) prep_mod_item(p, 96 + item0 + vb, smem, tid);
}
__device__ __forceinline__ void phase_prep_dft(const Params& p, int first_block) {
  if ((int)blockIdx.x < first_block) return;
  const int T_ = opaque_tid();
  const int vb = T_ >> 8, tid = T_ & 255;
  const int nb = gridDim.x - first_block;
  for (int item0 = ((int)blockIdx.x - first_block) * 2; item0 < 1152; item0 += nb * 2) prep_dft_item(p, item0 + vb, tid);
}
__device__ __forceinline__ void phase_prep_late(const Params& p, char* smem0, int which, int first_block) {
  if ((int)blockIdx.x < first_block) return;
  const int T_ = opaque_tid();
  const int vb = T_ >> 8, tid = T_ & 255;
  char* smem = smem0 + vb * 32768;
  const int nb = gridDim.x - first_block, total = which ? TR_LATE : TR_MID;
  for (int item0 = ((int)blockIdx.x - first_block) * 2; item0 < total; item0 += nb * 2) {
    if (which) prep_transpose_late(p, item0 + vb, smem, tid); else prep_transpose_mid(p, item0 + vb, smem, tid);
  }
}

__device__ __forceinline__ void phase_norm(const Params& p, bool from_input, const float* gvec, const float* modbase  ) {
  const int T_ = opaque_tid();
  const int lane = T_ & 63, wid = T_ >> 6;
  const float* X = (const float*)(p.ws + OFF_X);
  bf16_t* A = (bf16_t*)(p.ws + OFF_ABUF);
  for (int row = blockIdx.x * 8 + wid; row < NTOK; row += gridDim.x * 8) {
    const float* xr = from_input ? xin_row(p, row) : X + (size_t)row * DM;
    f32x4 v[4];
    float ss = 0.f;
#pragma unroll
    for (int i = 0; i < 4; ++i) {
      v[i] = *(const f32x4*)(xr + i * 256 + lane * 4);
#pragma unroll
      for (int e = 0; e < 4; ++e) ss += v[i][e] * v[i][e];
    }
#pragma unroll
    for (int o = 32; o >= 1; o >>= 1) ss += __shfl_xor(ss, o);
    const float rstd = rsqrtf(ss * (1.0f / DM) + 1e-6f);
    const float* mb = modbase + cond_index(row) * 6144;
#pragma unroll
    for (int i = 0; i < 4; ++i) {
      const int k = i * 256 + lane * 4;
      const f32x4 g = *(const f32x4*)(gvec + k), sh = *(const f32x4*)(mb + k), sc = *(const f32x4*)(mb + 1024 + k);
      float o[4];
#pragma unroll
      for (int e = 0; e < 4; ++e) o[e] = v[i][e] * rstd * g[e] * (1.0f + sc[e]) + sh[e];
      u32x2 w; w[0] = pack_bf16(o[0], o[1]); w[1] = pack_bf16(o[2], o[3]);
      *(u32x2*)(A + (size_t)row * DM + k) = w;
    }
  }
}
__device__ __forceinline__ void phase_norm_consts(const Params& p, int part, int first_block) {
  const int T_ = opaque_tid();
  const int lane = T_ & 63, wid = T_ >> 6;
  const float* MOD = (const float*)(p.ws + OFF_MOD);
  float* GS = (float*)(p.ws + OFF_GS);
  const int nblk = (int)gridDim.x - first_block, blk = (int)blockIdx.x - first_block;
  if (blk < 0) return;
  if (part < 2) {
    const int i0 = part == 0 ? 0 : 3072, i1 = part == 0 ? 3072 : 9216;
    for (int i = i0 + blk * 512 + T_; i < i1; i += nblk * 512) {
      const int uu = i / 3072, ci = (i >> 10) % 3, k = i & 1023;
      const float* gvec = uu == 0 ? p.norm_ffn_g : (uu == 1 ? p.norm_mix_g + DM : p.norm_ffn_g + DM);
      const int layer = uu == 0 ? 0 : 1, j = uu == 1 ? 1 : 4;
      GS[i] = gvec[k] * (1.0f + MOD[(size_t)(layer * 3 + ci) * 6144 + j * 1024 + k]);
    }
  }
  const int rbase = part == 0 ? 0 : (part == 2 ? 5632 : 11264), rcnt = part == 1 ? 1024 : 5632;
  for (int r0 = blk * 8 + wid; r0 < rcnt; r0 += nblk * 8) {
    const int row = rbase + r0;
    const bf16_t* wrow; const float* sh; float* dst; int dstride;
    if (row < 2 * 5632) {
      const int layer = row / 5632, n = row - layer * 5632;
      wrow = (const bf16_t*)(p.ws + OFF_WT_GU) + (size_t)row * 1024;
      sh = MOD + (size_t)layer * 3 * 6144 + 3 * 1024;
      dst = (float*)(p.ws + OFF_SHWGU) + (size_t)layer * 3 * 5632 + n; dstride = 5632;
    } else {
      const int n = row - 2 * 5632;
      wrow = (const bf16_t*)(p.ws + OFF_WT_INO) + (size_t)n * 1024;
      sh = MOD + (size_t)3 * 6144;
      dst = (float*)(p.ws + OFF_SHWINO) + n; dstride = 1024;
    }
    const u32x4 w0 = *(const u32x4*)(wrow + lane * 16), w1 = *(const u32x4*)(wrow + lane * 16 + 8);
    float wf[16];
#pragma unroll
    for (int q = 0; q < 4; ++q) { wf[2 * q] = __uint_as_float(w0[q] << 16); wf[2 * q + 1] = __uint_as_float(w0[q] & 0xffff0000u); wf[8 + 2 * q] = __uint_as_float(w1[q] << 16); wf[8 + 2 * q + 1] = __uint_as_float(w1[q] & 0xffff0000u); }
#pragma unroll
    for (int ci = 0; ci < 3; ++ci) {
      float acc = 0.f;
#pragma unroll
      for (int q = 0; q < 4; ++q) {
        const f32x4 sv = *(const f32x4*)(sh + ci * 6144 + lane * 16 + q * 4);
#pragma unroll
        for (int e = 0; e < 4; ++e) acc += wf[q * 4 + e] * sv[e];
      }
#pragma unroll
      for (int o = 32; o >= 1; o >>= 1) acc += __shfl_xor(acc, o);
      if (lane == 0) dst[ci * dstride] = acc;
    }
  }
}

__device__ __forceinline__ void phase_final_norm(const Params& p) {
  const int T_ = opaque_tid();
  const int lane = T_ & 63, wid = T_ >> 6;
  const float* X = (const float*)(p.ws + OFF_X);
  for (int row = blockIdx.x * 8 + wid; row < NTOK; row += gridDim.x * 8) {
    const float* xr = X + (size_t)row * DM;
    f32x4 v[4];
    float ss = 0.f;
#pragma unroll
    for (int i = 0; i < 4; ++i) {
      v[i] = *(const f32x4*)(xr + i * 256 + lane * 4);
#pragma unroll
      for (int e = 0; e < 4; ++e) ss += v[i][e] * v[i][e];
    }
#pragma unroll
    for (int o = 32; o >= 1; o >>= 1) ss += __shfl_xor(ss, o);
    const float rstd = rsqrtf(ss * (1.0f / DM) + 1e-6f);
#pragma unroll
    for (int i = 0; i < 4; ++i) {
      const int k = i * 256 + lane * 4;
      const f32x4 g = *(const f32x4*)(p.final_g + k);
      f32x4 o;
#pragma unroll
      for (int e = 0; e < 4; ++e) o[e] = v[i][e] * rstd * g[e];
      *(f32x4*)(p.out + (size_t)row * DM + k) = o;
    }
  }
}

__device__ __forceinline__ void attn_item(const Params& p, int item, char* smem, int tid, int c_lo, int c_hi, int ntrips, int merge, char* smem_peer) {
  const int lane = tid & 63, wid = tid >> 6, lr = lane & 31, lh = lane >> 5;
  const bf16_t* QB = (const bf16_t*)(p.ws + OFF_QB);
  const bf16_t* KB = (const bf16_t*)(p.ws + OFF_KB);
  const bf16_t* VB = (const bf16_t*)(p.ws + OFF_VB);
  bf16_t* CAT = (bf16_t*)(p.ws + OFF_CAT);
  bool latent; int b, head, qrow0, nchunks, r0 = 0, rowstart = 0;
  if (item < 128) { latent = true; b = item >> 6; head = (item >> 3) & 7; const int rp = item & 7; r0 = rp * 2; qrow0 = NP + b * LS + r0 * 64; nchunks = 9;
    int rs0 = r0 - 4; rs0 = rs0 < 0 ? 0 : (rs0 > 8 ? 8 : rs0); rowstart = rs0 < 6 ? rs0 : 6; }
  else { latent = false; const int it = item - 128; b = it >> 4; head = (it >> 1) & 7; qrow0 = b * LP + (it & 1) * 128; nchunks = 2; }
  const int qrow = qrow0 + wid * 32 + lr;
  bf16x8 qf[4];
#pragma unroll
  for (int ks = 0; ks < 4; ++ks) qf[ks] = *(const bf16x8*)(QB + (size_t)qrow * 512 + head * 64 + ks * 16 + lh * 8);
  f32x16 o[2];
#pragma unroll
  for (int i = 0; i < 16; ++i) { o[0][i] = 0.f; o[1][i] = 0.f; }
  float mrun = -1e30f, lsum = 0.f;
  const int qr = r0 + (wid >> 1), qc = (wid & 1) * 32 + lr;
  int rs = qr - 4; rs = rs < 0 ? 0 : (rs > 8 ? 8 : rs);
  int cs = qc - 8; cs = cs < 0 ? 0 : (cs > 48 ? 48 : cs);
  char* Ks = smem;
  char* Vt = smem + 16384;
  const float LOG2E = 1.4426950408889634f;
  (void)nchunks;
  for (int tr = 0; tr < ntrips; ++tr) {
    const int c = c_lo + tr;
    const bool active = c < c_hi;
    const bool local = latent && c < 5;
    __syncthreads();
    if (active) {
    if (!latent || local) {
      const int krow0 = latent ? NP + b * LS + (rowstart + 2 * c) * 64 : b * LP + c * 128;
#pragma unroll
      for (int i = 0; i < 4; ++i) {
        const int idx = tid + 256 * i, key = idx >> 3, seg = idx & 7;
        const u32x4 v = *(const u32x4*)(KB + (size_t)(krow0 + key) * 512 + head * 64 + seg * 8);
        *(u32x4*)(Ks + key * 128 + ((seg ^ ((key >> 1) & 7)) << 4)) = v;
      }
#pragma unroll
      for (int i = 0; i < 2; ++i) {
        const int idx = tid + 256 * i, kp = idx >> 3, seg = idx & 7;
        const u32x4 v0 = *(const u32x4*)(VB + (size_t)(krow0 + 2 * kp) * 512 + head * 64 + seg * 8);
        const u32x4 v1 = *(const u32x4*)(VB + (size_t)(krow0 + 2 * kp + 1) * 512 + head * 64 + seg * 8);
#pragma unroll
        for (int j = 0; j < 4; ++j) {
          const unsigned lo = (v0[j] & 0xffffu) | (v1[j] << 16), hi = (v0[j] >> 16) | (v1[j] & 0xffff0000u);
          *(unsigned*)(Vt + (seg * 8 + 2 * j) * 272 + kp * 4) = lo;
          *(unsigned*)(Vt + (seg * 8 + 2 * j + 1) * 272 + kp * 4) = hi;
        }
      }
    } else {
      const int l0 = (c - 5) * 128;
      const float* ck = p.cache_k + ((size_t)b * 512 + l0) * 512 + head * 64;
      const float* cv = p.cache_v + ((size_t)b * 512 + l0) * 512 + head * 64;
#pragma unroll
      for (int i = 0; i < 4; ++i) {
        const int idx = tid + 256 * i, key = idx >> 3, seg = idx & 7;
        const f32x4 a = *(const f32x4*)(ck + (size_t)key * 512 + seg * 8), bq = *(const f32x4*)(ck + (size_t)key * 512 + seg * 8 + 4);
        *(u32x4*)(Ks + key * 128 + ((seg ^ ((key >> 1) & 7)) << 4)) = pack8(a, bq);
      }
#pragma unroll
      for (int i = 0; i < 2; ++i) {
        const int idx = tid + 256 * i, kp = idx >> 3, seg = idx & 7;
        const float* s0 = cv + (size_t)(2 * kp) * 512 + seg * 8;
        const float* s1 = s0 + 512;
#pragma unroll
        for (int h4 = 0; h4 < 2; ++h4) {
          const f32x4 a = *(const f32x4*)(s0 + 4 * h4), bq = *(const f32x4*)(s1 + 4 * h4);
#pragma unroll
          for (int e = 0; e < 4; ++e) *(unsigned*)(Vt + (seg * 8 + 4 * h4 + e) * 272 + kp * 4) = pack_bf16(a[e], bq[e]);
        }
      }
    }
    }
    __syncthreads();
    if (active)
#pragma unroll 1
    for (int kt = 0; kt < 4; ++kt) {
      int kr = 0;
      if (local) {
        kr = rowstart + 2 * c + (kt >> 1);
        if (kr < rs || kr >= rs + 8) continue;
      }
      f32x16 st;
#pragma unroll
      for (int i = 0; i < 16; ++i) st[i] = 0.f;
#pragma unroll
      for (int ks = 0; ks < 4; ++ks) {
        const int row = kt * 32 + lr;
        const bf16x8 kf = *(const bf16x8*)(Ks + row * 128 + (((ks * 2 + lh) ^ ((row >> 1) & 7)) << 4));
        st = __builtin_amdgcn_mfma_f32_32x32x16_bf16(kf, qf[ks], st, 0, 0, 0);
      }
      float s2[16];
      float tmax = -1e30f;
      if (local) {
        const float* rp = p.na_rpb + ((size_t)head * 15 + (kr - qr + 7)) * 31;
#pragma unroll
        for (int i = 0; i < 16; ++i) {
          const int kc = (kt & 1) * 32 + 8 * (i >> 2) + 4 * lh + (i & 3);
          const bool valid = kc >= cs && kc < cs + 16;
          float sv = -1e30f;
          if (valid) sv = (st[i] * 0.125f + rp[kc - qc + 15]) * LOG2E;
          s2[i] = sv;
          tmax = fmaxf(tmax, sv);
        }
      } else {
#pragma unroll
        for (int i = 0; i < 16; ++i) { s2[i] = st[i] * (0.125f * LOG2E); tmax = fmaxf(tmax, s2[i]); }
      }
      tmax = fmaxf(tmax, xor32(tmax));
      const float mnew = fmaxf(mrun, tmax);
      const float alpha = __builtin_amdgcn_exp2f(mrun - mnew);
      mrun = mnew;
      float psum = 0.f;
#pragma unroll
      for (int i = 0; i < 16; ++i) { s2[i] = __builtin_amdgcn_exp2f(s2[i] - mnew); psum += s2[i]; }
      lsum = lsum * alpha + psum;
#pragma unroll
      for (int i = 0; i < 16; ++i) { o[0][i] *= alpha; o[1][i] *= alpha; }
#pragma unroll
      for (int s = 0; s < 2; ++s) {
        u32x4 pk;
        pk[0] = pack_bf16(s2[8 * s + 0], s2[8 * s + 1]); pk[1] = pack_bf16(s2[8 * s + 2], s2[8 * s + 3]);
        pk[2] = pack_bf16(s2[8 * s + 4], s2[8 * s + 5]); pk[3] = pack_bf16(s2[8 * s + 6], s2[8 * s + 7]);
        const bf16x8 pf = as_bf16x8(pk);
#pragma unroll
        for (int dt = 0; dt < 2; ++dt) {
          const char* vp = Vt + (dt * 32 + lr) * 272 + (kt * 32 + 16 * s + 4 * lh) * 2;
          const u32x2 a0 = *(const u32x2*)vp, a1 = *(const u32x2*)(vp + 16);
          u32x4 vv; vv[0] = a0[0]; vv[1] = a0[1]; vv[2] = a1[0]; vv[3] = a1[1];
          o[dt] = __builtin_amdgcn_mfma_f32_32x32x16_bf16(as_bf16x8(vv), pf, o[dt], 0, 0, 0);
        }
      }
    }
  }
  float ltot = lsum + xor32(lsum);
  if (merge == 1) {
    __syncthreads();
    char* pb_ = smem + wid * 8704;
#pragma unroll
    for (int dt = 0; dt < 2; ++dt)
#pragma unroll
      for (int i = 0; i < 16; ++i) *(float*)(pb_ + (dt * 16 + i) * 256 + lane * 4) = o[dt][i];
    *(float*)(pb_ + 8192 + lane * 4) = mrun;
    *(float*)(pb_ + 8448 + lane * 4) = ltot;
    __syncthreads();
    return;
  }
  if (merge == 2) {
    __syncthreads();
    __syncthreads();
    const char* pb_ = smem_peer + wid * 8704;
    const float m1 = *(const float*)(pb_ + 8192 + lane * 4), l1 = *(const float*)(pb_ + 8448 + lane * 4);
    const float m = fmaxf(mrun, m1);
    const float a0 = __builtin_amdgcn_exp2f(mrun - m), a1 = __builtin_amdgcn_exp2f(m1 - m);
    ltot = ltot * a0 + l1 * a1;
#pragma unroll
    for (int dt = 0; dt < 2; ++dt)
#pragma unroll
      for (int i = 0; i < 16; ++i) o[dt][i] = o[dt][i] * a0 + *(const float*)(pb_ + (dt * 16 + i) * 256 + lane * 4) * a1;
  }
  const float inv = 1.0f / ltot;
#pragma unroll
  for (int dt = 0; dt < 2; ++dt)
#pragma unroll
    for (int g = 0; g < 4; ++g) {
      const int d = dt * 32 + 8 * g + 4 * lh;
      u32x2 w; w[0] = pack_bf16(o[dt][4 * g] * inv, o[dt][4 * g + 1] * inv); w[1] = pack_bf16(o[dt][4 * g + 2] * inv, o[dt][4 * g + 3] * inv);
      *(u32x2*)(CAT + (size_t)qrow * DM + head * 64 + d) = w;
    }
}

template <bool FULL>
__device__ __forceinline__ void s5_scan(const Params& p, int trow0, int dstep, int nch, int g, int d, float (&cr_)[2], float (&ci_)[2], char* xs) {
  const int lane = opaque_tid() & 63, lr = lane & 31, lh = lane >> 5;
  const bf16_t* U = (const bf16_t*)(p.ws + OFF_U);
  float* Y = (float*)(p.ws + (d ? OFF_YB : OFF_YF));
  const float* AR = (const float*)(p.ws + OFF_AR);
  const float* AI = (const float*)(p.ws + OFF_AI);
  const float* BB = (const float*)(p.ws + OFF_BBAR);
  const int dg = d * 32 + g;
  bf16x8 bfrag[4];
#pragma unroll
  for (int nb = 0; nb < 4; ++nb) {
    const int ri = nb >> 1, pb = nb & 1;
    const float* src = BB + ((size_t)(dg * 2 + ri) * 64 + pb * 32 + lr) * 16 + lh * 8;
    bfrag[nb] = as_bf16x8(pack8(*(const f32x4*)src, *(const f32x4*)(src + 4)));
  }
  bf16x8 cfrag[4];
  if (FULL) {
    const int hch = lane & 15, q4 = lane >> 4;
#pragma unroll
    for (int ks = 0; ks < 4; ++ks) {
      const int p0 = 16 * ks + 4 * q4;
      const f32x4 cr = *(const f32x4*)(p.c_re + ((size_t)dg * 16 + hch) * 64 + p0), ci = *(const f32x4*)(p.c_im + ((size_t)dg * 16 + hch) * 64 + p0);
      u32x4 t; t[0] = pack_bf16(cr[0], -ci[0]); t[1] = pack_bf16(cr[1], -ci[1]); t[2] = pack_bf16(cr[2], -ci[2]); t[3] = pack_bf16(cr[3], -ci[3]);
      cfrag[ks] = as_bf16x8(t);
    }
  }
  float a1r_[2], a1i_[2], a16r_[2], a16i_[2];
#pragma unroll
  for (int pb = 0; pb < 2; ++pb) {
    float ar = AR[dg * 64 + pb * 32 + lr], ai = AI[dg * 64 + pb * 32 + lr];
    a1r_[pb] = ar; a1i_[pb] = ai;
#pragma unroll
    for (int k = 0; k < 4; ++k) { const float nr = ar * ar - ai * ai, ni = 2.f * ar * ai; ar = nr; ai = ni; }
    a16r_[pb] = ar; a16i_[pb] = ai;
  }
  const int upos = 16 * ((lr >> 2) & 1) + 4 * (lr >> 3) + (lr & 3);
  const bf16_t* up0 = U + (size_t)g * ((size_t)NTOK * 16) + (size_t)(trow0 + dstep * upos) * 16 + lh * 8;
  const long ustep = (long)dstep * 32 * 16;
  u32x4 un = *(const u32x4*)up0;
  auto cproj = [&](int cprev, const char* xb) {
#pragma unroll
    for (int mt = 0; mt < 2; ++mt) {
      f32x4 ya = {0.f, 0.f, 0.f, 0.f};
#pragma unroll
      for (int ks = 0; ks < 4; ++ks) {
        const bf16x8 xf = *(const bf16x8*)(xb + (mt * 16 + (lane & 15)) * 272 + (32 * ks + 8 * (lane >> 4)) * 2);
        ya = __builtin_amdgcn_mfma_f32_16x16x32_bf16(cfrag[ks], xf, ya, 0, 0, 0);
      }
      const int sp = cprev * 32 + mt * 16 + (lane & 15);
      *(f32x4*)(Y + (size_t)g * ((size_t)NTOK * 16) + (size_t)(trow0 + dstep * sp) * 16 + (lane >> 4) * 4) = ya;
    }
  };
#pragma unroll 1
  for (int c = 0; c < nch; ++c) {
    const bf16x8 uf = as_bf16x8(un);
    if (c + 1 < nch) { const bf16_t* upn = up0 + (long)(c + 1) * ustep; un = *(const u32x4*)upn; }
    f32x16 xr[2], xi[2];
#pragma unroll
    for (int pb = 0; pb < 2; ++pb) {
#pragma unroll
      for (int i = 0; i < 16; ++i) { xr[pb][i] = 0.f; xi[pb][i] = 0.f; }
      xr[pb] = __builtin_amdgcn_mfma_f32_32x32x16_bf16(uf, bfrag[pb], xr[pb], 0, 0, 0);
      xi[pb] = __builtin_amdgcn_mfma_f32_32x32x16_bf16(uf, bfrag[2 + pb], xi[pb], 0, 0, 0);
    }
    if (FULL && c > 0) cproj(c - 1, xs + ((c - 1) & 1) * 8704);
    char* xw = xs + (c & 1) * 8704;
#pragma unroll
    for (int pb = 0; pb < 2; ++pb) {
      const float a1r = a1r_[pb], a1i = a1i_[pb];
      {
        const float c0r = lh ? 0.f : cr_[pb], c0i = lh ? 0.f : ci_[pb];
        xr[pb][0] += a1r * c0r - a1i * c0i;
        xi[pb][0] += a1r * c0i + a1i * c0r;
      }
#pragma unroll
      for (int i = 1; i < 16; ++i) {
        const float pr = xr[pb][i - 1], pi = xi[pb][i - 1];
        xr[pb][i] += a1r * pr - a1i * pi;
        xi[pb][i] += a1r * pi + a1i * pr;
      }
      const float hr = half_bcast(xr[pb][15], 0), hi = half_bcast(xi[pb][15], 0);
      const float c2r = lh ? hr : 0.f, c2i = lh ? hi : 0.f;
      if (FULL) {
        float fr_ = c2r, fi_ = c2i;
#pragma unroll
        for (int i = 0; i < 16; ++i) {
          const float nr = a1r * fr_ - a1i * fi_, ni = a1r * fi_ + a1i * fr_;
          fr_ = nr; fi_ = ni;
          xr[pb][i] += fr_;
          xi[pb][i] += fi_;
        }
      } else {
        xr[pb][15] += a16r_[pb] * c2r - a16i_[pb] * c2i;
        xi[pb][15] += a16r_[pb] * c2i + a16i_[pb] * c2r;
      }
      cr_[pb] = half_bcast(xr[pb][15], 1);
      ci_[pb] = half_bcast(xi[pb][15], 1);
      if (FULL) {
#pragma unroll
        for (int i = 0; i < 16; ++i) *(unsigned*)(xw + (16 * lh + i) * 272 + (pb * 32 + lr) * 4) = pack_bf16(xr[pb][i], xi[pb][i]);
      }
    }
    if (FULL) asm volatile("s_waitcnt lgkmcnt(0)" ::: "memory");
  }
  if (FULL) cproj(nch - 1, xs + ((nch - 1) & 1) * 8704);
}

__device__ __forceinline__ void s5_combine(const Params& p, int rowbase, int L, int g0, int ng) {
  const float* YF = (const float*)(p.ws + OFF_YF); const float* YB = (const float*)(p.ws + OFF_YB); const bf16_t* U = (const bf16_t*)(p.ws + OFF_U);
  bf16_t* YBF = (bf16_t*)(p.ws + OFF_YBF);
  const int T_ = opaque_tid(), l4 = L * 4;
#pragma unroll 1
  for (int bt = 0; bt < 2; ++bt) {
    f32x4 yf[4], yb[4], u[4], d[4]; size_t oo[4];
#pragma unroll
    for (int k = 0; k < 4; ++k) {
      const int i = T_ + 512 * (bt * 4 + k);
      const int q = i / l4, rem = i - q * l4, t = rem >> 2, c4 = (rem & 3) * 4;
      const size_t oi = (size_t)(g0 + q) * ((size_t)NTOK * 16) + (size_t)(rowbase + t) * 16 + c4;
      oo[k] = (size_t)(rowbase + t) * 512 + (g0 + q) * 16 + c4;
      yf[k] = *(const f32x4*)(YF + oi); yb[k] = *(const f32x4*)(YB + oi); { const u32x2 t = *(const u32x2*)(U + oi); u[k] = (f32x4){__uint_as_float(t[0] << 16), __uint_as_float(t[0] & 0xffff0000u), __uint_as_float(t[1] << 16), __uint_as_float(t[1] & 0xffff0000u)}; } d[k] = *(const f32x4*)(p.s5_d + (g0 + q) * 16 + c4);
    }
#pragma unroll
    for (int k = 0; k < 4; ++k) {
      float r[4];
#pragma unroll
      for (int e = 0; e < 4; ++e) r[e] = gelu_tanh(yf[k][e] + yb[k][e] + d[k][e] * u[k][e]);
      u32x2 w; w[0] = pack_bf16(r[0], r[1]); w[1] = pack_bf16(r[2], r[3]);
      *(u32x2*)(YBF + oo[k]) = w;
    }
  }
}

__device__ __forceinline__ void phase_mix0(const Params& p, char* smem, volatile LAS unsigned* st) {
  const int T_ = opaque_tid();
  const int wid = T_ >> 6, vb = T_ >> 8, vtid = T_ & 255, lane = T_ & 63, lr = lane & 31, lh = lane >> 5;
  unsigned* qctr = (unsigned*)(p.ws + OFF_BAR) + 16;
  float* ex = (float*)(smem + 8 * 17408);
  for (;;) {
    __syncthreads();
    if (T_ == 0) st[2] = __hip_atomic_fetch_add(qctr, 1u, __ATOMIC_RELAXED, __HIP_MEMORY_SCOPE_AGENT);
    __syncthreads();
    const int q_ = (int)st[2];
    if (q_ >= 768) break;
    const int item = q_ < 128 ? 384 + q_ : (q_ < 384 ? q_ : (q_ < 512 ? q_ - 384 : q_));
    if (item < 384) {
      const bool lat = item < 128;
      const int it = lat ? item : item - 128;
      const int d = lat ? (it & 1) : (wid & 1), seg = wid;
      const int b = lat ? (it >> 6) : (it >> 3);
      const int g0 = lat ? ((it >> 1) & 31) : (it & 7) * 4;
      const int g = lat ? g0 : g0 + (wid >> 1);
      const int rowbase = lat ? NP + b * LS : b * LP;
      const int trow0 = lat ? rowbase + (d ? LS - 1 - 128 * seg : 128 * seg) : rowbase + (d ? LP - 1 : 0);
      const int dstep = d ? -1 : 1, nch = lat ? 4 : 8;
      float cr_[2] = {0.f, 0.f}, ci_[2] = {0.f, 0.f};
      if (lat) {
        s5_scan<false>(p, trow0, dstep, nch, g, d, cr_, ci_, nullptr);
        if (lh == 0) {
#pragma unroll
          for (int pb = 0; pb < 2; ++pb) { ex[(seg * 2 + 0) * 64 + pb * 32 + lr] = cr_[pb]; ex[(seg * 2 + 1) * 64 + pb * 32 + lr] = ci_[pb]; }
        }
        __syncthreads();
        const float* AR = (const float*)(p.ws + OFF_AR); const float* AI = (const float*)(p.ws + OFF_AI);
        const float* s0 = p.state_s5 + (size_t)b * 8192;
#pragma unroll
        for (int pb = 0; pb < 2; ++pb) {
          const int pi = pb * 32 + lr;
          float ar = AR[(d * 32 + g) * 64 + pi], ai = AI[(d * 32 + g) * 64 + pi];
#pragma unroll
          for (int k = 0; k < 7; ++k) { const float nr = ar * ar - ai * ai, ni = 2.f * ar * ai; ar = nr; ai = ni; }
          float cr = s0[((d * 2 + 0) * 32 + g) * 64 + pi], ci = s0[((d * 2 + 1) * 32 + g) * 64 + pi];
          for (int j = 0; j < seg; ++j) {
            const float er = ex[(j * 2 + 0) * 64 + pi], ei = ex[(j * 2 + 1) * 64 + pi];
            const float nr = ar * cr - ai * ci + er, ni = ar * ci + ai * cr + ei;
            cr = nr; ci = ni;
          }
          cr_[pb] = cr; ci_[pb] = ci;
        }
      }
      s5_scan<true>(p, trow0, dstep, nch, g, d, cr_, ci_, smem + wid * 17408);
      if (!lat && lh == 0) {
        float* os = p.out + (size_t)NTOK * DM + (size_t)2 * NP * 512 + (size_t)b * 8192;
#pragma unroll
        for (int pb = 0; pb < 2; ++pb) { os[((d * 2 + 0) * 32 + g) * 64 + pb * 32 + lr] = cr_[pb]; os[((d * 2 + 1) * 32 + g) * 64 + pb * 32 + lr] = ci_[pb]; }
      }
      __syncthreads();
      if (!lat) s5_combine(p, rowbase, LP, g0, 4);
      else {
        asm volatile("s_waitcnt vmcnt(0)" ::: "memory");
        __syncthreads();
        if (T_ == 0) {
          __builtin_amdgcn_fence(__ATOMIC_RELEASE, "agent");
          asm volatile("s_waitcnt vmcnt(0)" ::: "memory");
          const unsigned old = __hip_atomic_fetch_add((unsigned*)(p.ws + OFF_BAR) + 32 + b * 32 + g0, 1u, __ATOMIC_RELAXED, __HIP_MEMORY_SCOPE_AGENT);
          __builtin_amdgcn_fence(__ATOMIC_ACQUIRE, "agent");
          asm volatile("s_waitcnt vmcnt(0)" ::: "memory");
          st[3] = old;
        }
        __syncthreads();
        if (st[3] == 1u) s5_combine(p, rowbase, LS, g0, 1);
      }
    } else {
      int vt = vtid; asm volatile("" : "+v"(vt));
      if (item < 512) {
        attn_item(p, item - 384, smem + vb * 34816, vt, vb ? 5 : 0, vb ? 9 : 5, 5, vb ? 1 : 2, smem + 34816);
      } else {
        attn_item(p, 128 + (item - 512) * 2 + vb, smem + vb * 34816, vt, 0, 2, 2, 0, nullptr);
      }
    }
  }
}

constexpr int LDS_GEMM = 131072;
constexpr int LDS_BYTES = 147456;

#define WSP ({ const unsigned long long _w = (unsigned long long)p.ws; unsigned _lo = __builtin_amdgcn_readfirstlane((unsigned)_w), _hi = __builtin_amdgcn_readfirstlane((unsigned)(_w >> 32)); asm volatile("" : "+s"(_lo), "+s"(_hi)); (char*)(((unsigned long long)_hi << 32) | _lo); })
#define MOD ((float*)(WSP + OFF_MOD))
#define SUMSQ ((float*)(WSP + OFF_SUMSQ))
#define GS ((const float*)(WSP + OFF_GS))
#define SHWGU ((const float*)(WSP + OFF_SHWGU))
#define SHWINO ((const float*)(WSP + OFF_SHWINO))
#define ABUF ((bf16_t*)(WSP + OFF_ABUF))
#define CAT ((bf16_t*)(WSP + OFF_CAT))
#define X ((bf16_t*)(WSP + OFF_X))
#define HFF ((bf16_t*)(WSP + OFF_HFF))
__global__ void __launch_bounds__(512, 2) mega(Params p) {
  extern __shared__ __attribute__((aligned(16))) unsigned char lds_raw[];
  LAS unsigned char* lds = (LAS unsigned char*)lds_raw;
  char* smem = (char*)lds_raw;
  volatile LAS unsigned* st = (volatile LAS unsigned*)(lds + LDS_BYTES - 256);
  if (threadIdx.x < 4) st[threadIdx.x] = 0u;
  __syncthreads();
  XcdBarrier bar = xcd_barrier_post((unsigned*)(WSP + OFF_BAR), st);
  SchedFlat sf;

  phase_prep(p, smem);
  xcd_barrier(bar);
  phase_norm(p, true, p.norm_mix_g, MOD + 0 * 3 * 6144 + 0 * 1024);
  xcd_barrier(bar);
  {
    EpiInEven ep{(bf16_t*)(WSP + OFF_QB), (bf16_t*)(WSP + OFF_KB), (bf16_t*)(WSP + OFF_VB), (float*)(WSP + OFF_U),
                 p.out + (size_t)NTOK * DM, p.out + (size_t)NTOK * DM + (size_t)NP * 512};
    sf.init(ABUF, DM, (const bf16_t*)(WSP + OFF_WT_IN), DM, NTOK, 2048, 0);
    gemm8(lds, DM, DM, DM, sf, ep);
  }
  phase_prep_late(p, smem, 0, 64);
  phase_prep_mod1(p, smem, 64);
  xcd_barrier(bar);
  phase_mix0(p, smem, st);
  xcd_barrier(bar);
  {
    const bf16_t* YBF = (const bf16_t*)(WSP + OFF_YBF);
    sf.init(YBF, 512, (const bf16_t*)(WSP + OFF_WT_GLU), 512, NTOK, 512, 0);
    gemm8<true>(lds, 512, 512, 512, SchedFlatTail{sf, 0}, EpiGlu<true>{YBF, p.glu_b, CAT});
  }
  phase_norm_consts(p, 0, 160);
  xcd_barrier(bar);
  sf.init(CAT, DM, (const bf16_t*)(WSP + OFF_WT_OUT), DM, NTOK, DM, 0);
  gemm8(lds, DM, DM, DM, sf, EpiResid<true>{p.x_prompt, p.x_sample, nullptr, X, MOD + 2 * 1024, ABUF, GS, SUMSQ});
  phase_prep_dft(p, 160);
  phase_norm_consts(p, 1, 160);
  xcd_barrier(bar);
  sf.init(ABUF, DM, (const bf16_t*)(WSP + OFF_WT_GU), DM, NTOK, 5632, 0);
  sf.limit = 768;
  gemm8(lds, DM, DM, DM, sf, EpiSwiGLU<false>{HFF, SUMSQ, SHWGU});
  sf.limit = sf.nwg;
  gemm8<true>(lds, DM, DM, DM, SchedFlatTail{sf, 768}, EpiSwiGLU<true>{HFF, SUMSQ, SHWGU});
  xcd_barrier(bar);
  sf.init(HFF, DFF, (const bf16_t*)(WSP + OFF_WT_DN), DFF, NTOK, DM, 0);
  gemm8(lds, DFF, DFF, DFF, sf, EpiResid<false>{p.x_prompt, p.x_sample, X, X, MOD + 5 * 1024, ABUF, GS + 3072, SUMSQ + NTOK});
  phase_prep_late(p, smem, 1, 160);
  xcd_barrier(bar);
  sf.init(ABUF, DM, (const bf16_t*)(WSP + OFF_WT_INO), DM, NTOK, DM, DM);
  gemm8(lds, DM, DM, DM, sf, EpiBf16Norm{(bf16_t*)(WSP + OFF_Z), SUMSQ + NTOK, SHWINO});
  phase_norm_consts(p, 2, 160);
  {
    Unit u0; const bool have = sf.next(0, u0);
    asm volatile("s_waitcnt vmcnt(0)" ::: "memory");
    __syncthreads();
    gemm8(lds, 256, 256, DM, SchedF1Own{(const char*)(WSP + OFF_CS2), (const char*)(WSP + OFF_Z), have ? u0.pm : 0, have ? u0.pn : 0, have}, EpiBf16{(bf16_t*)(WSP + OFF_OT)});
  }
  xcd_barrier(bar);
  gemm8(lds, 512, 512, 512, SchedF2P{(const char*)(WSP + OFF_CL2P), (const char*)(WSP + OFF_OT), (int)blockIdx.x}, EpiBf16{CAT});
  gemm8<true>(lds, 2048, 2048, 2048, SchedF2S{(const char*)(WSP + OFF_CL2S), (const char*)(WSP + OFF_OT), (int)blockIdx.x}, EpiBf16Half{CAT});
  xcd_barrier(bar);
  sf.init(CAT, DM, (const bf16_t*)(WSP + OFF_WT_OUTO), DM, NTOK, DM, 0);
  gemm8(lds, DM, DM, DM, sf, EpiResid<false>{p.x_prompt, p.x_sample, X, X, MOD + 3 * 6144 + 2 * 1024, ABUF, GS + 2 * 3072, SUMSQ + 2 * NTOK});
  xcd_barrier(bar);
  sf.init(ABUF, DM, (const bf16_t*)(WSP + OFF_WT_GU) + (size_t)5632 * 1024, DM, NTOK, 5632, 0);
  sf.limit = 768;
  gemm8(lds, DM, DM, DM, sf, EpiSwiGLU<false>{HFF, SUMSQ + 2 * NTOK, SHWGU + 3 * 5632});
  sf.limit = sf.nwg;
  gemm8<true>(lds, DM, DM, DM, SchedFlatTail{sf, 768}, EpiSwiGLU<true>{HFF, SUMSQ + 2 * NTOK, SHWGU + 3 * 5632});
  xcd_barrier(bar);
  sf.init(HFF, DFF, (const bf16_t*)(WSP + OFF_WT_DN) + (size_t)1024 * DFF, DFF, NTOK, DM, 0);
  gemm8(lds, DFF, DFF, DFF, sf, EpiFinal{X, MOD + 3 * 6144 + 5 * 1024, p.final_g, p.out, SUMSQ + 3 * NTOK, (unsigned*)(WSP + OFF_PCNT)});
}

extern "C" void kernel_launch(void* const* d_in, const int* in_sizes, int n_in, void* d_out, int out_size, void* d_ws, size_t ws_size, hipStream_t stream) {
  static int grid_blocks = 0;
  if (!grid_blocks) {
    int dev = 0, cus = 0, per_cu = 0;
    (void)hipGetDevice(&dev);
    (void)hipDeviceGetAttribute(&cus, hipDeviceAttributeMultiprocessorCount, dev);
    if (hipFuncSetAttribute((const void*)mega, hipFuncAttributeMaxDynamicSharedMemorySize, LDS_BYTES) != hipSuccess) fprintf(stderr, "hipFuncSetAttribute failed\n");
    (void)hipOccupancyMaxActiveBlocksPerMultiprocessor(&per_cu, mega, 512, LDS_BYTES);
    if (per_cu < 1) fprintf(stderr, "occupancy query reports %d blocks per CU\n", per_cu);
    (void)hipGetLastError();
    grid_blocks = cus;
  }
  if (ws_size < WS_NEED) { fprintf(stderr, "workspace too small: %zu < %zu\n", ws_size, (size_t)WS_NEED); return; }
  Params p{};
  const float** pp = (const float**)&p;
  for (int i = 0; i < 30; ++i) pp[i] = (const float*)d_in[i];
  p.out = (float*)d_out;
  p.ws = (char*)d_ws;
  (void)hipMemsetAsync((char*)d_ws + OFF_BAR, 0, ZERO_BYTES, stream);
  void* args[] = {&p};
  hipError_t e = hipLaunchCooperativeKernel((void*)mega, dim3(grid_blocks), dim3(512), args, LDS_BYTES, stream);
  if (e != hipSuccess) fprintf(stderr, "cooperative launch failed: %s (grid %d)\n", hipGetErrorString(e), grid_blocks);
}
```

```cpp
#include <hip/hip_runtime.h>
#include <cstdio>

typedef unsigned short bf16_t;
typedef short bf16x8 __attribute__((ext_vector_type(8)));
typedef float f32x4 __attribute__((ext_vector_type(4)));
typedef float f32x16 __attribute__((ext_vector_type(16)));
typedef unsigned u32x4 __attribute__((ext_vector_type(4)));
typedef unsigned u32x2 __attribute__((ext_vector_type(2)));

#ifndef N_LAUNCH_MODE
#define N_LAUNCH_MODE 1
#endif

constexpr int DM = 1024, NP = 8192, NL = 2048, NTOK = NP + NL, LP = 256, LS = 1024;
constexpr int DFF = 2816, NAW = 512, S5W = 512;
constexpr int NPHASE = 18;

constexpr size_t al256(size_t x) { return (x + 255) & ~(size_t)255; }
constexpr size_t OFF_MOD = 0;
constexpr size_t OFF_AR = al256(OFF_MOD + 2 * 3 * 6144 * 4);
constexpr size_t OFF_AI = al256(OFF_AR + 4096 * 4);
constexpr size_t OFF_BBAR = al256(OFF_AI + 4096 * 4);
constexpr size_t OFF_WT_IN = al256(OFF_BBAR + 131072 * 4);
constexpr size_t OFF_WT_GLU = al256(OFF_WT_IN + 2048 * 1024 * 2);
constexpr size_t OFF_WT_OUT = al256(OFF_WT_GLU + 512 * 512 * 2);
constexpr size_t OFF_WT_INO = al256(OFF_WT_OUT + 1024 * 1024 * 2);
constexpr size_t OFF_WT_OUTO = al256(OFF_WT_INO + 1024 * 1024 * 2);
constexpr size_t OFF_WT_GU = al256(OFF_WT_OUTO + 1024 * 1024 * 2);
constexpr size_t OFF_WT_DN = al256(OFF_WT_GU + (size_t)2 * 5632 * 1024 * 2);
constexpr size_t OFF_CS2 = al256(OFF_WT_DN + (size_t)2 * 1024 * 2816 * 2);
constexpr size_t OFF_CL2P = al256(OFF_CS2 + 512 * 256 * 2);
constexpr size_t OFF_CL2S = al256(OFF_CL2P + 256 * 512 * 2);
constexpr size_t OFF_ABUF = al256(OFF_CL2S + 1024 * 2048 * 2);
constexpr size_t OFF_CAT = al256(OFF_ABUF + (size_t)NTOK * 1024 * 2);
constexpr size_t OFF_X = al256(OFF_CAT + (size_t)NTOK * 1024 * 2);
constexpr size_t OFF_POOL = al256(OFF_X + (size_t)NTOK * 1024 * 4);
constexpr size_t OFF_QB = OFF_POOL;
constexpr size_t OFF_KB = OFF_QB + (size_t)NTOK * 512 * 2;
constexpr size_t OFF_VB = OFF_KB + (size_t)NTOK * 512 * 2;
constexpr size_t OFF_U = OFF_VB + (size_t)NTOK * 512 * 2;
constexpr size_t OFF_YF = OFF_U + (size_t)NTOK * 512 * 4;
constexpr size_t OFF_YB = OFF_YF + (size_t)NTOK * 512 * 4;
constexpr size_t POOL_END0 = OFF_YB + (size_t)NTOK * 512 * 4;
constexpr size_t OFF_HFF = OFF_POOL;
constexpr size_t OFF_Z = OFF_POOL;
constexpr size_t OFF_OT = OFF_Z + (size_t)NTOK * 1024 * 2;
constexpr size_t OFF_YBF = POOL_END0;
constexpr size_t OFF_BAR = al256(OFF_YBF + (size_t)NTOK * 512 * 2);
constexpr size_t OFF_SUMSQ = OFF_BAR + 16384;
constexpr size_t OFF_PCNT = OFF_SUMSQ + (size_t)4 * NTOK * 4;
constexpr size_t ZERO_BYTES = 16384 + (size_t)4 * NTOK * 4 + 40 * 256;
constexpr size_t OFF_GS = al256(OFF_PCNT + 40 * 256);
constexpr size_t OFF_SHWGU = al256(OFF_GS + 3 * 3 * 1024 * 4);
constexpr size_t OFF_SHWINO = al256(OFF_SHWGU + 2 * 3 * 5632 * 4);
constexpr size_t WS_NEED = al256(OFF_SHWINO + 3 * 1024 * 4);
static_assert(WS_NEED <= (size_t)256 * 1024 * 1024, "workspace");

struct Params {
  const float *x_prompt, *x_sample, *cache_k, *cache_v, *state_s5, *c, *c_ctx, *w_mod, *b_mod, *norm_mix_g, *norm_ffn_g,
      *w_in_even, *na_rpb, *lam_re, *lam_im, *log_step, *b_re, *b_im, *c_re, *c_im, *s5_d, *glu_w, *glu_b, *w_out_even,
      *w_in_odd, *w_out_odd, *w_gate, *w_up, *w_down, *final_g;
  float* out;
  char* ws;
};

typedef __bf16 bf16v2_t __attribute__((ext_vector_type(2)));
__device__ __forceinline__ unsigned pack_bf16(float lo, float hi) {
  bf16v2_t v = {(__bf16)lo, (__bf16)hi};
  return __builtin_bit_cast(unsigned, v);
}
__device__ __forceinline__ float bf2f(unsigned short h) { return __uint_as_float(((unsigned)h) << 16); }
__device__ __forceinline__ u32x4 pack8(f32x4 a, f32x4 b) {
  u32x4 r;
  r[0] = pack_bf16(a[0], a[1]); r[1] = pack_bf16(a[2], a[3]); r[2] = pack_bf16(b[0], b[1]); r[3] = pack_bf16(b[2], b[3]);
  return r;
}
__device__ __forceinline__ bf16x8 as_bf16x8(u32x4 v) { return __builtin_bit_cast(bf16x8, v); }
__device__ __forceinline__ float sigmoidf_(float x) { return 1.0f / (1.0f + __expf(-x)); }
__device__ __forceinline__ float siluf_(float x) { return x * sigmoidf_(x); }
__device__ __forceinline__ float gelu_tanh(float x) {
  const float u = 0.7978845608028654f * (x + 0.044715f * x * x * x);
  const float t = 1.0f - 2.0f / (1.0f + __expf(2.0f * u));
  return 0.5f * x * (1.0f + t);
}
__device__ __forceinline__ float half_bcast(float x, int which) {
  auto r = __builtin_amdgcn_permlane32_swap(__float_as_uint(x), __float_as_uint(x), false, false);
  return __uint_as_float(which ? r[1] : r[0]);
}
__device__ __forceinline__ float xor32(float x) {
  auto r = __builtin_amdgcn_permlane32_swap(__float_as_uint(x), __float_as_uint(x), false, false);
  return (threadIdx.x & 32) ? __uint_as_float(r[0]) : __uint_as_float(r[1]);
}
__device__ __forceinline__ int opaque_tid() { int t = threadIdx.x; asm volatile("" : "+v"(t)); return t; }
__device__ __forceinline__ int cond_index(int row) { return row < NP ? 0 : 1 + ((row - NP) >> 10); }
__device__ __forceinline__ const float* xin_row(const Params& p, int row) {
  return row < NP ? p.x_prompt + (size_t)row * DM : p.x_sample + (size_t)(row - NP) * DM;
}

#define LAS __attribute__((address_space(3)))
#define XB_TMO      128
#define XB_XCNT(j)  (256  + 64 * (j))
#define XB_XSUB(j)  (1280 + 64 * (j))
#define XB_XGEN(j)  (2304 + 64 * (j))
#define XB_TOP      3328
#define XB_TOPGEN   3392
#define XCD_BAR_WORDS 3456
#define XB_SPIN_CAP (1u << 22)
__device__ __forceinline__ unsigned xb_ld(unsigned* p)              { return __hip_atomic_load(p, __ATOMIC_RELAXED, __HIP_MEMORY_SCOPE_AGENT); }
__device__ __forceinline__ unsigned xb_add(unsigned* p, unsigned v) { return __hip_atomic_fetch_add(p, v, __ATOMIC_RELAXED, __HIP_MEMORY_SCOPE_AGENT); }
__device__ __forceinline__ unsigned xb_xcc_id() { return (unsigned)__builtin_amdgcn_s_getreg((3 << 11) | 20) & 0xFu; }
#define XB_SPIN(cond, bar) do { unsigned _sp = 0; while (cond) { __builtin_amdgcn_s_sleep(1); \
    if ((++_sp & 255u) == 0u) { if (xb_ld(&(bar)[XB_TMO])) break; if (_sp > XB_SPIN_CAP) { atomicAdd(&(bar)[XB_TMO], 1u); break; } } } } while (0)
struct XcdBarrier { unsigned* bar; unsigned x; volatile LAS unsigned* st; };
__device__ __forceinline__ XcdBarrier xcd_barrier_post(unsigned* bar, volatile LAS unsigned* st) {
  XcdBarrier b; b.bar = bar; b.x = xb_xcc_id(); b.st = st;
  if (threadIdx.x == 0) (void)xb_add(&bar[XB_XCNT(b.x)], 1u);
  return b;
}
__device__ __forceinline__ void xcd_barrier_complete(unsigned* bar, unsigned x, unsigned& nloc, unsigned& nx) {
  const unsigned G = gridDim.x * gridDim.y * gridDim.z;
  unsigned sum, cnt, mine, sp = 0u;
  for (;;) {
    sum = 0u; cnt = 0u; mine = 0u;
#pragma unroll
    for (unsigned j = 0; j < 16; ++j) { const unsigned c = xb_ld(&bar[XB_XCNT(j)]); sum += c; cnt += (c > 0u) ? 1u : 0u; mine = (j == x) ? c : mine; }
    if (sum == G) break;
    __builtin_amdgcn_s_sleep(1);
    if ((++sp & 255u) == 0u) { if (xb_ld(&bar[XB_TMO])) break; if (sp > XB_SPIN_CAP) { atomicAdd(&bar[XB_TMO], 1u); break; } }
  }
  nloc = mine > 0u ? mine : 1u; nx = cnt > 0u ? cnt : 1u;
}
__device__ __forceinline__ void xcd_barrier(const XcdBarrier& b) {
  asm volatile("s_waitcnt vmcnt(0)" ::: "memory");
  __syncthreads();
  if (threadIdx.x == 0) {
    unsigned* bar = b.bar;
    __builtin_amdgcn_s_waitcnt(0);
    unsigned nloc = b.st[0], nx = b.st[1];
    if (nloc == 0u) { xcd_barrier_complete(bar, b.x, nloc, nx); b.st[0] = nloc; b.st[1] = nx; }
    const unsigned old = xb_add(&bar[XB_XSUB(b.x)], 1u);
    const unsigned gen = old / nloc;
    if (old + 1u == (gen + 1u) * nloc) {
      __builtin_amdgcn_fence(__ATOMIC_RELEASE, "agent");
      asm volatile("s_waitcnt vmcnt(0)" ::: "memory");
      const unsigned og = xb_add(&bar[XB_TOP], 1u);
      const unsigned tg = og / nx;
      if (og + 1u == (tg + 1u) * nx) xb_add(&bar[XB_TOPGEN], 1u);
      else XB_SPIN(xb_ld(&bar[XB_TOPGEN]) == tg, bar);
      __builtin_amdgcn_fence(__ATOMIC_ACQUIRE, "agent");
      xb_add(&bar[XB_XGEN(b.x)], 1u);
      asm volatile("s_waitcnt vmcnt(0)" ::: "memory");
    } else {
      XB_SPIN(xb_ld(&bar[XB_XGEN(b.x)]) == gen, bar);
      __builtin_amdgcn_fence(__ATOMIC_ACQUIRE, "agent");
      asm volatile("s_waitcnt vmcnt(0)" ::: "memory");
    }
  }
  __syncthreads();
}

constexpr int G8_HTB = 128 * 64 * 2;
__device__ __forceinline__ int lds_byte(int r, int c) { const int st = (r >> 4) * 2 + (c >> 5), rr = r & 15, cc = c & 31, ob = rr * 64 + cc * 2; return st * 1024 + (ob ^ (((ob >> 9) & 1) << 5)); }
__device__ __forceinline__ void stage_rc(int b, int& R, int& C) { const int st = b / 1024, sb = b % 1024, swz = sb ^ (((sb >> 9) & 1) << 5); R = (st >> 1) * 16 + swz / 64; C = (st & 1) * 32 + (swz % 64) / 2; }
struct Unit { const char* a; const char* b; size_t cbase; int ldc; int pm, pn; int row0; };

template <bool HALF_M = false, class Epi, class Sched>
__device__ __forceinline__ void gemm8(LAS unsigned char* lds, int K, int lda, int ldb, const Sched& S, const Epi& E) {
  const int tid = opaque_tid(), wid = __builtin_amdgcn_readfirstlane(tid >> 6), lane = tid & 63, wr = wid >> 2, wc = wid & 3, fr = lane & 15, fq = lane >> 4;
  const int nt = K / 64;
  unsigned voffA[2], voffB[2];
#pragma unroll
  for (int i = 0; i < 2; ++i) { int R, C; stage_rc(tid * 16 + i * 8192, R, C);
    const int rho = R & 31, Rb = Epi::PERM ? ((R & ~31) + 8 * ((rho & 15) >> 2) + 4 * (rho >> 4) + (rho & 3)) : R;
    voffA[i] = (unsigned)(R * lda + C) * 2u; voffB[i] = (unsigned)(Rb * ldb + C) * 2u; }
  const size_t kstep = 128;
  const size_t hstepA = (size_t)128 * lda * 2, hstepB = (size_t)128 * ldb * 2;
  const unsigned ldsw = (unsigned)wid * 1024u;
  const int aoff = lds_byte(wr * 64 + fr, fq * 8), boff = lds_byte(wc * 32 + fr, fq * 8);
#define G8_SA(b, h) (((b) * 2 + (h)) * G8_HTB)
#define G8_SB(b, h) ((4 + (b) * 2 + (h)) * G8_HTB)
#define G8_STAGE(bufoff, gbase, voff) do { _Pragma("unroll") for (int _i = 0; _i < 2; ++_i) \
    __builtin_amdgcn_global_load_lds((const unsigned*)((const char*)(gbase) + (voff)[_i]), (LAS unsigned*)(lds + (bufoff) + ldsw + _i * 8192), 16, 0, 0); } while (0)
#define G8_LDA(dst, b, h) do { _Pragma("unroll") for (int m = 0; m < 4; ++m) _Pragma("unroll") for (int k = 0; k < 2; ++k) dst[m][k] = *(const LAS bf16x8*)(lds + G8_SA(b, h) + aoff + m * 2048 + k * 1024); } while (0)
#define G8_LDB(dst, b, h) do { _Pragma("unroll") for (int n = 0; n < 2; ++n) _Pragma("unroll") for (int k = 0; k < 2; ++k) dst[n][k] = *(const LAS bf16x8*)(lds + G8_SB(b, h) + boff + n * 2048 + k * 1024); } while (0)
#define G8_MMA(ai, bj, At, Bt) do { __builtin_amdgcn_s_setprio(1); _Pragma("unroll") for (int m = 0; m < 4; ++m) _Pragma("unroll") for (int n = 0; n < 2; ++n) _Pragma("unroll") for (int k = 0; k < 2; ++k) \
    acc[ai][bj][m][n] = __builtin_amdgcn_mfma_f32_16x16x32_bf16(Bt[n][k], At[m][k], acc[ai][bj][m][n], 0, 0, 0); __builtin_amdgcn_s_setprio(0); } while (0)
#define G8_WAIT_V(n) asm volatile("s_waitcnt vmcnt(" #n ")" ::: "memory")
#define G8_WAIT_L(n) asm volatile("s_waitcnt lgkmcnt(" #n ")" ::: "memory")
#define G8_BAR __builtin_amdgcn_s_barrier()
#define G8_SCHED __builtin_amdgcn_sched_barrier(0)
  Unit cur, nxt; int ui = 0;
  if (!S.next(0, cur)) return;
  f32x4 acc[2][2][4][2];
#pragma unroll
  for (int a = 0; a < 2; ++a)
#pragma unroll
    for (int b = 0; b < 2; ++b)
#pragma unroll
      for (int m = 0; m < 4; ++m)
#pragma unroll
        for (int n = 0; n < 2; ++n) acc[a][b][m][n] = (f32x4){0.f, 0.f, 0.f, 0.f};
  bf16x8 At[4][2], B0[2][2], B1[2][2];
  const char* cA = cur.a; const char* cB = cur.b;
  G8_STAGE(G8_SB(0, 0), cB, voffB); G8_STAGE(G8_SA(0, 0), cA, voffA); G8_STAGE(G8_SB(0, 1), cB + hstepB, voffB); G8_STAGE(G8_SA(0, 1), cA + hstepA, voffA);
  if (wr == 1) G8_BAR;
  G8_WAIT_V(4); G8_BAR;
  G8_STAGE(G8_SB(1, 0), cB + kstep, voffB); G8_STAGE(G8_SA(1, 0), cA + kstep, voffA); G8_STAGE(G8_SB(1, 1), cB + hstepB + kstep, voffB);
  G8_WAIT_V(6); G8_BAR;
  for (;;) {
    const bool has_next = S.next(ui + 1, nxt);
    const char* nA = has_next ? nxt.a : cA; const char* nB = has_next ? nxt.b : cB;
    for (int t = 0; t < nt; t += 2) {
      const bool last = (t == nt - 2);
      const char* a1 = cA + (size_t)(t + 1) * kstep;
      const char* a2 = last ? nA : cA + (size_t)(t + 2) * kstep; const char* b2 = last ? nB : cB + (size_t)(t + 2) * kstep;
      const char* a3 = a2 + kstep; const char* b3 = b2 + kstep;
      G8_LDB(B0, 0, 0); G8_SCHED; G8_LDA(At, 0, 0); G8_STAGE(G8_SA(1, 1), a1 + hstepA, voffA);
      G8_WAIT_L(8); G8_BAR; G8_WAIT_L(0); G8_MMA(0, 0, At, B0); G8_BAR; G8_SCHED;
      G8_LDB(B1, 0, 1); G8_STAGE(G8_SB(0, 0), b2, voffB);
      G8_BAR; G8_WAIT_L(0); G8_MMA(0, 1, At, B1); G8_BAR;
      if constexpr (!HALF_M) { G8_LDA(At, 0, 1); } G8_STAGE(G8_SA(0, 0), a2, voffA);
      G8_BAR; G8_WAIT_L(0); if constexpr (!HALF_M) { G8_MMA(1, 0, At, B0); } G8_BAR; G8_SCHED;
      G8_STAGE(G8_SB(0, 1), b2 + hstepB, voffB);
      G8_WAIT_V(6); G8_BAR; if constexpr (!HALF_M) { G8_MMA(1, 1, At, B1); } G8_BAR;
      G8_LDB(B0, 1, 0); G8_SCHED; G8_LDA(At, 1, 0); G8_STAGE(G8_SA(0, 1), a2 + hstepA, voffA);
      G8_WAIT_L(8); G8_BAR; G8_WAIT_L(0); G8_MMA(0, 0, At, B0); G8_BAR; G8_SCHED;
      G8_LDB(B1, 1, 1); G8_STAGE(G8_SB(1, 0), b3, voffB);
      G8_BAR; G8_WAIT_L(0); G8_MMA(0, 1, At, B1); G8_BAR;
      if constexpr (!HALF_M) { G8_LDA(At, 1, 1); } G8_STAGE(G8_SA(1, 0), a3, voffA);
      G8_BAR; G8_WAIT_L(0); if constexpr (!HALF_M) { G8_MMA(1, 0, At, B0); } G8_BAR; G8_SCHED;
      G8_STAGE(G8_SB(1, 1), b3 + hstepB, voffB);
      G8_WAIT_V(6); G8_BAR; if constexpr (!HALF_M) { G8_MMA(1, 1, At, B1); } G8_BAR;
    }
    if constexpr (!Epi::AFTER_DRAIN) E(acc, cur, wr, wc, fr, fq);
    if (!has_next) break;
#pragma unroll
    for (int a = 0; a < 2; ++a)
#pragma unroll
      for (int b = 0; b < 2; ++b)
#pragma unroll
        for (int m = 0; m < 4; ++m)
#pragma unroll
          for (int n = 0; n < 2; ++n) acc[a][b][m][n] = (f32x4){0.f, 0.f, 0.f, 0.f};
    cur = nxt; cA = nA; cB = nB; ++ui;
  }
  G8_WAIT_V(0);
  if (wr == 0) G8_BAR;
  G8_BAR;
  if constexpr (Epi::AFTER_DRAIN) E(acc, cur, wr, wc, fr, fq);
#undef G8_SA
#undef G8_SB
#undef G8_STAGE
#undef G8_LDA
#undef G8_LDB
#undef G8_MMA
#undef G8_WAIT_V
#undef G8_WAIT_L
#undef G8_BAR
#undef G8_SCHED
}

struct SchedFlat {
  const char *A, *B; size_t atstep, btstep; int ldc; int nM, nN, nwg, G, c, limit;
  __device__ __forceinline__ void init(const bf16_t* A_, int lda, const bf16_t* B_, int ldb, int M, int N, int ldc_) {
    A = (const char*)A_; B = (const char*)B_; atstep = (size_t)256 * lda * 2; btstep = (size_t)256 * ldb * 2; ldc = ldc_;
    nM = M / 256; nN = N / 256; nwg = nM * nN; G = gridDim.x; c = blockIdx.x; limit = nwg;
  }
  __device__ __forceinline__ void unit_at(int L, Unit& u) const {
    int wgid = L; { const int q = nwg / 8, r = nwg % 8, xcd = wgid % 8, off = wgid / 8; wgid = (xcd < r ? xcd * (q + 1) : r * (q + 1) + (xcd - r) * q) + off; }
    const int nig = 8 * nN, gid = wgid / nig, fm = gid * 8, gsz = (nM - fm) < 8 ? (nM - fm) : 8;
    u.pm = fm + ((wgid % nig) % gsz); u.pn = (wgid % nig) / gsz;
    u.a = A + (size_t)u.pm * atstep; u.b = B + (size_t)u.pn * btstep; u.ldc = ldc; u.cbase = (size_t)u.pm * 256 * ldc + (size_t)u.pn * 256; u.row0 = u.pm * 256;
  }
  __device__ __forceinline__ bool next(int i, Unit& u) const {
    const long L = (long)i * G + c; if (L >= limit) return false;
    unit_at((int)L, u);
    return true;
  }
};
struct SchedFlatTail {
  SchedFlat f; int first;
  __device__ __forceinline__ bool next(int i, Unit& u) const {
    const int Lh = i * f.G + f.c; if (Lh >= 2 * (f.nwg - first)) return false;
    f.unit_at(first + (Lh >> 1), u);
    if (Lh & 1) { u.a += f.atstep / 2; u.row0 += 128; u.cbase += (size_t)128 * f.ldc; }
    return true;
  }
};
struct SchedF1 {
  const char *CS2, *Z; int G, c;
  __device__ __forceinline__ bool next(int i, Unit& u) const {
    const int L = i * G + c; if (L >= 320) return false;
    int bg, pm, pn, Lseq, rowb; size_t obase;
    if (L < 256) { bg = L >> 1; pm = L & 1; pn = 0; Lseq = LP; rowb = (bg >> 2) * LP; obase = (size_t)bg * 512 * LP; }
    else { const int t = L - 256; bg = t >> 3; pm = (t >> 2) & 1; pn = t & 3; Lseq = LS; rowb = NP + (bg >> 2) * LS; obase = (size_t)128 * 512 * LP + (size_t)bg * 512 * LS; }
    u.pm = pm; u.pn = pn; u.ldc = Lseq;
    u.a = CS2 + (size_t)pm * 256 * 256 * 2;
    u.b = Z + ((size_t)(rowb + pn * 256) * DM + (bg & 3) * 256) * 2;
    u.cbase = obase + (size_t)pm * 256 * Lseq + (size_t)pn * 256;
    return true;
  }
};
struct SchedF1Own {
  const char *CS2, *Z; int pm_tok, g; bool have;
  __device__ __forceinline__ bool next(int i, Unit& u) const {
    if (!have || i > 1) return false;
    int bg, pn, Lseq, rowb; size_t obase;
    if (pm_tok < NP / 256) { const int b = pm_tok; bg = b * 4 + g; pn = 0; Lseq = LP; rowb = b * LP; obase = (size_t)bg * 512 * LP; }
    else { const int t = pm_tok - NP / 256, b = t >> 2; pn = t & 3; bg = b * 4 + g; Lseq = LS; rowb = NP + b * LS; obase = (size_t)128 * 512 * LP + (size_t)bg * 512 * LS; }
    u.pm = i; u.pn = pn; u.ldc = Lseq; u.row0 = 0;
    u.a = CS2 + (size_t)i * 256 * 256 * 2;
    u.b = Z + ((size_t)(rowb + pn * 256) * DM + g * 256) * 2;
    u.cbase = obase + (size_t)i * 256 * Lseq + (size_t)pn * 256;
    return true;
  }
};
struct SchedF2P {
  const char *CL, *OT; int c;
  __device__ __forceinline__ bool next(int i, Unit& u) const {
    if (i > 0 || c >= 128) return false;
    const int b = c >> 2, pn = c & 3;
    u.pm = 0; u.pn = pn; u.ldc = DM;
    u.a = CL; u.b = OT + ((size_t)b * 4 * 512 * LP + (size_t)pn * 256 * 512) * 2;
    u.cbase = (size_t)(b * LP) * DM + (size_t)pn * 256;
    return true;
  }
};
struct SchedF2S {
  const char *CL, *OT; int c;
  __device__ __forceinline__ bool next(int i, Unit& u) const {
    const int t = c - 128;
    if (i > 0 || t < 0 || t >= 64) return false;
    const int b = t >> 5, ph = (t >> 2) & 7, pn = t & 3;
    u.pm = ph; u.pn = pn; u.ldc = DM;
    u.a = CL + (size_t)ph * 128 * 2048 * 2;
    u.b = OT + ((size_t)128 * 512 * LP + (size_t)b * 4 * 512 * LS + (size_t)pn * 256 * 2048) * 2;
    u.cbase = (size_t)(NP + b * LS + ph * 128) * DM + (size_t)pn * 256;
    return true;
  }
};

template <class F>
__device__ __forceinline__ void epi_foreach(const f32x4 (&acc)[2][2][4][2], int wr, int wc, int fr, int fq, const F& f) {
#pragma unroll
  for (int ai = 0; ai < 2; ++ai)
#pragma unroll
    for (int m = 0; m < 4; ++m)
#pragma unroll
      for (int bj = 0; bj < 2; ++bj)
#pragma unroll
        for (int n = 0; n < 2; ++n) f(128 * ai + 64 * wr + 16 * m + fr, 128 * bj + 32 * wc + 16 * n + 4 * fq, acc[ai][bj][m][n]);
}
struct EpiBf16 {
  static constexpr bool AFTER_DRAIN = false, PERM = true;
  bf16_t* C;
  __device__ __forceinline__ void operator()(const f32x4 (&acc)[2][2][4][2], const Unit& u, int wr, int wc, int fr, int fq) const {
    bf16_t* base = C + u.cbase; const int ldc = u.ldc;
#pragma unroll
    for (int ai = 0; ai < 2; ++ai)
#pragma unroll
      for (int m = 0; m < 4; ++m)
#pragma unroll
        for (int bj = 0; bj < 2; ++bj) {
          const f32x4 v0 = acc[ai][bj][m][0], v1 = acc[ai][bj][m][1];
          u32x4 o; o[0] = pack_bf16(v0[0], v0[1]); o[1] = pack_bf16(v0[2], v0[3]); o[2] = pack_bf16(v1[0], v1[1]); o[3] = pack_bf16(v1[2], v1[3]);
          *(u32x4*)(base + (size_t)(128 * ai + 64 * wr + 16 * m + fr) * ldc + 128 * bj + 32 * wc + 8 * fq) = o;
        }
  }
};
struct EpiBf16Half {
  static constexpr bool AFTER_DRAIN = false, PERM = false;
  bf16_t* C;
  __device__ __forceinline__ void operator()(const f32x4 (&acc)[2][2][4][2], const Unit& u, int wr, int wc, int fr, int fq) const {
    bf16_t* base = C + u.cbase; const int ldc = u.ldc;
#pragma unroll
    for (int m = 0; m < 4; ++m)
#pragma unroll
      for (int bj = 0; bj < 2; ++bj)
#pragma unroll
        for (int n = 0; n < 2; ++n) {
          const f32x4 v = acc[0][bj][m][n];
          u32x2 o; o[0] = pack_bf16(v[0], v[1]); o[1] = pack_bf16(v[2], v[3]);
          *(u32x2*)(base + (size_t)(64 * wr + 16 * m + fr) * ldc + 128 * bj + 32 * wc + 16 * n + 4 * fq) = o;
        }
  }
};
struct EpiInEven {
  static constexpr bool AFTER_DRAIN = false, PERM = false;
  bf16_t *Q, *Kb, *Vb; float *U, *outk, *outv;
  __device__ __forceinline__ void operator()(const f32x4 (&acc)[2][2][4][2], const Unit& u, int wr, int wc, int fr, int fq) const {
    const int region = u.pn >> 1, cb = (u.pn & 1) * 256, rb = u.pm * 256;
    epi_foreach(acc, wr, wc, fr, fq, [&](int r, int c, f32x4 v) {
      const int row = rb + r, col = cb + c;
      if (region == 3) {
        { u32x2 uw; uw[0] = pack_bf16(v[0], v[1]); uw[1] = pack_bf16(v[2], v[3]); *(u32x2*)((bf16_t*)U + (size_t)(col >> 4) * ((size_t)NTOK * 16) + (size_t)row * 16 + (col & 15)) = uw; }
      } else {
        u32x2 o; o[0] = pack_bf16(v[0], v[1]); o[1] = pack_bf16(v[2], v[3]);
        bf16_t* dst = region == 0 ? Q : (region == 1 ? Kb : Vb);
        *(u32x2*)(dst + (size_t)row * 512 + col) = o;
        if (region != 0 && row < NP) {
          float* od = region == 1 ? outk : outv;
          *(f32x4*)(od + (size_t)row * 512 + col) = v;
        }
      }
    });
  }
};
template <bool FROM_INPUT>
struct EpiResid {
  static constexpr bool AFTER_DRAIN = false, PERM = true;
  const float *xp, *xs; const bf16_t* Xin; bf16_t* Xout; const float* gate;
  bf16_t* AB; const float* gs; float* sumsq;
  __device__ __forceinline__ void operator()(const f32x4 (&acc)[2][2][4][2], const Unit& u, int wr, int wc, int fr, int fq) const {
    const int rb = u.pm * 256, cb = u.pn * 256;
    const int ci = cond_index(rb);
    const int c0 = cb + 32 * wc + 8 * fq;
    f32x4 gt[2][2], g4[2][2];
#pragma unroll
    for (int bj = 0; bj < 2; ++bj)
#pragma unroll
      for (int n = 0; n < 2; ++n) {
        gt[bj][n] = *(const f32x4*)(gate + ci * 6144 + c0 + 128 * bj + 4 * n);
        g4[bj][n] = AB ? *(const f32x4*)(gs + ci * 1024 + c0 + 128 * bj + 4 * n) : (f32x4){0.f, 0.f, 0.f, 0.f};
      }
    const float* xbase = rb < NP ? xp + (size_t)rb * DM : xs + (size_t)(rb - NP) * DM;
    const bf16_t* xbb = Xin + (size_t)rb * DM;
    constexpr int RB = FROM_INPUT ? 2 : 4;
#pragma unroll
    for (int bt = 0; bt < 8 / RB; ++bt) {
      f32x4 xf[FROM_INPUT ? RB : 1][2][2];
      u32x4 xr[FROM_INPUT ? 1 : RB][2];
#pragma unroll
      for (int k = 0; k < RB; ++k)
#pragma unroll
        for (int bj = 0; bj < 2; ++bj) {
          const int lrow = bt * RB + k, ai = lrow >> 2, m = lrow & 3;
          const size_t xo = (size_t)(128 * ai + 64 * wr + 16 * m + fr) * DM + c0 + 128 * bj;
          if constexpr (FROM_INPUT) { xf[k][bj][0] = *(const f32x4*)(xbase + xo); xf[k][bj][1] = *(const f32x4*)(xbase + xo + 4); }
          else xr[k][bj] = *(const u32x4*)(xbb + xo);
        }
#pragma unroll
      for (int k = 0; k < RB; ++k) {
        const int lrow = bt * RB + k, ai = lrow >> 2, m = lrow & 3;
        const int row = rb + 128 * ai + 64 * wr + 16 * m + fr;
        float ss = 0.f;
#pragma unroll
        for (int bj = 0; bj < 2; ++bj) {
          const int col = c0 + 128 * bj;
          f32x4 x0, x1;
          if constexpr (FROM_INPUT) { x0 = xf[k][bj][0]; x1 = xf[k][bj][1]; }
          else {
            const u32x4 t = xr[k][bj];
            x0 = (f32x4){__uint_as_float(t[0] << 16), __uint_as_float(t[0] & 0xffff0000u), __uint_as_float(t[1] << 16), __uint_as_float(t[1] & 0xffff0000u)};
            x1 = (f32x4){__uint_as_float(t[2] << 16), __uint_as_float(t[2] & 0xffff0000u), __uint_as_float(t[3] << 16), __uint_as_float(t[3] & 0xffff0000u)};
          }
          f32x4 o[2];
#pragma unroll
          for (int e = 0; e < 4; ++e) { o[0][e] = x0[e] + gt[bj][0][e] * acc[ai][bj][m][0][e]; o[1][e] = x1[e] + gt[bj][1][e] * acc[ai][bj][m][1][e]; }
          { u32x4 xw; xw[0] = pack_bf16(o[0][0], o[0][1]); xw[1] = pack_bf16(o[0][2], o[0][3]); xw[2] = pack_bf16(o[1][0], o[1][1]); xw[3] = pack_bf16(o[1][2], o[1][3]);
            *(u32x4*)(Xout + (size_t)row * DM + col) = xw; }
          if (AB) {
#pragma unroll
            for (int n = 0; n < 2; ++n)
#pragma unroll
              for (int e = 0; e < 4; ++e) ss += o[n][e] * o[n][e];
            u32x4 w;
            w[0] = pack_bf16(o[0][0] * g4[bj][0][0], o[0][1] * g4[bj][0][1]); w[1] = pack_bf16(o[0][2] * g4[bj][0][2], o[0][3] * g4[bj][0][3]);
            w[2] = pack_bf16(o[1][0] * g4[bj][1][0], o[1][1] * g4[bj][1][1]); w[3] = pack_bf16(o[1][2] * g4[bj][1][2], o[1][3] * g4[bj][1][3]);
            *(u32x4*)(AB + (size_t)row * DM + col) = w;
          }
        }
        if (AB) {
          ss += __shfl_xor(ss, 16);
          ss += __shfl_xor(ss, 32);
          if (fq == 0) atomicAdd(sumsq + row, ss);
        }
      }
    }
  }
};
struct EpiFinal {
  static constexpr bool AFTER_DRAIN = true, PERM = true;
  const bf16_t* Xin; const float* gate; const float* gfin; float* out; float* sumsq; unsigned* pcnt;
  __device__ __forceinline__ void operator()(f32x4 (&acc)[2][2][4][2], const Unit& u, int wr, int wc, int fr, int fq) const {
    const int rb = u.pm * 256, cb = u.pn * 256;
    const int ci = cond_index(rb);
    const int c0 = cb + 32 * wc + 8 * fq;
    f32x4 gt[2][2];
#pragma unroll
    for (int bj = 0; bj < 2; ++bj)
#pragma unroll
      for (int n = 0; n < 2; ++n) gt[bj][n] = *(const f32x4*)(gate + ci * 6144 + c0 + 128 * bj + 4 * n);
    const bf16_t* xbase = Xin + (size_t)rb * DM;
#pragma unroll
    for (int am = 0; am < 4; ++am) {
      const int ai = am >> 1, m0 = (am & 1) * 2;
      f32x4 x[2][2][2];
#pragma unroll
      for (int mm = 0; mm < 2; ++mm)
#pragma unroll
        for (int bj = 0; bj < 2; ++bj) {
          const u32x4 t = *(const u32x4*)(xbase + (size_t)(128 * ai + 64 * wr + 16 * (m0 + mm) + fr) * DM + c0 + 128 * bj);
          x[mm][bj][0] = (f32x4){__uint_as_float(t[0] << 16), __uint_as_float(t[0] & 0xffff0000u), __uint_as_float(t[1] << 16), __uint_as_float(t[1] & 0xffff0000u)};
          x[mm][bj][1] = (f32x4){__uint_as_float(t[2] << 16), __uint_as_float(t[2] & 0xffff0000u), __uint_as_float(t[3] << 16), __uint_as_float(t[3] & 0xffff0000u)};
        }
#pragma unroll
      for (int mm = 0; mm < 2; ++mm) {
        const int m = m0 + mm;
        float ss = 0.f;
#pragma unroll
        for (int bj = 0; bj < 2; ++bj)
#pragma unroll
          for (int n = 0; n < 2; ++n) {
            f32x4 o;
#pragma unroll
            for (int e = 0; e < 4; ++e) { o[e] = x[mm][bj][n][e] + gt[bj][n][e] * acc[ai][bj][m][n][e]; ss += o[e] * o[e]; }
            acc[ai][bj][m][n] = o;
          }
        ss += __shfl_xor(ss, 16);
        ss += __shfl_xor(ss, 32);
        if (fq == 0) atomicAdd(sumsq + rb + 128 * ai + 64 * wr + 16 * m + fr, ss);
      }
    }
    asm volatile("s_waitcnt vmcnt(0)" ::: "memory");
    unsigned* pc = pcnt + u.pm * 64;
    if ((threadIdx.x & 63) == 0) __hip_atomic_fetch_add(pc, 1u, __ATOMIC_RELAXED, __HIP_MEMORY_SCOPE_AGENT);
    {
      unsigned spins = 0;
      while ((unsigned)__builtin_amdgcn_readfirstlane(__hip_atomic_load(pc, __ATOMIC_RELAXED, __HIP_MEMORY_SCOPE_AGENT)) < 32u) {
        __builtin_amdgcn_s_sleep(2);
        if (++spins > (1u << 22)) break;
      }
    }
    f32x4 gf[2][2];
#pragma unroll
    for (int bj = 0; bj < 2; ++bj)
#pragma unroll
      for (int n = 0; n < 2; ++n) gf[bj][n] = *(const f32x4*)(gfin + c0 + 128 * bj + 4 * n);
    float sq[2][4];
#pragma unroll
    for (int ai = 0; ai < 2; ++ai)
#pragma unroll
      for (int m = 0; m < 4; ++m) sq[ai][m] = __hip_atomic_load(sumsq + rb + 128 * ai + 64 * wr + 16 * m + fr, __ATOMIC_RELAXED, __HIP_MEMORY_SCOPE_AGENT);
#pragma unroll
    for (int ai = 0; ai < 2; ++ai)
#pragma unroll
      for (int m = 0; m < 4; ++m) {
        const int row = rb + 128 * ai + 64 * wr + 16 * m + fr;
        const float rs = rsqrtf(sq[ai][m] * (1.0f / DM) + 1e-6f);
#pragma unroll
        for (int bj = 0; bj < 2; ++bj)
#pragma unroll
          for (int n = 0; n < 2; ++n) {
            f32x4 y;
#pragma unroll
            for (int e = 0; e < 4; ++e) y[e] = acc[ai][bj][m][n][e] * rs * gf[bj][n][e];
            *(f32x4*)(out + (size_t)row * DM + c0 + 128 * bj + 4 * n) = y;
          }
      }
  }
};
template <bool HALF>
struct EpiSwiGLU {
  static constexpr bool AFTER_DRAIN = false, PERM = false;
  bf16_t* H; const float* sumsq; const float* shw;
  __device__ __forceinline__ void operator()(const f32x4 (&acc)[2][2][4][2], const Unit& u, int wr, int wc, int fr, int fq) const {
    const int rb = u.row0;
    const float* sw = shw + cond_index(rb) * 5632 + u.pn * 256 + 32 * wc + 4 * fq;
    f32x4 sg[2], su[2];
#pragma unroll
    for (int bj = 0; bj < 2; ++bj) { sg[bj] = *(const f32x4*)(sw + 128 * bj); su[bj] = *(const f32x4*)(sw + 128 * bj + 16); }
    float rstd[2][4];
#pragma unroll
    for (int ai = 0; ai < (HALF ? 1 : 2); ++ai)
#pragma unroll
      for (int m = 0; m < 4; ++m) rstd[ai][m] = sumsq[rb + 128 * ai + 64 * wr + 16 * m + fr];
#pragma unroll
    for (int ai = 0; ai < (HALF ? 1 : 2); ++ai)
#pragma unroll
      for (int m = 0; m < 4; ++m) {
        const int row = rb + 128 * ai + 64 * wr + 16 * m + fr;
        const float rs = rsqrtf(rstd[ai][m] * (1.0f / DM) + 1e-6f);
#pragma unroll
        for (int bj = 0; bj < 2; ++bj) {
          const int col = (u.pn * 256 + 128 * bj + 32 * wc) / 2 + 4 * fq;
          float o[4];
#pragma unroll
          for (int e = 0; e < 4; ++e) o[e] = siluf_(rs * acc[ai][bj][m][0][e] + sg[bj][e]) * (rs * acc[ai][bj][m][1][e] + su[bj][e]);
          u32x2 w; w[0] = pack_bf16(o[0], o[1]); w[1] = pack_bf16(o[2], o[3]);
          *(u32x2*)(H + (size_t)row * DFF + col) = w;
        }
      }
  }
};
struct EpiBf16Norm {
  static constexpr bool AFTER_DRAIN = false, PERM = true;
  bf16_t* C; const float* sumsq; const float* shw;
  __device__ __forceinline__ void operator()(const f32x4 (&acc)[2][2][4][2], const Unit& u, int wr, int wc, int fr, int fq) const {
    const int rb = u.pm * 256, c0 = u.pn * 256 + 32 * wc + 8 * fq;
    const float* sw = shw + cond_index(rb) * 1024 + c0;
    f32x4 sh[2][2];
#pragma unroll
    for (int bj = 0; bj < 2; ++bj)
#pragma unroll
      for (int n = 0; n < 2; ++n) sh[bj][n] = *(const f32x4*)(sw + 128 * bj + 4 * n);
    float rstd[2][4];
#pragma unroll
    for (int ai = 0; ai < 2; ++ai)
#pragma unroll
      for (int m = 0; m < 4; ++m) rstd[ai][m] = sumsq[rb + 128 * ai + 64 * wr + 16 * m + fr];
#pragma unroll
    for (int ai = 0; ai < 2; ++ai)
#pragma unroll
      for (int m = 0; m < 4; ++m) {
        const int row = rb + 128 * ai + 64 * wr + 16 * m + fr;
        const float rs = rsqrtf(rstd[ai][m] * (1.0f / DM) + 1e-6f);
#pragma unroll
        for (int bj = 0; bj < 2; ++bj) {
          const f32x4 v0 = acc[ai][bj][m][0], v1 = acc[ai][bj][m][1];
          u32x4 w;
          w[0] = pack_bf16(rs * v0[0] + sh[bj][0][0], rs * v0[1] + sh[bj][0][1]); w[1] = pack_bf16(rs * v0[2] + sh[bj][0][2], rs * v0[3] + sh[bj][0][3]);
          w[2] = pack_bf16(rs * v1[0] + sh[bj][1][0], rs * v1[1] + sh[bj][1][1]); w[3] = pack_bf16(rs * v1[2] + sh[bj][1][2], rs * v1[3] + sh[bj][1][3]);
          *(u32x4*)(C + (size_t)row * DM + c0 + 128 * bj) = w;
        }
      }
  }
};
template <bool HALF>
struct EpiGlu {
  static constexpr bool AFTER_DRAIN = false, PERM = true;
  const bf16_t* YBF; const float* bias; bf16_t* CAT;
  __device__ __forceinline__ void operator()(const f32x4 (&acc)[2][2][4][2], const Unit& u, int wr, int wc, int fr, int fq) const {
    const int rb = u.row0, c0 = u.pn * 256 + 32 * wc + 8 * fq;
    f32x4 bb[2][2];
#pragma unroll
    for (int bj = 0; bj < 2; ++bj)
#pragma unroll
      for (int n = 0; n < 2; ++n) bb[bj][n] = *(const f32x4*)(bias + c0 + 128 * bj + 4 * n);
#pragma unroll
    for (int ai = 0; ai < (HALF ? 1 : 2); ++ai) {
      u32x4 yy[4][2];
#pragma unroll
      for (int m = 0; m < 4; ++m)
#pragma unroll
        for (int bj = 0; bj < 2; ++bj) yy[m][bj] = *(const u32x4*)(YBF + (size_t)(rb + 128 * ai + 64 * wr + 16 * m + fr) * 512 + c0 + 128 * bj);
#pragma unroll
      for (int m = 0; m < 4; ++m) {
        const int row = rb + 128 * ai + 64 * wr + 16 * m + fr;
#pragma unroll
        for (int bj = 0; bj < 2; ++bj) {
          u32x4 w;
#pragma unroll
          for (int n = 0; n < 2; ++n) {
            const f32x4 v = acc[ai][bj][m][n]; const f32x4 b = bb[bj][n];
            const unsigned ya = yy[m][bj][2 * n], yb = yy[m][bj][2 * n + 1];
            const float y0 = __uint_as_float(ya << 16), y1 = __uint_as_float(ya & 0xffff0000u), y2 = __uint_as_float(yb << 16), y3 = __uint_as_float(yb & 0xffff0000u);
            w[2 * n] = pack_bf16(y0 * sigmoidf_(v[0] + b[0]), y1 * sigmoidf_(v[1] + b[1]));
            w[2 * n + 1] = pack_bf16(y2 * sigmoidf_(v[2] + b[2]), y3 * sigmoidf_(v[3] + b[3]));
          }
          *(u32x4*)(CAT + (size_t)row * DM + 512 + c0 + 128 * bj) = w;
        }
      }
    }
  }
};

__device__ __forceinline__ void prep_mod_item(const Params& p, int item, char* smem, int tid) {
  const int layer = item / 96, cg64 = item % 96;
  const int kg = tid >> 4, l16 = tid & 15;
  float* sc = (float*)smem;
  float* red = (float*)(smem + 12288);
  __syncthreads();
  for (int i = tid; i < 3072; i += 256) {
    const int ci = i >> 10, k = i & 1023;
    const float cv = ci == 0 ? p.c_ctx[k] : p.c[(ci - 1) * DM + k];
    sc[i] = siluf_(cv);
  }
  __syncthreads();
  const int col = cg64 * 64 + l16 * 4;
  const float* w = p.w_mod + ((size_t)layer * DM + kg * 64) * 6144 + col;
  float a[3][4];
#pragma unroll
  for (int ci = 0; ci < 3; ++ci)
#pragma unroll
    for (int e = 0; e < 4; ++e) a[ci][e] = 0.f;
#pragma unroll 8
  for (int r = 0; r < 64; ++r) {
    const f32x4 wv = *(const f32x4*)(w + (size_t)r * 6144);
#pragma unroll
    for (int ci = 0; ci < 3; ++ci) {
      const float s = sc[ci * 1024 + kg * 64 + r];
#pragma unroll
      for (int e = 0; e < 4; ++e) a[ci][e] += s * wv[e];
    }
  }
#pragma unroll
  for (int ci = 0; ci < 3; ++ci)
#pragma unroll
    for (int e = 0; e < 4; ++e) red[(kg * 3 + ci) * 64 + l16 * 4 + e] = a[ci][e];
  __syncthreads();
  if (tid < 192) {
    const int ci = tid >> 6, c = tid & 63;
    float sum = p.b_mod[layer * 6144 + cg64 * 64 + c];
#pragma unroll
    for (int k2 = 0; k2 < 16; ++k2) sum += red[(k2 * 3 + ci) * 64 + c];
    ((float*)(p.ws + OFF_MOD))[(size_t)(layer * 3 + ci) * 6144 + cg64 * 64 + c] = sum;
  }
}

__device__ __forceinline__ void prep_transpose_tile(const float* src, int K, int N, bf16_t* dst, int kt, int nt, int mapmode, char* smem, int tid) {
  float* T = (float*)smem;
  __syncthreads();
#pragma unroll
  for (int i = 0; i < 4; ++i) {
    const int idx = tid + 256 * i, kr = idx >> 4, c4 = idx & 15;
    const f32x4 v = *(const f32x4*)(src + (size_t)(kt * 64 + kr) * N + nt * 64 + c4 * 4);
#pragma unroll
    for (int e = 0; e < 4; ++e) T[kr * 65 + c4 * 4 + e] = v[e];
  }
  __syncthreads();
#pragma unroll
  for (int i = 0; i < 2; ++i) {
    const int idx = tid + 256 * i, nr = idx >> 3, seg = idx & 7;
    f32x4 a, b;
#pragma unroll
    for (int e = 0; e < 4; ++e) { a[e] = T[(seg * 8 + e) * 65 + nr]; b[e] = T[(seg * 8 + 4 + e) * 65 + nr]; }
    const int n = nt * 64 + nr;
    int drow = n;
    if (mapmode == 1) drow = (n >> 4) * 32 + (n & 15);
    else if (mapmode == 2) drow = (n >> 4) * 32 + 16 + (n & 15);
    *(u32x4*)(dst + (size_t)drow * K + kt * 64 + seg * 8) = pack8(a, b);
  }
}

__device__ __forceinline__ void prep_s5_item(const Params& p, int item, int tid) {
  const int idx = item * 256 + tid;
  const int d = idx >> 11, g = (idx >> 6) & 31;
  const float lr = fminf(p.lam_re[idx], -1e-4f), li = p.lam_im[idx];
  const float dt = expf(p.log_step[d * 32 + g]);
  const float mag = expf(lr * dt);
  const float ar = mag * cosf(li * dt), ai = mag * sinf(li * dt);
  const float den = lr * lr + li * li, nr = ar - 1.0f, ni = ai;
  const float cr = (nr * lr + ni * li) / den, ci = (ni * lr - nr * li) / den;
  ((float*)(p.ws + OFF_AR))[idx] = ar;
  ((float*)(p.ws + OFF_AI))[idx] = ai;
  float* bb = (float*)(p.ws + OFF_BBAR);
  const int pp = idx & 63;
  const size_t o0 = ((size_t)((d * 32 + g) * 2 + 0) * 64 + pp) * 16, o1 = ((size_t)((d * 32 + g) * 2 + 1) * 64 + pp) * 16;
  for (int h = 0; h < 16; ++h) {
    const float br = p.b_re[(size_t)idx * 16 + h], bi = p.b_im[(size_t)idx * 16 + h];
    bb[o0 + h] = cr * br - ci * bi;
    bb[o1 + h] = cr * bi + ci * br;
  }
}

__device__ __forceinline__ void prep_dft_item(const Params& p, int item, int tid) {
  bf16_t* dst; int e0;
  int mode;
  if (item < 64) { dst = (bf16_t*)(p.ws + OFF_CS2); e0 = item * 2048 + tid * 8; mode = 0; }
  else if (item < 128) { dst = (bf16_t*)(p.ws + OFF_CL2P); e0 = (item - 64) * 2048 + tid * 8; mode = 1; }
  else { dst = (bf16_t*)(p.ws + OFF_CL2S); e0 = (item - 128) * 2048 + tid * 8; mode = 2; }
  float v[8];
#pragma unroll
  for (int j = 0; j < 8; ++j) {
    const int e = e0 + j;
    float s, c;
    if (mode == 0) {
      const int row = e >> 8, cc = e & 255, kc = row >> 1, cs = row & 1;
      const int ph = (kc * cc) & 255;
      sincospif((float)ph * (2.0f / 256.0f), &s, &c);
      v[j] = (cs ? s : c) * (1.0f / 16.0f);
    } else if (mode == 1) {
      const int kl = e >> 9, r = e & 511, cs = r >> 8, l = r & 255;
      const int ph = (kl * l) & 255;
      sincospif((float)ph * (2.0f / 256.0f), &s, &c);
      v[j] = (cs ? -s : c) * (1.0f / 16.0f);
    } else {
      const int kl = e >> 11, r = e & 2047, cs = r >> 10, l = r & 1023;
      const int ph = (kl * l) & 1023;
      sincospif((float)ph * (2.0f / 1024.0f), &s, &c);
      v[j] = (cs ? -s : c) * (1.0f / 32.0f);
    }
  }
  u32x4 o; o[0] = pack_bf16(v[0], v[1]); o[1] = pack_bf16(v[2], v[3]); o[2] = pack_bf16(v[4], v[5]); o[3] = pack_bf16(v[6], v[7]);
  *(u32x4*)(dst + e0) = o;
}

__device__ __forceinline__ void prep_transpose_job(const Params& p, int job, int t, char* smem, int tid) {
  if (job == 0) prep_transpose_tile(p.w_in_even, 1024, 2048, (bf16_t*)(p.ws + OFF_WT_IN), t / 32, t % 32, 0, smem, tid);
  else if (job == 1) prep_transpose_tile(p.glu_w, 512, 512, (bf16_t*)(p.ws + OFF_WT_GLU), t / 8, t % 8, 0, smem, tid);
  else if (job <= 4) {
    const float* src = job == 2 ? p.w_out_even : (job == 3 ? p.w_in_odd : p.w_out_odd);
    const size_t off = job == 2 ? OFF_WT_OUT : (job == 3 ? OFF_WT_INO : OFF_WT_OUTO);
    prep_transpose_tile(src, 1024, 1024, (bf16_t*)(p.ws + off), t / 16, t % 16, 0, smem, tid);
  } else if (job <= 8) {
    const int layer = (job - 5) & 1, isup = (job - 5) >> 1;
    const float* src = (isup ? p.w_up : p.w_gate) + (size_t)layer * 1024 * DFF;
    prep_transpose_tile(src, 1024, DFF, (bf16_t*)(p.ws + OFF_WT_GU) + (size_t)layer * 5632 * 1024, t / 44, t % 44, 1 + isup, smem, tid);
  } else {
    const int layer = job - 9;
    prep_transpose_tile(p.w_down + (size_t)layer * DFF * 1024, DFF, 1024, (bf16_t*)(p.ws + OFF_WT_DN) + (size_t)layer * 1024 * DFF, t / 16, t % 16, 0, smem, tid);
  }
}
constexpr int TR_EARLY = 512;
constexpr int TR_MID = 64 + 256 + 256 + 3 * 704;
constexpr int TR_LATE = 256 + 3 * 704;
__device__ __forceinline__ void prep_transpose_early(const Params& p, int t, char* smem, int tid) {
  prep_transpose_job(p, 0, t, smem, tid);
}
__device__ __forceinline__ void prep_transpose_mid(const Params& p, int t, char* smem, int tid) {
  int job;
  if (t < 64) job = 1; else if ((t -= 64) < 256) job = 2; else if ((t -= 256) < 256) job = 3;
  else if ((t -= 256) < 704) job = 5; else if ((t -= 704) < 704) job = 7; else { t -= 704; job = 9; }
  prep_transpose_job(p, job, t, smem, tid);
}
__device__ __forceinline__ void prep_transpose_late(const Params& p, int t, char* smem, int tid) {
  int job;
  if (t < 256) job = 4; else if ((t -= 256) < 704) job = 6; else if ((t -= 704) < 704) job = 8; else { t -= 704; job = 10; }
  prep_transpose_job(p, job, t, smem, tid);
}

__device__ __forceinline__ void phase_prep(const Params& p, char* smem0) {
  constexpr int T0 = 96;
  constexpr int S0 = T0 + TR_EARLY, TOTAL = S0 + 16;
  static_assert((T0 % 2) == 0 && (TR_EARLY % 2) == 0 && (TOTAL % 2) == 0, "even");
  const int T_ = opaque_tid();
  const int vb = T_ >> 8, tid = T_ & 255;
  char* smem = smem0 + vb * 32768;
  for (int item0 = blockIdx.x * 2; item0 < TOTAL; item0 += gridDim.x * 2) {
    const int item = item0 + vb;
    if (item < T0) prep_mod_item(p, item, smem, tid);
    else if (item < S0) prep_transpose_early(p, item - T0, smem, tid);
    else prep_s5_item(p, item - S0, tid);
  }
}
__device__ __forceinline__ void phase_prep_mod1(const Params& p, char* smem0, int first_block) {
  if ((int)blockIdx.x < first_block) return;
  const int T_ = opaque_tid();
  const int vb = T_ >> 8, tid = T_ & 255;
  char* smem = smem0 + vb * 32768;
  const int nb = gridDim.x - first_block;
  for (int item0 = ((int)blockIdx.x - first_block) * 2; item0 < 96; item0 += nb * 2) prep_mod_item(p, 96 + item0 + vb, smem, tid);
}
__device__ __forceinline__ void phase_prep_dft(const Params& p, int first_block) {
  if ((int)blockIdx.x < first_block) return;
  const int T_ = opaque_tid();
  const int vb = T_ >> 8, tid = T_ & 255;
  const int nb = gridDim.x - first_block;
  for (int item0 = ((int)blockIdx.x - first_block) * 2; item0 < 1152; item0 += nb * 2) prep_dft_item(p, item0 + vb, tid);
}
__device__ __forceinline__ void phase_prep_late(const Params& p, char* smem0, int which, int first_block) {
  if ((int)blockIdx.x < first_block) return;
  const int T_ = opaque_tid();
  const int vb = T_ >> 8, tid = T_ & 255;
  char* smem = smem0 + vb * 32768;
  const int nb = gridDim.x - first_block, total = which ? TR_LATE : TR_MID;
  for (int item0 = ((int)blockIdx.x - first_block) * 2; item0 < total; item0 += nb * 2) {
    if (which) prep_transpose_late(p, item0 + vb, smem, tid); else prep_transpose_mid(p, item0 + vb, smem, tid);
  }
}

__device__ __forceinline__ void phase_norm(const Params& p, bool from_input, const float* gvec, const float* modbase  ) {
  const int T_ = opaque_tid();
  const int lane = T_ & 63, wid = T_ >> 6;
  const float* X = (const float*)(p.ws + OFF_X);
  bf16_t* A = (bf16_t*)(p.ws + OFF_ABUF);
  constexpr int RPW = 5;
  const int nw = gridDim.x * 8, w0 = blockIdx.x * 8 + wid;
  if (nw * RPW == NTOK) {
    f32x4 v[RPW][4];
#pragma unroll
    for (int j = 0; j < RPW; ++j) {
      const int row = w0 + j * nw;
      const float* xr = from_input ? xin_row(p, row) : X + (size_t)row * DM;
#pragma unroll
      for (int i = 0; i < 4; ++i) v[j][i] = *(const f32x4*)(xr + i * 256 + lane * 4);
    }
    f32x4 g[4];
#pragma unroll
    for (int i = 0; i < 4; ++i) g[i] = *(const f32x4*)(gvec + i * 256 + lane * 4);
#pragma unroll
    for (int j = 0; j < RPW; ++j) {
      const int row = w0 + j * nw;
      float ss = 0.f;
#pragma unroll
      for (int i = 0; i < 4; ++i)
#pragma unroll
        for (int e = 0; e < 4; ++e) ss += v[j][i][e] * v[j][i][e];
#pragma unroll
      for (int o = 32; o >= 1; o >>= 1) ss += __shfl_xor(ss, o);
      const float rstd = rsqrtf(ss * (1.0f / DM) + 1e-6f);
      const float* mb = modbase + cond_index(row) * 6144;
#pragma unroll
      for (int i = 0; i < 4; ++i) {
        const int k = i * 256 + lane * 4;
        const f32x4 sh = *(const f32x4*)(mb + k), sc = *(const f32x4*)(mb + 1024 + k);
        float o[4];
#pragma unroll
        for (int e = 0; e < 4; ++e) o[e] = v[j][i][e] * rstd * g[i][e] * (1.0f + sc[e]) + sh[e];
        u32x2 w; w[0] = pack_bf16(o[0], o[1]); w[1] = pack_bf16(o[2], o[3]);
        *(u32x2*)(A + (size_t)row * DM + k) = w;
      }
    }
    return;
  }
  for (int row = w0; row < NTOK; row += nw) {
    const float* xr = from_input ? xin_row(p, row) : X + (size_t)row * DM;
    f32x4 v[4];
    float ss = 0.f;
#pragma unroll
    for (int i = 0; i < 4; ++i) {
      v[i] = *(const f32x4*)(xr + i * 256 + lane * 4);
#pragma unroll
      for (int e = 0; e < 4; ++e) ss += v[i][e] * v[i][e];
    }
#pragma unroll
    for (int o = 32; o >= 1; o >>= 1) ss += __shfl_xor(ss, o);
    const float rstd = rsqrtf(ss * (1.0f / DM) + 1e-6f);
    const float* mb = modbase + cond_index(row) * 6144;
#pragma unroll
    for (int i = 0; i < 4; ++i) {
      const int k = i * 256 + lane * 4;
      const f32x4 g = *(const f32x4*)(gvec + k), sh = *(const f32x4*)(mb + k), sc = *(const f32x4*)(mb + 1024 + k);
      float o[4];
#pragma unroll
      for (int e = 0; e < 4; ++e) o[e] = v[i][e] * rstd * g[e] * (1.0f + sc[e]) + sh[e];
      u32x2 w; w[0] = pack_bf16(o[0], o[1]); w[1] = pack_bf16(o[2], o[3]);
      *(u32x2*)(A + (size_t)row * DM + k) = w;
    }
  }
}
__device__ __forceinline__ void phase_norm_consts(const Params& p, int part, int first_block) {
  const int T_ = opaque_tid();
  const int lane = T_ & 63, wid = T_ >> 6;
  const float* MOD = (const float*)(p.ws + OFF_MOD);
  float* GS = (float*)(p.ws + OFF_GS);
  const int nblk = (int)gridDim.x - first_block, blk = (int)blockIdx.x - first_block;
  if (blk < 0) return;
  if (part < 2) {
    const int i0 = part == 0 ? 0 : 3072, i1 = part == 0 ? 3072 : 9216;
    for (int i = i0 + blk * 512 + T_; i < i1; i += nblk * 512) {
      const int uu = i / 3072, ci = (i >> 10) % 3, k = i & 1023;
      const float* gvec = uu == 0 ? p.norm_ffn_g : (uu == 1 ? p.norm_mix_g + DM : p.norm_ffn_g + DM);
      const int layer = uu == 0 ? 0 : 1, j = uu == 1 ? 1 : 4;
      GS[i] = gvec[k] * (1.0f + MOD[(size_t)(layer * 3 + ci) * 6144 + j * 1024 + k]);
    }
  }
  const int rbase = part == 0 ? 0 : (part == 2 ? 5632 : 11264), rcnt = part == 1 ? 1024 : 5632;
  for (int r0 = blk * 8 + wid; r0 < rcnt; r0 += nblk * 8) {
    const int row = rbase + r0;
    const bf16_t* wrow; const float* sh; float* dst; int dstride;
    if (row < 2 * 5632) {
      const int layer = row / 5632, n = row - layer * 5632;
      wrow = (const bf16_t*)(p.ws + OFF_WT_GU) + (size_t)row * 1024;
      sh = MOD + (size_t)layer * 3 * 6144 + 3 * 1024;
      dst = (float*)(p.ws + OFF_SHWGU) + (size_t)layer * 3 * 5632 + n; dstride = 5632;
    } else {
      const int n = row - 2 * 5632;
      wrow = (const bf16_t*)(p.ws + OFF_WT_INO) + (size_t)n * 1024;
      sh = MOD + (size_t)3 * 6144;
      dst = (float*)(p.ws + OFF_SHWINO) + n; dstride = 1024;
    }
    const u32x4 w0 = *(const u32x4*)(wrow + lane * 16), w1 = *(const u32x4*)(wrow + lane * 16 + 8);
    float wf[16];
#pragma unroll
    for (int q = 0; q < 4; ++q) { wf[2 * q] = __uint_as_float(w0[q] << 16); wf[2 * q + 1] = __uint_as_float(w0[q] & 0xffff0000u); wf[8 + 2 * q] = __uint_as_float(w1[q] << 16); wf[8 + 2 * q + 1] = __uint_as_float(w1[q] & 0xffff0000u); }
#pragma unroll
    for (int ci = 0; ci < 3; ++ci) {
      float acc = 0.f;
#pragma unroll
      for (int q = 0; q < 4; ++q) {
        const f32x4 sv = *(const f32x4*)(sh + ci * 6144 + lane * 16 + q * 4);
#pragma unroll
        for (int e = 0; e < 4; ++e) acc += wf[q * 4 + e] * sv[e];
      }
#pragma unroll
      for (int o = 32; o >= 1; o >>= 1) acc += __shfl_xor(acc, o);
      if (lane == 0) dst[ci * dstride] = acc;
    }
  }
}

__device__ __forceinline__ void phase_final_norm(const Params& p) {
  const int T_ = opaque_tid();
  const int lane = T_ & 63, wid = T_ >> 6;
  const float* X = (const float*)(p.ws + OFF_X);
  for (int row = blockIdx.x * 8 + wid; row < NTOK; row += gridDim.x * 8) {
    const float* xr = X + (size_t)row * DM;
    f32x4 v[4];
    float ss = 0.f;
#pragma unroll
    for (int i = 0; i < 4; ++i) {
      v[i] = *(const f32x4*)(xr + i * 256 + lane * 4);
#pragma unroll
      for (int e = 0; e < 4; ++e) ss += v[i][e] * v[i][e];
    }
#pragma unroll
    for (int o = 32; o >= 1; o >>= 1) ss += __shfl_xor(ss, o);
    const float rstd = rsqrtf(ss * (1.0f / DM) + 1e-6f);
#pragma unroll
    for (int i = 0; i < 4; ++i) {
      const int k = i * 256 + lane * 4;
      const f32x4 g = *(const f32x4*)(p.final_g + k);
      f32x4 o;
#pragma unroll
      for (int e = 0; e < 4; ++e) o[e] = v[i][e] * rstd * g[e];
      *(f32x4*)(p.out + (size_t)row * DM + k) = o;
    }
  }
}

__device__ __forceinline__ void attn_item(const Params& p, int item, char* smem, int tid, int c_lo, int c_hi, int ntrips, int merge, char* smem_peer) {
  const int lane = tid & 63, wid = tid >> 6, lr = lane & 31, lh = lane >> 5;
  const bf16_t* QB = (const bf16_t*)(p.ws + OFF_QB);
  const bf16_t* KB = (const bf16_t*)(p.ws + OFF_KB);
  const bf16_t* VB = (const bf16_t*)(p.ws + OFF_VB);
  bf16_t* CAT = (bf16_t*)(p.ws + OFF_CAT);
  bool latent; int b, head, qrow0, nchunks, r0 = 0, rowstart = 0;
  if (item < 128) { latent = true; b = item >> 6; head = (item >> 3) & 7; const int rp = item & 7; r0 = rp * 2; qrow0 = NP + b * LS + r0 * 64; nchunks = 9;
    int rs0 = r0 - 4; rs0 = rs0 < 0 ? 0 : (rs0 > 8 ? 8 : rs0); rowstart = rs0 < 6 ? rs0 : 6; }
  else { latent = false; const int it = item - 128; b = it >> 4; head = (it >> 1) & 7; qrow0 = b * LP + (it & 1) * 128; nchunks = 2; }
  const int qrow = qrow0 + wid * 32 + lr;
  bf16x8 qf[4];
#pragma unroll
  for (int ks = 0; ks < 4; ++ks) qf[ks] = *(const bf16x8*)(QB + (size_t)qrow * 512 + head * 64 + ks * 16 + lh * 8);
  f32x16 o[2];
#pragma unroll
  for (int i = 0; i < 16; ++i) { o[0][i] = 0.f; o[1][i] = 0.f; }
  float mrun = -1e30f, lsum = 0.f;
  const int qr = r0 + (wid >> 1), qc = (wid & 1) * 32 + lr;
  int rs = qr - 4; rs = rs < 0 ? 0 : (rs > 8 ? 8 : rs);
  int cs = qc - 8; cs = cs < 0 ? 0 : (cs > 48 ? 48 : cs);
  char* Ks = smem;
  char* Vt = smem + 16384;
  const float LOG2E = 1.4426950408889634f;
  (void)nchunks;
  for (int tr = 0; tr < ntrips; ++tr) {
    const int c = c_lo + tr;
    const bool active = c < c_hi;
    const bool local = latent && c < 5;
    __syncthreads();
    if (active) {
    if (!latent || local) {
      const int krow0 = latent ? NP + b * LS + (rowstart + 2 * c) * 64 : b * LP + c * 128;
#pragma unroll
      for (int i = 0; i < 4; ++i) {
        const int idx = tid + 256 * i, key = idx >> 3, seg = idx & 7;
        const u32x4 v = *(const u32x4*)(KB + (size_t)(krow0 + key) * 512 + head * 64 + seg * 8);
        *(u32x4*)(Ks + key * 128 + ((seg ^ ((key >> 1) & 7)) << 4)) = v;
      }
#pragma unroll
      for (int i = 0; i < 2; ++i) {
        const int idx = tid + 256 * i, kp = idx >> 3, seg = idx & 7;
        const u32x4 v0 = *(const u32x4*)(VB + (size_t)(krow0 + 2 * kp) * 512 + head * 64 + seg * 8);
        const u32x4 v1 = *(const u32x4*)(VB + (size_t)(krow0 + 2 * kp + 1) * 512 + head * 64 + seg * 8);
#pragma unroll
        for (int j = 0; j < 4; ++j) {
          const unsigned lo = (v0[j] & 0xffffu) | (v1[j] << 16), hi = (v0[j] >> 16) | (v1[j] & 0xffff0000u);
          *(unsigned*)(Vt + (seg * 8 + 2 * j) * 272 + kp * 4) = lo;
          *(unsigned*)(Vt + (seg * 8 + 2 * j + 1) * 272 + kp * 4) = hi;
        }
      }
    } else {
      const int l0 = (c - 5) * 128;
      const float* ck = p.cache_k + ((size_t)b * 512 + l0) * 512 + head * 64;
      const float* cv = p.cache_v + ((size_t)b * 512 + l0) * 512 + head * 64;
#pragma unroll
      for (int i = 0; i < 4; ++i) {
        const int idx = tid + 256 * i, key = idx >> 3, seg = idx & 7;
        const f32x4 a = *(const f32x4*)(ck + (size_t)key * 512 + seg * 8), bq = *(const f32x4*)(ck + (size_t)key * 512 + seg * 8 + 4);
        *(u32x4*)(Ks + key * 128 + ((seg ^ ((key >> 1) & 7)) << 4)) = pack8(a, bq);
      }
#pragma unroll
      for (int i = 0; i < 2; ++i) {
        const int idx = tid + 256 * i, kp = idx >> 3, seg = idx & 7;
        const float* s0 = cv + (size_t)(2 * kp) * 512 + seg * 8;
        const float* s1 = s0 + 512;
#pragma unroll
        for (int h4 = 0; h4 < 2; ++h4) {
          const f32x4 a = *(const f32x4*)(s0 + 4 * h4), bq = *(const f32x4*)(s1 + 4 * h4);
#pragma unroll
          for (int e = 0; e < 4; ++e) *(unsigned*)(Vt + (seg * 8 + 4 * h4 + e) * 272 + kp * 4) = pack_bf16(a[e], bq[e]);
        }
      }
    }
    }
    __syncthreads();
    if (active)
#pragma unroll 1
    for (int kt = 0; kt < 4; ++kt) {
      int kr = 0;
      if (local) {
        kr = rowstart + 2 * c + (kt >> 1);
        if (kr < rs || kr >= rs + 8) continue;
      }
      f32x16 st;
#pragma unroll
      for (int i = 0; i < 16; ++i) st[i] = 0.f;
#pragma unroll
      for (int ks = 0; ks < 4; ++ks) {
        const int row = kt * 32 + lr;
        const bf16x8 kf = *(const bf16x8*)(Ks + row * 128 + (((ks * 2 + lh) ^ ((row >> 1) & 7)) << 4));
        st = __builtin_amdgcn_mfma_f32_32x32x16_bf16(kf, qf[ks], st, 0, 0, 0);
      }
      float s2[16];
      float tmax = -1e30f;
      if (local) {
        const float* rp = p.na_rpb + ((size_t)head * 15 + (kr - qr + 7)) * 31;
#pragma unroll
        for (int i = 0; i < 16; ++i) {
          const int kc = (kt & 1) * 32 + 8 * (i >> 2) + 4 * lh + (i & 3);
          const bool valid = kc >= cs && kc < cs + 16;
          float sv = -1e30f;
          if (valid) sv = (st[i] * 0.125f + rp[kc - qc + 15]) * LOG2E;
          s2[i] = sv;
          tmax = fmaxf(tmax, sv);
        }
      } else {
#pragma unroll
        for (int i = 0; i < 16; ++i) { s2[i] = st[i] * (0.125f * LOG2E); tmax = fmaxf(tmax, s2[i]); }
      }
      tmax = fmaxf(tmax, xor32(tmax));
      const float mnew = fmaxf(mrun, tmax);
      const float alpha = __builtin_amdgcn_exp2f(mrun - mnew);
      mrun = mnew;
      float psum = 0.f;
#pragma unroll
      for (int i = 0; i < 16; ++i) { s2[i] = __builtin_amdgcn_exp2f(s2[i] - mnew); psum += s2[i]; }
      lsum = lsum * alpha + psum;
#pragma unroll
      for (int i = 0; i < 16; ++i) { o[0][i] *= alpha; o[1][i] *= alpha; }
#pragma unroll
      for (int s = 0; s < 2; ++s) {
        u32x4 pk;
        pk[0] = pack_bf16(s2[8 * s + 0], s2[8 * s + 1]); pk[1] = pack_bf16(s2[8 * s + 2], s2[8 * s + 3]);
        pk[2] = pack_bf16(s2[8 * s + 4], s2[8 * s + 5]); pk[3] = pack_bf16(s2[8 * s + 6], s2[8 * s + 7]);
        const bf16x8 pf = as_bf16x8(pk);
#pragma unroll
        for (int dt = 0; dt < 2; ++dt) {
          const char* vp = Vt + (dt * 32 + lr) * 272 + (kt * 32 + 16 * s + 4 * lh) * 2;
          const u32x2 a0 = *(const u32x2*)vp, a1 = *(const u32x2*)(vp + 16);
          u32x4 vv; vv[0] = a0[0]; vv[1] = a0[1]; vv[2] = a1[0]; vv[3] = a1[1];
          o[dt] = __builtin_amdgcn_mfma_f32_32x32x16_bf16(as_bf16x8(vv), pf, o[dt], 0, 0, 0);
        }
      }
    }
  }
  float ltot = lsum + xor32(lsum);
  if (merge == 1) {
    __syncthreads();
    char* pb_ = smem + wid * 8704;
#pragma unroll
    for (int dt = 0; dt < 2; ++dt)
#pragma unroll
      for (int i = 0; i < 16; ++i) *(float*)(pb_ + (dt * 16 + i) * 256 + lane * 4) = o[dt][i];
    *(float*)(pb_ + 8192 + lane * 4) = mrun;
    *(float*)(pb_ + 8448 + lane * 4) = ltot;
    __syncthreads();
    return;
  }
  if (merge == 2) {
    __syncthreads();
    __syncthreads();
    const char* pb_ = smem_peer + wid * 8704;
    const float m1 = *(const float*)(pb_ + 8192 + lane * 4), l1 = *(const float*)(pb_ + 8448 + lane * 4);
    const float m = fmaxf(mrun, m1);
    const float a0 = __builtin_amdgcn_exp2f(mrun - m), a1 = __builtin_amdgcn_exp2f(m1 - m);
    ltot = ltot * a0 + l1 * a1;
#pragma unroll
    for (int dt = 0; dt < 2; ++dt)
#pragma unroll
      for (int i = 0; i < 16; ++i) o[dt][i] = o[dt][i] * a0 + *(const float*)(pb_ + (dt * 16 + i) * 256 + lane * 4) * a1;
  }
  const float inv = 1.0f / ltot;
#pragma unroll
  for (int dt = 0; dt < 2; ++dt)
#pragma unroll
    for (int g = 0; g < 4; ++g) {
      const int d = dt * 32 + 8 * g + 4 * lh;
      u32x2 w; w[0] = pack_bf16(o[dt][4 * g] * inv, o[dt][4 * g + 1] * inv); w[1] = pack_bf16(o[dt][4 * g + 2] * inv, o[dt][4 * g + 3] * inv);
      *(u32x2*)(CAT + (size_t)qrow * DM + head * 64 + d) = w;
    }
}

template <bool FULL>
__device__ __forceinline__ void s5_scan(const Params& p, int trow0, int dstep, int nch, int g, int d, float (&cr_)[2], float (&ci_)[2], char* xs) {
  const int lane = opaque_tid() & 63, lr = lane & 31, lh = lane >> 5;
  const bf16_t* U = (const bf16_t*)(p.ws + OFF_U);
  float* Y = (float*)(p.ws + (d ? OFF_YB : OFF_YF));
  const float* AR = (const float*)(p.ws + OFF_AR);
  const float* AI = (const float*)(p.ws + OFF_AI);
  const float* BB = (const float*)(p.ws + OFF_BBAR);
  const int dg = d * 32 + g;
  bf16x8 bfrag[4];
#pragma unroll
  for (int nb = 0; nb < 4; ++nb) {
    const int ri = nb >> 1, pb = nb & 1;
    const float* src = BB + ((size_t)(dg * 2 + ri) * 64 + pb * 32 + lr) * 16 + lh * 8;
    bfrag[nb] = as_bf16x8(pack8(*(const f32x4*)src, *(const f32x4*)(src + 4)));
  }
  bf16x8 cfrag[4];
  if (FULL) {
    const int hch = lane & 15, q4 = lane >> 4;
#pragma unroll
    for (int ks = 0; ks < 4; ++ks) {
      const int p0 = 16 * ks + 4 * q4;
      const f32x4 cr = *(const f32x4*)(p.c_re + ((size_t)dg * 16 + hch) * 64 + p0), ci = *(const f32x4*)(p.c_im + ((size_t)dg * 16 + hch) * 64 + p0);
      u32x4 t; t[0] = pack_bf16(cr[0], -ci[0]); t[1] = pack_bf16(cr[1], -ci[1]); t[2] = pack_bf16(cr[2], -ci[2]); t[3] = pack_bf16(cr[3], -ci[3]);
      cfrag[ks] = as_bf16x8(t);
    }
  }
  float a1r_[2], a1i_[2], a16r_[2], a16i_[2];
#pragma unroll
  for (int pb = 0; pb < 2; ++pb) {
    float ar = AR[dg * 64 + pb * 32 + lr], ai = AI[dg * 64 + pb * 32 + lr];
    a1r_[pb] = ar; a1i_[pb] = ai;
#pragma unroll
    for (int k = 0; k < 4; ++k) { const float nr = ar * ar - ai * ai, ni = 2.f * ar * ai; ar = nr; ai = ni; }
    a16r_[pb] = ar; a16i_[pb] = ai;
  }
  const int upos = 16 * ((lr >> 2) & 1) + 4 * (lr >> 3) + (lr & 3);
  const bf16_t* up0 = U + (size_t)g * ((size_t)NTOK * 16) + (size_t)(trow0 + dstep * upos) * 16 + lh * 8;
  const long ustep = (long)dstep * 32 * 16;
  u32x4 un = *(const u32x4*)up0;
  auto cproj = [&](int cprev, const char* xb) {
#pragma unroll
    for (int mt = 0; mt < 2; ++mt) {
      f32x4 ya = {0.f, 0.f, 0.f, 0.f};
#pragma unroll
      for (int ks = 0; ks < 4; ++ks) {
        const bf16x8 xf = *(const bf16x8*)(xb + (mt * 16 + (lane & 15)) * 272 + (32 * ks + 8 * (lane >> 4)) * 2);
        ya = __builtin_amdgcn_mfma_f32_16x16x32_bf16(cfrag[ks], xf, ya, 0, 0, 0);
      }
      const int sp = cprev * 32 + mt * 16 + (lane & 15);
      *(f32x4*)(Y + (size_t)g * ((size_t)NTOK * 16) + (size_t)(trow0 + dstep * sp) * 16 + (lane >> 4) * 4) = ya;
    }
  };
#pragma unroll 1
  for (int c = 0; c < nch; ++c) {
    const bf16x8 uf = as_bf16x8(un);
    if (c + 1 < nch) { const bf16_t* upn = up0 + (long)(c + 1) * ustep; un = *(const u32x4*)upn; }
    f32x16 xr[2], xi[2];
#pragma unroll
    for (int pb = 0; pb < 2; ++pb) {
#pragma unroll
      for (int i = 0; i < 16; ++i) { xr[pb][i] = 0.f; xi[pb][i] = 0.f; }
      xr[pb] = __builtin_amdgcn_mfma_f32_32x32x16_bf16(uf, bfrag[pb], xr[pb], 0, 0, 0);
      xi[pb] = __builtin_amdgcn_mfma_f32_32x32x16_bf16(uf, bfrag[2 + pb], xi[pb], 0, 0, 0);
    }
    if (FULL && c > 0) cproj(c - 1, xs + ((c - 1) & 1) * 8704);
    char* xw = xs + (c & 1) * 8704;
#pragma unroll
    for (int pb = 0; pb < 2; ++pb) {
      const float a1r = a1r_[pb], a1i = a1i_[pb];
      {
        const float c0r = lh ? 0.f : cr_[pb], c0i = lh ? 0.f : ci_[pb];
        xr[pb][0] += a1r * c0r - a1i * c0i;
        xi[pb][0] += a1r * c0i + a1i * c0r;
      }
#pragma unroll
      for (int i = 1; i < 16; ++i) {
        const float pr = xr[pb][i - 1], pi = xi[pb][i - 1];
        xr[pb][i] += a1r * pr - a1i * pi;
        xi[pb][i] += a1r * pi + a1i * pr;
      }
      const float hr = half_bcast(xr[pb][15], 0), hi = half_bcast(xi[pb][15], 0);
      const float c2r = lh ? hr : 0.f, c2i = lh ? hi : 0.f;
      if (FULL) {
        float fr_ = c2r, fi_ = c2i;
#pragma unroll
        for (int i = 0; i < 16; ++i) {
          const float nr = a1r * fr_ - a1i * fi_, ni = a1r * fi_ + a1i * fr_;
          fr_ = nr; fi_ = ni;
          xr[pb][i] += fr_;
          xi[pb][i] += fi_;
        }
      } else {
        xr[pb][15] += a16r_[pb] * c2r - a16i_[pb] * c2i;
        xi[pb][15] += a16r_[pb] * c2i + a16i_[pb] * c2r;
      }
      cr_[pb] = half_bcast(xr[pb][15], 1);
      ci_[pb] = half_bcast(xi[pb][15], 1);
      if (FULL) {
#pragma unroll
        for (int i = 0; i < 16; ++i) *(unsigned*)(xw + (16 * lh + i) * 272 + (pb * 32 + lr) * 4) = pack_bf16(xr[pb][i], xi[pb][i]);
      }
    }
    if (FULL) asm volatile("s_waitcnt lgkmcnt(0)" ::: "memory");
  }
  if (FULL) cproj(nch - 1, xs + ((nch - 1) & 1) * 8704);
}

__device__ __forceinline__ void s5_combine(const Params& p, int rowbase, int L, int g0, int ng) {
  const float* YF = (const float*)(p.ws + OFF_YF); const float* YB = (const float*)(p.ws + OFF_YB); const bf16_t* U = (const bf16_t*)(p.ws + OFF_U);
  bf16_t* YBF = (bf16_t*)(p.ws + OFF_YBF);
  const int T_ = opaque_tid(), l4 = L * 4;
#pragma unroll 1
  for (int bt = 0; bt < 2; ++bt) {
    f32x4 yf[4], yb[4], u[4], d[4]; size_t oo[4];
#pragma unroll
    for (int k = 0; k < 4; ++k) {
      const int i = T_ + 512 * (bt * 4 + k);
      const int q = i / l4, rem = i - q * l4, t = rem >> 2, c4 = (rem & 3) * 4;
      const size_t oi = (size_t)(g0 + q) * ((size_t)NTOK * 16) + (size_t)(rowbase + t) * 16 + c4;
      oo[k] = (size_t)(rowbase + t) * 512 + (g0 + q) * 16 + c4;
      yf[k] = *(const f32x4*)(YF + oi); yb[k] = *(const f32x4*)(YB + oi); { const u32x2 t = *(const u32x2*)(U + oi); u[k] = (f32x4){__uint_as_float(t[0] << 16), __uint_as_float(t[0] & 0xffff0000u), __uint_as_float(t[1] << 16), __uint_as_float(t[1] & 0xffff0000u)}; } d[k] = *(const f32x4*)(p.s5_d + (g0 + q) * 16 + c4);
    }
#pragma unroll
    for (int k = 0; k < 4; ++k) {
      float r[4];
#pragma unroll
      for (int e = 0; e < 4; ++e) r[e] = gelu_tanh(yf[k][e] + yb[k][e] + d[k][e] * u[k][e]);
      u32x2 w; w[0] = pack_bf16(r[0], r[1]); w[1] = pack_bf16(r[2], r[3]);
      *(u32x2*)(YBF + oo[k]) = w;
    }
  }
}

__device__ __forceinline__ void phase_mix0(const Params& p, char* smem, volatile LAS unsigned* st) {
  const int T_ = opaque_tid();
  const int wid = T_ >> 6, vb = T_ >> 8, vtid = T_ & 255, lane = T_ & 63, lr = lane & 31, lh = lane >> 5;
  unsigned* qctr = (unsigned*)(p.ws + OFF_BAR) + 16;
  float* ex = (float*)(smem + 8 * 17408);
  for (;;) {
    __syncthreads();
    if (T_ == 0) st[2] = __hip_atomic_fetch_add(qctr, 1u, __ATOMIC_RELAXED, __HIP_MEMORY_SCOPE_AGENT);
    __syncthreads();
    const int q_ = (int)st[2];
    if (q_ >= 768) break;
    const int item = q_ < 128 ? 384 + q_ : (q_ < 384 ? q_ : (q_ < 512 ? q_ - 384 : q_));
    if (item < 384) {
      const bool lat = item < 128;
      const int it = lat ? item : item - 128;
      const int d = lat ? (it & 1) : (wid & 1), seg = wid;
      const int b = lat ? (it >> 6) : (it >> 3);
      const int g0 = lat ? ((it >> 1) & 31) : (it & 7) * 4;
      const int g = lat ? g0 : g0 + (wid >> 1);
      const int rowbase = lat ? NP + b * LS : b * LP;
      const int trow0 = lat ? rowbase + (d ? LS - 1 - 128 * seg : 128 * seg) : rowbase + (d ? LP - 1 : 0);
      const int dstep = d ? -1 : 1, nch = lat ? 4 : 8;
      float cr_[2] = {0.f, 0.f}, ci_[2] = {0.f, 0.f};
      if (lat) {
        s5_scan<false>(p, trow0, dstep, nch, g, d, cr_, ci_, nullptr);
        if (lh == 0) {
#pragma unroll
          for (int pb = 0; pb < 2; ++pb) { ex[(seg * 2 + 0) * 64 + pb * 32 + lr] = cr_[pb]; ex[(seg * 2 + 1) * 64 + pb * 32 + lr] = ci_[pb]; }
        }
        __syncthreads();
        const float* AR = (const float*)(p.ws + OFF_AR); const float* AI = (const float*)(p.ws + OFF_AI);
        const float* s0 = p.state_s5 + (size_t)b * 8192;
#pragma unroll
        for (int pb = 0; pb < 2; ++pb) {
          const int pi = pb * 32 + lr;
          float ar = AR[(d * 32 + g) * 64 + pi], ai = AI[(d * 32 + g) * 64 + pi];
#pragma unroll
          for (int k = 0; k < 7; ++k) { const float nr = ar * ar - ai * ai, ni = 2.f * ar * ai; ar = nr; ai = ni; }
          float cr = s0[((d * 2 + 0) * 32 + g) * 64 + pi], ci = s0[((d * 2 + 1) * 32 + g) * 64 + pi];
          for (int j = 0; j < seg; ++j) {
            const float er = ex[(j * 2 + 0) * 64 + pi], ei = ex[(j * 2 + 1) * 64 + pi];
            const float nr = ar * cr - ai * ci + er, ni = ar * ci + ai * cr + ei;
            cr = nr; ci = ni;
          }
          cr_[pb] = cr; ci_[pb] = ci;
        }
      }
      s5_scan<true>(p, trow0, dstep, nch, g, d, cr_, ci_, smem + wid * 17408);
      if (!lat && lh == 0) {
        float* os = p.out + (size_t)NTOK * DM + (size_t)2 * NP * 512 + (size_t)b * 8192;
#pragma unroll
        for (int pb = 0; pb < 2; ++pb) { os[((d * 2 + 0) * 32 + g) * 64 + pb * 32 + lr] = cr_[pb]; os[((d * 2 + 1) * 32 + g) * 64 + pb * 32 + lr] = ci_[pb]; }
      }
      __syncthreads();
      if (!lat) s5_combine(p, rowbase, LP, g0, 4);
      else {
        asm volatile("s_waitcnt vmcnt(0)" ::: "memory");
        __syncthreads();
        if (T_ == 0) {
          __builtin_amdgcn_fence(__ATOMIC_RELEASE, "agent");
          asm volatile("s_waitcnt vmcnt(0)" ::: "memory");
          const unsigned old = __hip_atomic_fetch_add((unsigned*)(p.ws + OFF_BAR) + 32 + b * 32 + g0, 1u, __ATOMIC_RELAXED, __HIP_MEMORY_SCOPE_AGENT);
          __builtin_amdgcn_fence(__ATOMIC_ACQUIRE, "agent");
          asm volatile("s_waitcnt vmcnt(0)" ::: "memory");
          st[3] = old;
        }
        __syncthreads();
        if (st[3] == 1u) s5_combine(p, rowbase, LS, g0, 1);
      }
    } else {
      int vt = vtid; asm volatile("" : "+v"(vt));
      if (item < 512) {
        attn_item(p, item - 384, smem + vb * 34816, vt, vb ? 5 : 0, vb ? 9 : 5, 5, vb ? 1 : 2, smem + 34816);
      } else {
        attn_item(p, 128 + (item - 512) * 2 + vb, smem + vb * 34816, vt, 0, 2, 2, 0, nullptr);
      }
    }
  }
}

constexpr int LDS_GEMM = 131072;
constexpr int LDS_BYTES = 147456;

#define WSP ({ const unsigned long long _w = (unsigned long long)p.ws; unsigned _lo = __builtin_amdgcn_readfirstlane((unsigned)_w), _hi = __builtin_amdgcn_readfirstlane((unsigned)(_w >> 32)); asm volatile("" : "+s"(_lo), "+s"(_hi)); (char*)(((unsigned long long)_hi << 32) | _lo); })
#define MOD ((float*)(WSP + OFF_MOD))
#define SUMSQ ((float*)(WSP + OFF_SUMSQ))
#define GS ((const float*)(WSP + OFF_GS))
#define SHWGU ((const float*)(WSP + OFF_SHWGU))
#define SHWINO ((const float*)(WSP + OFF_SHWINO))
#define ABUF ((bf16_t*)(WSP + OFF_ABUF))
#define CAT ((bf16_t*)(WSP + OFF_CAT))
#define X ((bf16_t*)(WSP + OFF_X))
#define HFF ((bf16_t*)(WSP + OFF_HFF))
__global__ void __launch_bounds__(512, 2) mega(Params p) {
  extern __shared__ __attribute__((aligned(16))) unsigned char lds_raw[];
  LAS unsigned char* lds = (LAS unsigned char*)lds_raw;
  char* smem = (char*)lds_raw;
  volatile LAS unsigned* st = (volatile LAS unsigned*)(lds + LDS_BYTES - 256);
  if (threadIdx.x < 4) st[threadIdx.x] = 0u;
  __syncthreads();
  XcdBarrier bar = xcd_barrier_post((unsigned*)(WSP + OFF_BAR), st);
  SchedFlat sf;

  phase_prep(p, smem);
  xcd_barrier(bar);
  phase_norm(p, true, p.norm_mix_g, MOD + 0 * 3 * 6144 + 0 * 1024);
  xcd_barrier(bar);
  {
    EpiInEven ep{(bf16_t*)(WSP + OFF_QB), (bf16_t*)(WSP + OFF_KB), (bf16_t*)(WSP + OFF_VB), (float*)(WSP + OFF_U),
                 p.out + (size_t)NTOK * DM, p.out + (size_t)NTOK * DM + (size_t)NP * 512};
    sf.init(ABUF, DM, (const bf16_t*)(WSP + OFF_WT_IN), DM, NTOK, 2048, 0);
    gemm8(lds, DM, DM, DM, sf, ep);
  }
  phase_prep_late(p, smem, 0, 64);
  phase_prep_mod1(p, smem, 64);
  xcd_barrier(bar);
  phase_mix0(p, smem, st);
  xcd_barrier(bar);
  {
    const bf16_t* YBF = (const bf16_t*)(WSP + OFF_YBF);
    sf.init(YBF, 512, (const bf16_t*)(WSP + OFF_WT_GLU), 512, NTOK, 512, 0);
    gemm8<true>(lds, 512, 512, 512, SchedFlatTail{sf, 0}, EpiGlu<true>{YBF, p.glu_b, CAT});
  }
  phase_norm_consts(p, 0, 160);
  xcd_barrier(bar);
  sf.init(CAT, DM, (const bf16_t*)(WSP + OFF_WT_OUT), DM, NTOK, DM, 0);
  gemm8(lds, DM, DM, DM, sf, EpiResid<true>{p.x_prompt, p.x_sample, nullptr, X, MOD + 2 * 1024, ABUF, GS, SUMSQ});
  phase_prep_dft(p, 160);
  phase_norm_consts(p, 1, 160);
  xcd_barrier(bar);
  sf.init(ABUF, DM, (const bf16_t*)(WSP + OFF_WT_GU), DM, NTOK, 5632, 0);
  sf.limit = 768;
  gemm8(lds, DM, DM, DM, sf, EpiSwiGLU<false>{HFF, SUMSQ, SHWGU});
  sf.limit = sf.nwg;
  gemm8<true>(lds, DM, DM, DM, SchedFlatTail{sf, 768}, EpiSwiGLU<true>{HFF, SUMSQ, SHWGU});
  xcd_barrier(bar);
  sf.init(HFF, DFF, (const bf16_t*)(WSP + OFF_WT_DN), DFF, NTOK, DM, 0);
  gemm8(lds, DFF, DFF, DFF, sf, EpiResid<false>{p.x_prompt, p.x_sample, X, X, MOD + 5 * 1024, ABUF, GS + 3072, SUMSQ + NTOK});
  phase_prep_late(p, smem, 1, 160);
  xcd_barrier(bar);
  sf.init(ABUF, DM, (const bf16_t*)(WSP + OFF_WT_INO), DM, NTOK, DM, DM);
  gemm8(lds, DM, DM, DM, sf, EpiBf16Norm{(bf16_t*)(WSP + OFF_Z), SUMSQ + NTOK, SHWINO});
  phase_norm_consts(p, 2, 160);
  {
    Unit u0; const bool have = sf.next(0, u0);
    asm volatile("s_waitcnt vmcnt(0)" ::: "memory");
    __syncthreads();
    gemm8(lds, 256, 256, DM, SchedF1Own{(const char*)(WSP + OFF_CS2), (const char*)(WSP + OFF_Z), have ? u0.pm : 0, have ? u0.pn : 0, have}, EpiBf16{(bf16_t*)(WSP + OFF_OT)});
  }
  xcd_barrier(bar);
  gemm8(lds, 512, 512, 512, SchedF2P{(const char*)(WSP + OFF_CL2P), (const char*)(WSP + OFF_OT), (int)blockIdx.x}, EpiBf16{CAT});
  gemm8<true>(lds, 2048, 2048, 2048, SchedF2S{(const char*)(WSP + OFF_CL2S), (const char*)(WSP + OFF_OT), (int)blockIdx.x}, EpiBf16Half{CAT});
  xcd_barrier(bar);
  sf.init(CAT, DM, (const bf16_t*)(WSP + OFF_WT_OUTO), DM, NTOK, DM, 0);
  gemm8(lds, DM, DM, DM, sf, EpiResid<false>{p.x_prompt, p.x_sample, X, X, MOD + 3 * 6144 + 2 * 1024, ABUF, GS + 2 * 3072, SUMSQ + 2 * NTOK});
  xcd_barrier(bar);
  sf.init(ABUF, DM, (const bf16_t*)(WSP + OFF_WT_GU) + (size_t)5632 * 1024, DM, NTOK, 5632, 0);
  sf.limit = 768;
  gemm8(lds, DM, DM, DM, sf, EpiSwiGLU<false>{HFF, SUMSQ + 2 * NTOK, SHWGU + 3 * 5632});
  sf.limit = sf.nwg;
  gemm8<true>(lds, DM, DM, DM, SchedFlatTail{sf, 768}, EpiSwiGLU<true>{HFF, SUMSQ + 2 * NTOK, SHWGU + 3 * 5632});
  xcd_barrier(bar);
  sf.init(HFF, DFF, (const bf16_t*)(WSP + OFF_WT_DN) + (size_t)1024 * DFF, DFF, NTOK, DM, 0);
  gemm8(lds, DFF, DFF, DFF, sf, EpiFinal{X, MOD + 3 * 6144 + 5 * 1024, p.final_g, p.out, SUMSQ + 3 * NTOK, (unsigned*)(WSP + OFF_PCNT)});
}

extern "C" void kernel_launch(void* const* d_in, const int* in_sizes, int n_in, void* d_out, int out_size, void* d_ws, size_t ws_size, hipStream_t stream) {
  static int grid_blocks = 0;
  if (!grid_blocks) {
    int dev = 0, cus = 0, per_cu = 0;
    (void)hipGetDevice(&dev);
    (void)hipDeviceGetAttribute(&cus, hipDeviceAttributeMultiprocessorCount, dev);
    if (hipFuncSetAttribute((const void*)mega, hipFuncAttributeMaxDynamicSharedMemorySize, LDS_BYTES) != hipSuccess) fprintf(stderr, "hipFuncSetAttribute failed\n");
    (void)hipOccupancyMaxActiveBlocksPerMultiprocessor(&per_cu, mega, 512, LDS_BYTES);
    if (per_cu < 1) fprintf(stderr, "occupancy query reports %d blocks per CU\n", per_cu);
    (void)hipGetLastError();
    grid_blocks = cus;
  }
  if (ws_size < WS_NEED) { fprintf(stderr, "workspace too small: %zu < %zu\n", ws_size, (size_t)WS_NEED); return; }
  Params p{};
  const float** pp = (const float**)&p;
  for (int i = 0; i < 30; ++i) pp[i] = (const float*)d_in[i];
  p.out = (float*)d_out;
  p.ws = (char*)d_ws;
  (void)hipMemsetAsync((char*)d_ws + OFF_BAR, 0, ZERO_BYTES, stream);
  void* args[] = {&p};
  hipError_t e = hipLaunchCooperativeKernel((void*)mega, dim3(grid_blocks), dim3(512), args, LDS_BYTES, stream);
  if (e != hipSuccess) fprintf(stderr, "cooperative launch failed: %s (grid %d)\n", hipGetErrorString(e), grid_blocks);
}
```
